# Optimizing an MI355X kernel written in HIP

```python
import jax, jax.numpy as jnp
from jax import lax
import numpy as np

D_MODEL = 1024
BATCH = 8
SEQ = 8192
DEPTH = 2

HEAD_DIM = 64
SWA_Q_HEADS = 8
SWA_KV_HEADS = 2
SWA_WINDOW = 128
FOX_HEADS = 8
BLOCK = 128
D_FF = 2816
CONV_WIDTH = 3
LN_EPS = 1e-5
NEG_INF = -1e30
FOX_GATE_BIAS_INIT = 3.0
DEEPNORM_ALPHA = (2 * DEPTH) ** 0.25
DEEPNORM_BETA = (8 * DEPTH) ** -0.25
SWA_Q = SWA_Q_HEADS * HEAD_DIM
SWA_KV = SWA_KV_HEADS * HEAD_DIM
FOX_W = FOX_HEADS * HEAD_DIM
SPLIT_SIZES = (SWA_Q, SWA_KV, SWA_KV, FOX_W, FOX_W, FOX_W, FOX_HEADS, D_MODEL, D_MODEL)
N_IN = SWA_Q + 2 * SWA_KV + 3 * FOX_W + FOX_HEADS + 2 * D_MODEL

kernel_name = "hybrid_swa_sink_fox_gated_convffn_deepnorm"


def layer_norm(x, g, b):
    xf = x.astype(jnp.float32)
    mu = jnp.mean(xf, axis=-1, keepdims=True)
    var = jnp.mean(jnp.square(xf - mu), axis=-1, keepdims=True)
    y = (xf - mu) * lax.rsqrt(var + LN_EPS) * g.astype(jnp.float32) + b.astype(jnp.float32)
    return y.astype(x.dtype)


def alibi_slopes(n_heads):
    return jnp.asarray(2.0 ** (-8.0 * np.arange(1, n_heads + 1) / n_heads), dtype=jnp.float32)


def swa_sink_attention(q, k, v, sinks):
    B, S, Hq, d = q.shape
    Hkv = k.shape[2]
    G = Hq // Hkv
    nb = S // BLOCK
    qb = q.reshape(B, nb, BLOCK, Hkv, G, d)
    kb = k.reshape(B, nb, BLOCK, Hkv, d)
    vb = v.reshape(B, nb, BLOCK, Hkv, d)

    def with_prev(t):
        prev = jnp.pad(t, ((0, 0), (1, 0), (0, 0), (0, 0), (0, 0)))[:, :-1]
        return jnp.concatenate([prev, t], axis=2)

    kw, vw = with_prev(kb), with_prev(vb)
    scores = jnp.einsum('bnqhgd,bnkhd->bnhgqk', qb, kw).astype(jnp.float32) * (d ** -0.5)
    q_pos = jnp.arange(BLOCK)[:, None] + BLOCK
    k_pos = jnp.arange(2 * BLOCK)[None, :]
    dist = q_pos - k_pos
    valid = (dist >= 0) & (dist < SWA_WINDOW)
    blk = jnp.arange(nb)[:, None, None]
    valid = valid[None] & ((k_pos[None] >= BLOCK) | (blk > 0))
    slopes = alibi_slopes(Hq).reshape(Hkv, G)
    alibi = -slopes[:, :, None, None] * dist.astype(jnp.float32)[None, None]
    scores = scores + alibi[None, None]
    scores = jnp.where(valid[None, :, None, None], scores, NEG_INF)
    sink = jnp.broadcast_to(sinks.astype(jnp.float32).reshape(Hkv, G)[None, None, :, :, None, None],
                            scores.shape[:-1] + (1,))
    probs = jax.nn.softmax(jnp.concatenate([scores, sink], axis=-1), axis=-1)[..., :-1]
    out = jnp.einsum('bnhgqk,bnkhd->bnqhgd', probs.astype(v.dtype), vw)
    return out.reshape(B, S, Hq * d)


def forgetting_attention(q, k, v, log_f):
    B, S, H, d = q.shape
    nb = S // BLOCK
    c = jnp.cumsum(log_f, axis=1)
    c_k = jnp.transpose(c, (0, 2, 1))
    qb = jnp.transpose(q.reshape(B, nb, BLOCK, H, d), (1, 0, 2, 3, 4))
    cq = jnp.transpose(c.reshape(B, nb, BLOCK, H), (1, 0, 3, 2))
    k_pos = jnp.arange(S)
    scale = d ** -0.5

    def one_block(args):
        q_blk, c_blk, i = args
        s = jnp.einsum('bqhd,bkhd->bhqk', q_blk, k).astype(jnp.float32) * scale
        s = s + c_blk[..., None] - c_k[:, :, None, :]
        q_pos = i * BLOCK + jnp.arange(BLOCK)
        mask = k_pos[None, :] <= q_pos[:, None]
        s = jnp.where(mask[None, None], s, NEG_INF)
        p = jax.nn.softmax(s, axis=-1)
        return jnp.einsum('bhqk,bkhd->bqhd', p.astype(v.dtype), v)

    out = lax.map(one_block, (qb, cq, jnp.arange(nb)))
    return jnp.transpose(out, (1, 0, 2, 3, 4)).reshape(B, S, H * d)


def token_mixer(h, w_in, b_in, sinks, w_proj_a, w_proj_b, w_out):
    B, S, _ = h.shape
    z = h @ w_in + b_in
    idx = [int(i) for i in np.cumsum(SPLIT_SIZES)[:-1]]
    q_a, k_a, v_a, q_b, k_b, v_b, f_logit, g_a, g_b = jnp.split(z, idx, axis=-1)
    y_a = swa_sink_attention(q_a.reshape(B, S, SWA_Q_HEADS, HEAD_DIM),
                             k_a.reshape(B, S, SWA_KV_HEADS, HEAD_DIM),
                             v_a.reshape(B, S, SWA_KV_HEADS, HEAD_DIM), sinks) @ w_proj_a
    log_f = jax.nn.log_sigmoid(f_logit.astype(jnp.float32))
    y_b = forgetting_attention(q_b.reshape(B, S, FOX_HEADS, HEAD_DIM),
                               k_b.reshape(B, S, FOX_HEADS, HEAD_DIM),
                               v_b.reshape(B, S, FOX_HEADS, HEAD_DIM), log_f) @ w_proj_b
    merged = jax.nn.sigmoid(g_a) * y_a + jax.nn.sigmoid(g_b) * y_b
    return merged @ w_out


def conv_gated_ffn(h, w_ffn_in, conv_w, conv_b, w_ffn_out):
    S = h.shape[1]
    gate, up = jnp.split(h @ w_ffn_in, 2, axis=-1)
    gp = jnp.pad(gate, ((0, 0), (CONV_WIDTH - 1, 0), (0, 0)))
    conv = conv_b
    for j in range(CONV_WIDTH):
        conv = conv + conv_w[j] * gp[:, j:j + S]
    return (jax.nn.silu(conv) * up) @ w_ffn_out


def setup_inputs(seed: int = 0) -> dict:
    key = jax.random.key(seed)
    ks = jax.random.split(key, 16)
    f32 = jnp.float32
    L = DEPTH
    beta = DEEPNORM_BETA
    x = jax.random.normal(ks[0], (BATCH, SEQ, D_MODEL), f32)
    ln_mix_g = 1.0 + 0.02 * jax.random.normal(ks[1], (L, D_MODEL), f32)
    ln_mix_b = 0.02 * jax.random.normal(ks[2], (L, D_MODEL), f32)
    col_scale = np.ones((N_IN,), np.float32)
    va0 = SWA_Q + SWA_KV
    col_scale[va0:va0 + SWA_KV] = beta
    vb0 = SWA_Q + 2 * SWA_KV + 2 * FOX_W
    col_scale[vb0:vb0 + FOX_W] = beta
    w_in = jax.random.normal(ks[3], (L, D_MODEL, N_IN), f32) * (D_MODEL ** -0.5) * jnp.asarray(col_scale)
    bias_off = np.zeros((N_IN,), np.float32)
    f0 = SWA_Q + 2 * SWA_KV + 3 * FOX_W
    bias_off[f0:f0 + FOX_HEADS] = FOX_GATE_BIAS_INIT
    b_in = 0.02 * jax.random.normal(ks[4], (L, N_IN), f32) + jnp.asarray(bias_off)
    attn_sinks = 0.5 * jax.random.normal(ks[5], (L, SWA_Q_HEADS), f32)
    w_proj_a = jax.random.normal(ks[6], (L, SWA_Q, D_MODEL), f32) * (SWA_Q ** -0.5) * beta
    w_proj_b = jax.random.normal(ks[7], (L, FOX_W, D_MODEL), f32) * (FOX_W ** -0.5) * beta
    w_out = jax.random.normal(ks[8], (L, D_MODEL, D_MODEL), f32) * (D_MODEL ** -0.5) * beta
    ln_ffn_g = 1.0 + 0.02 * jax.random.normal(ks[9], (L, D_MODEL), f32)
    ln_ffn_b = 0.02 * jax.random.normal(ks[10], (L, D_MODEL), f32)
    w_ffn_in = jax.random.normal(ks[11], (L, D_MODEL, 2 * D_FF), f32) * (D_MODEL ** -0.5) * beta
    conv_w = jax.random.normal(ks[12], (L, CONV_WIDTH, D_FF), f32) * (CONV_WIDTH ** -0.5)
    conv_b = 0.02 * jax.random.normal(ks[13], (L, D_FF), f32)
    w_ffn_out = jax.random.normal(ks[14], (L, D_FF, D_MODEL), f32) * (D_FF ** -0.5) * beta
    return {"x": x, "ln_mix_g": ln_mix_g, "ln_mix_b": ln_mix_b, "w_in": w_in, "b_in": b_in,
            "attn_sinks": attn_sinks, "w_proj_a": w_proj_a, "w_proj_b": w_proj_b, "w_out": w_out,
            "ln_ffn_g": ln_ffn_g, "ln_ffn_b": ln_ffn_b, "w_ffn_in": w_ffn_in, "conv_w": conv_w,
            "conv_b": conv_b, "w_ffn_out": w_ffn_out}


def reference(x, ln_mix_g, ln_mix_b, w_in, b_in, attn_sinks, w_proj_a, w_proj_b, w_out,
              ln_ffn_g, ln_ffn_b, w_ffn_in, conv_w, conv_b, w_ffn_out):
    h = x
    for l in range(DEPTH):
        mix = token_mixer(h, w_in[l], b_in[l], attn_sinks[l], w_proj_a[l], w_proj_b[l], w_out[l])
        h = layer_norm(DEEPNORM_ALPHA * h + mix, ln_mix_g[l], ln_mix_b[l])
        ffn = conv_gated_ffn(h, w_ffn_in[l], conv_w[l], conv_b[l], w_ffn_out[l])
        h = layer_norm(DEEPNORM_ALPHA * h + ffn, ln_ffn_g[l], ln_ffn_b[l])
    return h
```

```cpp
#include <hip/hip_runtime.h>
#include <hip/hip_cooperative_groups.h>
#include <hip/hip_bf16.h>
#include <cstdio>
#include <cstdint>
#include <cmath>
namespace cg = cooperative_groups;

namespace pg8 {
#define PG8_LAS __attribute__((address_space(3)))
typedef unsigned short bf16_t;
typedef short bf16x8 __attribute__((ext_vector_type(8)));
typedef float f32x4 __attribute__((ext_vector_type(4)));
typedef unsigned u32x4 __attribute__((ext_vector_type(4)));
constexpr int BM = 256, BK = 64, HALF = 128, HTB = HALF * BK * 2  , STAGE_BYTES = 8 * HTB;

__host__ __device__ __forceinline__ int lds_byte(int r, int c) { const int st = (r >> 4) * 2 + (c >> 5), rr = r & 15, cc = c & 31, ob = rr * 64 + cc * 2; return st * 1024 + (ob ^ (((ob >> 9) & 1) << 5)); }
__host__ __device__ __forceinline__ void stage_rc(int b, int& R, int& C) { const int st = b / 1024, sb = b % 1024, swz = sb ^ (((sb >> 9) & 1) << 5); R = (st >> 1) * 16 + swz / 64; C = (st & 1) * 32 + (swz % 64) / 2; }
__host__ __device__ __forceinline__ int perm32(int rho) { const int n = rho >> 4, i = rho & 15; return 8 * (i >> 2) + 4 * n + (i & 3); }

struct Unit { int pm, pn; };
struct Gemm { const bf16_t* A; const bf16_t* Bt; int M, N, K, lda; };

struct PanelOrder {
    int pm, nN;
    __device__ __forceinline__ bool next(int i, Unit& u) const { if (i >= nN) return false; u.pm = pm; u.pn = i; return true; }
    __device__ __forceinline__ void a_ready(const Unit&) const {}
    __device__ __forceinline__ void done(const Unit&) const {}
};

__device__ __forceinline__ unsigned cvt_pk_bf16(float lo, float hi) { unsigned r; asm volatile("v_cvt_pk_bf16_f32 %0, %1, %2" : "=v"(r) : "v"(lo), "v"(hi)); return r; }
__device__ __forceinline__ float bf_lo(unsigned w) { return __uint_as_float(w << 16); }
__device__ __forceinline__ float bf_hi(unsigned w) { return __uint_as_float(w & 0xffff0000u); }
__device__ __forceinline__ float sigmoidf_(float x) { return __builtin_amdgcn_rcpf(1.0f + __expf(-x)); }


struct EpiZ {
    static constexpr bool PERM = true, AFTER_DRAIN = false;
    bf16_t* O; int ldc; const float* bias; float qscale;
    __device__ __forceinline__ void operator()(const f32x4 (&acc)[2][2][4][2], const Unit& u, int wr, int wc, int fr_in, int fq_in) const {
        int fr = fr_in, fq = fq_in; asm volatile("" : "+v"(fr), "+v"(fq));
        const int row0 = u.pm * BM + wr * 64 + fr; const int col0 = u.pn * BM + wc * 32 + 8 * fq;
        const float sc = (u.pn == 0 || u.pn == 1 || u.pn == 3 || u.pn == 4) ? qscale : 1.f;
        f32x4 bv[2][2];
#pragma unroll
        for (int bj = 0; bj < 2; ++bj)
#pragma unroll
            for (int n = 0; n < 2; ++n) { const int c = col0 + bj * HALF + 4 * n; bv[bj][n] = *(const f32x4*)(bias + c + (c >= 2304 ? 8 : 0)); }
#pragma unroll
        for (int ai = 0; ai < 2; ++ai)
#pragma unroll
            for (int m = 0; m < 4; ++m) { bf16_t* rowp = O + (size_t)(row0 + ai * HALF + m * 16) * ldc + col0;
#pragma unroll
                for (int bj = 0; bj < 2; ++bj) { f32x4 v0 = (acc[ai][bj][m][0] + bv[bj][0]) * sc, v1 = (acc[ai][bj][m][1] + bv[bj][1]) * sc;
                    u32x4 w; w.x = cvt_pk_bf16(v0[0], v0[1]); w.y = cvt_pk_bf16(v0[2], v0[3]); w.z = cvt_pk_bf16(v1[0], v1[1]); w.w = cvt_pk_bf16(v1[2], v1[3]);
                    *(u32x4*)(rowp + bj * HALF) = w; } }
    }
};

template <bool SECOND> struct EpiGate {
    static constexpr bool PERM = true, AFTER_DRAIN = false;
    bf16_t* MG; const bf16_t* G; int ldg;
    __device__ __forceinline__ void operator()(const f32x4 (&acc)[2][2][4][2], const Unit& u, int wr, int wc, int fr_in, int fq_in) const {
        int fr = fr_in, fq = fq_in; asm volatile("" : "+v"(fr), "+v"(fq));
        const int row0 = u.pm * BM + wr * 64 + fr; const int col0 = u.pn * BM + wc * 32 + 8 * fq;
#pragma unroll
        for (int ai = 0; ai < 2; ++ai)
#pragma unroll
            for (int m = 0; m < 4; ++m) { const size_t row = (size_t)(row0 + ai * HALF + m * 16);
#pragma unroll
                for (int bj = 0; bj < 2; ++bj) {
                    const u32x4 gw = *(const u32x4*)(G + row * ldg + col0 + bj * HALF);
                    bf16_t* mp = MG + row * 1024 + col0 + bj * HALF;
                    const f32x4 a0 = acc[ai][bj][m][0], a1 = acc[ai][bj][m][1];
                    float v[8];
                    v[0] = sigmoidf_(bf_lo(gw.x)) * a0[0]; v[1] = sigmoidf_(bf_hi(gw.x)) * a0[1]; v[2] = sigmoidf_(bf_lo(gw.y)) * a0[2]; v[3] = sigmoidf_(bf_hi(gw.y)) * a0[3];
                    v[4] = sigmoidf_(bf_lo(gw.z)) * a1[0]; v[5] = sigmoidf_(bf_hi(gw.z)) * a1[1]; v[6] = sigmoidf_(bf_lo(gw.w)) * a1[2]; v[7] = sigmoidf_(bf_hi(gw.w)) * a1[3];
                    if (SECOND) { const u32x4 pw = *(const u32x4*)mp;
                        v[0] += bf_lo(pw.x); v[1] += bf_hi(pw.x); v[2] += bf_lo(pw.y); v[3] += bf_hi(pw.y); v[4] += bf_lo(pw.z); v[5] += bf_hi(pw.z); v[6] += bf_lo(pw.w); v[7] += bf_hi(pw.w); }
                    u32x4 w; w.x = cvt_pk_bf16(v[0], v[1]); w.y = cvt_pk_bf16(v[2], v[3]); w.z = cvt_pk_bf16(v[4], v[5]); w.w = cvt_pk_bf16(v[6], v[7]);
                    *(u32x4*)mp = w; } }
    }
};

struct EpiRes {
    static constexpr bool PERM = true, AFTER_DRAIN = false;
    const float* base; float* out; float alpha;
    __device__ __forceinline__ void operator()(const f32x4 (&acc)[2][2][4][2], const Unit& u, int wr, int wc, int fr_in, int fq_in) const {
        int fr = fr_in, fq = fq_in; asm volatile("" : "+v"(fr), "+v"(fq));
        const int row0 = u.pm * BM + wr * 64 + fr; const int col0 = u.pn * BM + wc * 32 + 8 * fq;
#pragma unroll
        for (int ai = 0; ai < 2; ++ai)
#pragma unroll
            for (int m = 0; m < 4; ++m) { const size_t off = (size_t)(row0 + ai * HALF + m * 16) * 1024 + col0;
#pragma unroll
                for (int bj = 0; bj < 2; ++bj) {
                    const f32x4 b0 = *(const f32x4*)(base + off + bj * HALF), b1 = *(const f32x4*)(base + off + bj * HALF + 4);
                    *(f32x4*)(out + off + bj * HALF) = b0 * alpha + acc[ai][bj][m][0];
                    *(f32x4*)(out + off + bj * HALF + 4) = b1 * alpha + acc[ai][bj][m][1]; } }
    }
};

__device__ __forceinline__ float dpp_shr1(float v) { return __builtin_bit_cast(float, __builtin_amdgcn_update_dpp(0, __builtin_bit_cast(int, v), 0x111, 0xf, 0xf, true)); }
__device__ __forceinline__ float dpp_shr2(float v) { return __builtin_bit_cast(float, __builtin_amdgcn_update_dpp(0, __builtin_bit_cast(int, v), 0x112, 0xf, 0xf, true)); }
__device__ __forceinline__ float lane_get(float v, int src_lane) { return __builtin_bit_cast(float, __builtin_amdgcn_ds_bpermute(src_lane * 4, __builtin_bit_cast(int, v))); }

struct EpiConv {
    static constexpr bool PERM = true, AFTER_DRAIN = false;
    bf16_t* H;
    const float* cw; const float* cb;
    float* TAIL; float* HP; float* HU;
    PG8_LAS float* tl;
    __device__ __forceinline__ void operator()(const f32x4 (&acc)[2][2][4][2], const Unit& u, int wr, int wc, int fr_in, int fq_in) const {
        int fr = fr_in, fq = fq_in; asm volatile("" : "+v"(fr), "+v"(fq));
        const int lane = fq * 16 + fr;
        const int colw = wc * 32 + 8 * fq; const int hc0 = u.pn * 128 + colw;
        if (fr >= 14) {
#pragma unroll
            for (int ai = 0; ai < 2; ++ai)
#pragma unroll
                for (int n = 0; n < 2; ++n) *(PG8_LAS f32x4*)(tl + ((ai * 2 + wr) * 2 + (fr - 14)) * 128 + colw + 4 * n) = acc[ai][0][3][n];
            if (wr == 1) {
#pragma unroll
                for (int n = 0; n < 2; ++n) *(f32x4*)(TAIL + ((size_t)u.pm * 2 + (fr - 14)) * 2816 + hc0 + 4 * n) = acc[1][0][3][n];
            }
        }
        asm volatile("s_waitcnt lgkmcnt(0)" ::: "memory"); __builtin_amdgcn_s_barrier(); asm volatile("" ::: "memory");
        const int l15 = (lane & 48) + 15, l14f = (lane & 48) + 14 + (fr & 1);
#pragma unroll
        for (int n = 0; n < 2; ++n) {
            const f32x4 w0 = *(const f32x4*)(cw + hc0 + 4 * n), w1 = *(const f32x4*)(cw + 2816 + hc0 + 4 * n), w2 = *(const f32x4*)(cw + 5632 + hc0 + 4 * n), bb = *(const f32x4*)(cb + hc0 + 4 * n);
#pragma unroll
            for (int ai = 0; ai < 2; ++ai) {
                const int lin = ai * 2 + wr;
                f32x4 hA = (f32x4){0.f, 0.f, 0.f, 0.f}, hB = (f32x4){0.f, 0.f, 0.f, 0.f};
                if (lin > 0) { hA = *(const PG8_LAS f32x4*)(tl + ((lin - 1) * 2 + 1) * 128 + colw + 4 * n); hB = *(const PG8_LAS f32x4*)(tl + ((lin - 1) * 2 + 0) * 128 + colw + 4 * n); }
#pragma unroll
                for (int m = 0; m < 4; ++m) {
                    float hv[4], cv[4];
#pragma unroll
                    for (int e = 0; e < 4; ++e) {
                        const float G = acc[ai][0][m][n][e];
                        float X, Y;
                        if (m == 0) { X = hA[e]; Y = (fr == 0) ? hB[e] : hA[e]; }
                        else { const float Gp = acc[ai][0][m - 1][n][e]; X = lane_get(Gp, l15); Y = lane_get(Gp, l14f); }
                        const float s1 = dpp_shr1(G), s2 = dpp_shr2(G);
                        const float p1 = (fr >= 1) ? s1 : X, p2 = (fr >= 2) ? s2 : Y;
                        const float c = bb[e] + w0[e] * p2 + w1[e] * p1 + w2[e] * G;
                        cv[e] = c;
                        hv[e] = c * sigmoidf_(c) * acc[ai][1][m][n][e];
                    }
                    const size_t row = (size_t)(u.pm * BM + ai * HALF + wr * 64 + m * 16 + fr);
                    typedef unsigned u32x2 __attribute__((ext_vector_type(2)));
                    u32x2 w; w.x = cvt_pk_bf16(hv[0], hv[1]); w.y = cvt_pk_bf16(hv[2], hv[3]);
                    *(u32x2*)(H + row * 2816 + hc0 + 4 * n) = w;
                    if (ai == 0 && m == 0 && wr == 0 && fr < 2) {
                        *(f32x4*)(HP + ((size_t)u.pm * 2 + fr) * 2816 + hc0 + 4 * n) = (f32x4){cv[0], cv[1], cv[2], cv[3]};
                        *(f32x4*)(HU + ((size_t)u.pm * 2 + fr) * 2816 + hc0 + 4 * n) = acc[0][1][0][n];
                    }
                }
            }
        }
    }
};

template <class Epi, class Sched, bool ALIGN_EPI = false, bool SP2 = false>
__device__ __forceinline__ void gemm_phase(PG8_LAS unsigned char* lds, const Gemm g, const Sched& S, const Epi& E) {
    int tid_ = threadIdx.x; asm volatile("" : "+v"(tid_)); const int tid = tid_, wid = __builtin_amdgcn_readfirstlane(tid >> 6), lane = tid & 63, wr = wid >> 2, wc = wid & 3, fr = lane & 15, fq = lane >> 4;
    const int K = g.K, nt = K / BK;
    unsigned voffA[2], voffB[2];
#pragma unroll
    for (int i = 0; i < 2; ++i) { int R, C; stage_rc(tid * 16 + i * 8192, R, C); const int Rb = Epi::PERM ? ((R & ~31) + perm32(R & 31)) : R;
        voffA[i] = (unsigned)(R * g.lda + C) * 2u; voffB[i] = (unsigned)(Rb * K + C) * 2u; }
    const size_t kstep = (size_t)(BK * 2);
    const size_t hstepA = (size_t)HALF * g.lda * 2, hstepB = (size_t)HALF * K * 2;
    const size_t tstepA = 2 * hstepA, tstepB = 2 * hstepB;
    const unsigned ldsw = (unsigned)wid * 1024u;
    const int aoff = lds_byte(wr * 64 + fr, fq * 8), boff = lds_byte(wc * 32 + fr, fq * 8);
#define PG8_SA(b, h) (((b) * 2 + (h)) * HTB)
#define PG8_SB(b, h) ((4 + (b) * 2 + (h)) * HTB)
#define PG8_STAGE(bufoff, gbase, voff) do { _Pragma("unroll") for (int _i = 0; _i < 2; ++_i) \
        __builtin_amdgcn_global_load_lds((const unsigned*)((const char*)(gbase) + (voff)[_i]), (PG8_LAS unsigned*)(lds + (bufoff) + ldsw + _i * 8192), 16, 0, 0); } while (0)
#define PG8_LDA(dst, b, h) do { _Pragma("unroll") for (int m = 0; m < 4; ++m) _Pragma("unroll") for (int k = 0; k < 2; ++k) dst[m][k] = *(const PG8_LAS bf16x8*)(lds + PG8_SA(b, h) + aoff + m * 2048 + k * 1024); } while (0)
#define PG8_LDB(dst, b, h) do { _Pragma("unroll") for (int n = 0; n < 2; ++n) _Pragma("unroll") for (int k = 0; k < 2; ++k) dst[n][k] = *(const PG8_LAS bf16x8*)(lds + PG8_SB(b, h) + boff + n * 2048 + k * 1024); } while (0)
#define PG8_MMA(ai, bj, At, Bt) do { __builtin_amdgcn_s_setprio(1); _Pragma("unroll") for (int m = 0; m < 4; ++m) _Pragma("unroll") for (int n = 0; n < 2; ++n) _Pragma("unroll") for (int k = 0; k < 2; ++k) \
        acc[ai][bj][m][n] = __builtin_amdgcn_mfma_f32_16x16x32_bf16(Bt[n][k], At[m][k], acc[ai][bj][m][n], 0, 0, 0); __builtin_amdgcn_s_setprio(0); } while (0)
#define PG8_WAIT_V(n) asm volatile("s_waitcnt vmcnt(" #n ")" ::: "memory")
#define PG8_WAIT_L(n) asm volatile("s_waitcnt lgkmcnt(" #n ")" ::: "memory")
#define PG8_BAR __builtin_amdgcn_s_barrier()
#define PG8_SCHED __builtin_amdgcn_sched_barrier(0)
    Unit cur, nxt; int ui = 0;
    if (!S.next(0, cur)) return;
    f32x4 acc[2][2][4][2];
#pragma unroll
    for (int a = 0; a < 2; ++a)
#pragma unroll
        for (int b = 0; b < 2; ++b)
#pragma unroll
            for (int m = 0; m < 4; ++m)
#pragma unroll
                for (int n = 0; n < 2; ++n) acc[a][b][m][n] = (f32x4){0.f, 0.f, 0.f, 0.f};
    bf16x8 At[4][2], B0[2][2], B1[2][2];
    const char* cA = (const char*)g.A + (size_t)cur.pm * tstepA; const char* cB = (const char*)g.Bt + (size_t)cur.pn * tstepB;
    S.a_ready(cur);
    if constexpr (SP2) {
        PG8_STAGE(PG8_SB(0, 0), cB, voffB); PG8_STAGE(PG8_SB(0, 1), cB + hstepB, voffB); PG8_STAGE(PG8_SA(0, 0), cA, voffA); PG8_STAGE(PG8_SA(0, 1), cA + hstepA, voffA);
        if (wr == 1) PG8_BAR;
        PG8_WAIT_V(2); PG8_BAR;
        PG8_STAGE(PG8_SB(1, 0), cB + kstep, voffB); PG8_STAGE(PG8_SA(1, 0), cA + kstep, voffA); PG8_STAGE(PG8_SB(1, 1), cB + hstepB + kstep, voffB);
        PG8_WAIT_V(6); PG8_BAR;
    } else {
        PG8_STAGE(PG8_SB(0, 0), cB, voffB); PG8_STAGE(PG8_SA(0, 0), cA, voffA); PG8_STAGE(PG8_SB(0, 1), cB + hstepB, voffB); PG8_STAGE(PG8_SA(0, 1), cA + hstepA, voffA);
        if (wr == 1) PG8_BAR;
        PG8_WAIT_V(4); PG8_BAR;
        PG8_STAGE(PG8_SB(1, 0), cB + kstep, voffB); PG8_STAGE(PG8_SA(1, 0), cA + kstep, voffA); PG8_STAGE(PG8_SB(1, 1), cB + hstepB + kstep, voffB);
        PG8_WAIT_V(6); PG8_BAR;
    }
    for (;;) {
        const bool has_next = S.next(ui + 1, nxt);
        const char* nA = has_next ? (const char*)g.A + (size_t)nxt.pm * tstepA : cA; const char* nB = has_next ? (const char*)g.Bt + (size_t)nxt.pn * tstepB : cB;
        for (int t = 0; t < nt; t += 2) {
            const bool last = (t == nt - 2);
            const char* a1 = cA + (size_t)(t + 1) * kstep;
            const char* a2 = last ? nA : cA + (size_t)(t + 2) * kstep; const char* b2 = last ? nB : cB + (size_t)(t + 2) * kstep;
            const char* a3 = a2 + kstep; const char* b3 = b2 + kstep;
            if (last && has_next) S.a_ready(nxt);
            if constexpr (SP2) {
            PG8_LDB(B0, 0, 0); PG8_LDB(B1, 0, 1); PG8_SCHED; PG8_LDA(At, 0, 0); PG8_STAGE(PG8_SA(1, 1), a1 + hstepA, voffA);
            PG8_WAIT_V(8); PG8_WAIT_L(0); PG8_BAR; PG8_MMA(0, 0, At, B0); PG8_MMA(0, 1, At, B1); PG8_BAR; PG8_SCHED;
            PG8_LDA(At, 0, 1); PG8_STAGE(PG8_SB(0, 0), b2, voffB); PG8_STAGE(PG8_SB(0, 1), b2 + hstepB, voffB); PG8_STAGE(PG8_SA(0, 0), a2, voffA);
            PG8_WAIT_V(8); PG8_WAIT_L(0); PG8_BAR; PG8_MMA(1, 0, At, B0); PG8_MMA(1, 1, At, B1); PG8_BAR; PG8_SCHED;
            PG8_LDB(B0, 1, 0); PG8_LDB(B1, 1, 1); PG8_SCHED; PG8_LDA(At, 1, 0); PG8_STAGE(PG8_SA(0, 1), a2 + hstepA, voffA);
            PG8_WAIT_V(8); PG8_WAIT_L(0); PG8_BAR; PG8_MMA(0, 0, At, B0); PG8_MMA(0, 1, At, B1); PG8_BAR; PG8_SCHED;
            PG8_LDA(At, 1, 1); PG8_STAGE(PG8_SB(1, 0), b3, voffB); PG8_STAGE(PG8_SB(1, 1), b3 + hstepB, voffB); PG8_STAGE(PG8_SA(1, 0), a3, voffA);
            PG8_WAIT_V(8); PG8_WAIT_L(0); PG8_BAR; PG8_MMA(1, 0, At, B0); PG8_MMA(1, 1, At, B1); PG8_BAR; PG8_SCHED;
            } else {
            PG8_LDB(B0, 0, 0); PG8_SCHED; PG8_LDA(At, 0, 0); PG8_STAGE(PG8_SA(1, 1), a1 + hstepA, voffA);
            PG8_WAIT_L(8); PG8_BAR; PG8_WAIT_L(0); PG8_MMA(0, 0, At, B0); PG8_BAR; PG8_SCHED;
            PG8_LDB(B1, 0, 1); PG8_STAGE(PG8_SB(0, 0), b2, voffB);
            PG8_BAR; PG8_WAIT_L(0); PG8_MMA(0, 1, At, B1); PG8_BAR;
            PG8_LDA(At, 0, 1); PG8_STAGE(PG8_SA(0, 0), a2, voffA);
            PG8_BAR; PG8_WAIT_L(0); PG8_MMA(1, 0, At, B0); PG8_BAR; PG8_SCHED;
            PG8_STAGE(PG8_SB(0, 1), b2 + hstepB, voffB);
            PG8_WAIT_V(6); PG8_BAR; PG8_MMA(1, 1, At, B1); PG8_BAR;
            PG8_LDB(B0, 1, 0); PG8_SCHED; PG8_LDA(At, 1, 0); PG8_STAGE(PG8_SA(0, 1), a2 + hstepA, voffA);
            PG8_WAIT_L(8); PG8_BAR; PG8_WAIT_L(0); PG8_MMA(0, 0, At, B0); PG8_BAR; PG8_SCHED;
            PG8_LDB(B1, 1, 1); PG8_STAGE(PG8_SB(1, 0), b3, voffB);
            PG8_BAR; PG8_WAIT_L(0); PG8_MMA(0, 1, At, B1); PG8_BAR;
            PG8_LDA(At, 1, 1); PG8_STAGE(PG8_SA(1, 0), a3, voffA);
            PG8_BAR; PG8_WAIT_L(0); PG8_MMA(1, 0, At, B0); PG8_BAR; PG8_SCHED;
            PG8_STAGE(PG8_SB(1, 1), b3 + hstepB, voffB);
            PG8_WAIT_V(6); PG8_BAR; PG8_MMA(1, 1, At, B1); PG8_BAR;
            }
        }
        if constexpr (ALIGN_EPI) { if (wr == 0) PG8_BAR; }
        if constexpr (!Epi::AFTER_DRAIN) { E(acc, cur, wr, wc, fr, fq); S.done(cur); }
        if (!has_next) break;
#pragma unroll
        for (int a = 0; a < 2; ++a)
#pragma unroll
            for (int b = 0; b < 2; ++b)
#pragma unroll
                for (int m = 0; m < 4; ++m)
#pragma unroll
                    for (int n = 0; n < 2; ++n) acc[a][b][m][n] = (f32x4){0.f, 0.f, 0.f, 0.f};
        cur = nxt; cA = nA; cB = nB; ++ui;
        if constexpr (ALIGN_EPI) { if (wr == 1) PG8_BAR; }
    }
    PG8_WAIT_V(0);
    if constexpr (!ALIGN_EPI) { if (wr == 0) PG8_BAR; }
    PG8_BAR;
    if constexpr (Epi::AFTER_DRAIN) { E.fused(acc, cur, wr, wc, fr, fq, lds, wid, lane); S.done(cur); }
#undef PG8_SA
#undef PG8_SB
#undef PG8_STAGE
#undef PG8_LDA
#undef PG8_LDB
#undef PG8_MMA
#undef PG8_WAIT_V
#undef PG8_WAIT_L
#undef PG8_BAR
#undef PG8_SCHED
}

}

namespace attn_body {
using bf16=__hip_bfloat16;
using bf16x8=__attribute__((ext_vector_type(8)))short;
using s16x4=__attribute__((ext_vector_type(4)))short;
using f32x16=__attribute__((ext_vector_type(16)))float;
using u32x4=__attribute__((ext_vector_type(4)))unsigned;
constexpr int BATCH=8,NHEAD=8,SEQ=8192,D=64,DM=4352;
constexpr int NW=8,QBLK=32,QB=QBLK*NW,KVBLK=64,NQB=SEQ/QB;
constexpr int ATTN_PITCH=DM, ATTN_UNIT_ROWS=QB;
__device__ __forceinline__ int crow(int r,int hi){return (r&3)+8*(r>>2)+4*hi;}
#define SBAR() __builtin_amdgcn_sched_barrier(0)
__device__ __forceinline__ void cmask(f32x16&p0,f32x16&p1,int jb,int qrel,int hi){
  const float NEG=-INFINITY; int kb=64*jb+4*hi;
  #pragma unroll
  for(int r=0;r<16;++r){int kv=kb+(r&3)+8*(r>>2); if(kv>qrel)p0[r]=NEG; if(kv+32>qrel)p1[r]=NEG;}
}

constexpr int NSLOT=3, SLOTB=8192;
constexpr int LDS_K=0, LDS_V=NSLOT*SLOTB, LDS_WS=2*NSLOT*SLOTB, LDS_OST=LDS_WS+NW*64*4, LDS_BYTES=LDS_OST+NW*4096;
constexpr int LDS_CB=LDS_BYTES;
constexpr float C2=0.125f*1.4426950408889634f;
__device__ __forceinline__ void glds16(const void*gsrc,unsigned lds_dst){unsigned keep;
  asm volatile("s_mov_b32 %0, m0\n\ts_mov_b32 m0, %2\n\ts_nop 0\n\tglobal_load_lds_dwordx4 %1, off\n\ts_mov_b32 m0, %0":"=&s"(keep):"v"(gsrc),"s"(lds_dst):"memory");}
__device__ __forceinline__ float max3f(float a,float b,float c){float r;asm("v_max3_f32 %0, %1, %2, %3":"=v"(r):"v"(a),"v"(b),"v"(c));return r;}
__device__ __forceinline__ float max2f(float a,float b){float r;asm("v_max_f32_e32 %0, %1, %2":"=v"(r):"v"(a),"v"(b));return r;}
__device__ __forceinline__ float fadd_s(float a,float b){float r;asm("v_add_f32_e32 %0, %1, %2":"=v"(r):"v"(a),"v"(b));return r;}
__device__ __forceinline__ float fsub_s(float a,float b){float r;asm("v_sub_f32_e32 %0, %1, %2":"=v"(r):"v"(a),"v"(b));return r;}
typedef float f32x2_t __attribute__((ext_vector_type(2))); typedef __bf16 bf16x2_t __attribute__((ext_vector_type(2)));
__device__ __forceinline__ unsigned cvtpk_s(float lo,float hi){f32x2_t v={lo,hi};bf16x2_t b=__builtin_convertvector(v,bf16x2_t);return __builtin_bit_cast(unsigned,b);}
#define WAIT_BAR(N) asm volatile("s_waitcnt vmcnt(" #N ") lgkmcnt(0)\n\ts_barrier":::"memory")

__device__ __forceinline__ void qkt(f32x16&p0,f32x16&p1,const char*Kslot,const bf16x8*qr,const f32x16&negm,int r32,int hi){
  const char*kb=Kslot+hi*1024+r32*16;
  #pragma unroll
  for(int d0=0;d0<4;++d0){
    const bf16x8 b0=*reinterpret_cast<const bf16x8*>(kb+d0*2048);
    const bf16x8 b1=*reinterpret_cast<const bf16x8*>(kb+d0*2048+512);
    if(d0==0){p0=__builtin_amdgcn_mfma_f32_32x32x16_bf16(b0,qr[0],negm,0,0,0);p1=__builtin_amdgcn_mfma_f32_32x32x16_bf16(b1,qr[0],negm,0,0,0);}
    else{p0=__builtin_amdgcn_mfma_f32_32x32x16_bf16(b0,qr[d0],p0,0,0,0);p1=__builtin_amdgcn_mfma_f32_32x32x16_bf16(b1,qr[d0],p1,0,0,0);}}
}
typedef __attribute__((address_space(3))) const char* lds_cptr;
typedef short v4i16_t __attribute__((ext_vector_type(4)));
__device__ __forceinline__ void kload8(bf16x8*kf,lds_cptr kp){
  kf[0]=*(const __attribute__((address_space(3))) bf16x8*)(kp);      kf[1]=*(const __attribute__((address_space(3))) bf16x8*)(kp+512);
  kf[2]=*(const __attribute__((address_space(3))) bf16x8*)(kp+2048); kf[3]=*(const __attribute__((address_space(3))) bf16x8*)(kp+2560);
  kf[4]=*(const __attribute__((address_space(3))) bf16x8*)(kp+4096); kf[5]=*(const __attribute__((address_space(3))) bf16x8*)(kp+4608);
  kf[6]=*(const __attribute__((address_space(3))) bf16x8*)(kp+6144); kf[7]=*(const __attribute__((address_space(3))) bf16x8*)(kp+6656);
}
__device__ __forceinline__ void kload2(bf16x8*kf,lds_cptr kp,int j){ kf[2*j]=*(const __attribute__((address_space(3))) bf16x8*)(kp+j*2048); kf[2*j+1]=*(const __attribute__((address_space(3))) bf16x8*)(kp+j*2048+512); }
__device__ __forceinline__ s16x4 vtr(lds_cptr p){ return __builtin_bit_cast(s16x4,__builtin_amdgcn_ds_read_tr16_b64_v4i16((__attribute__((address_space(3))) v4i16_t*)p)); }
__device__ __forceinline__ float rowmax(const f32x16&p0,const f32x16&p1){
  float a=max3f(p0[0],p0[1],p1[0]),b=max3f(p0[2],p0[3],p1[1]);a=max3f(a,p1[2],p1[3]);
  #pragma unroll
  for(int r=4;r<16;r+=4){a=max3f(a,p0[r],p0[r+1]);b=max3f(b,p0[r+2],p0[r+3]);a=max3f(a,p1[r],p1[r+1]);b=max3f(b,p1[r+2],p1[r+3]);}
  const float m=max2f(a,b);
  auto rr=__builtin_amdgcn_permlane32_swap(__float_as_uint(m),__float_as_uint(m),false,false);
  return max2f(__uint_as_float(rr[0]),__uint_as_float(rr[1]));
}
__device__ __forceinline__ void pv(f32x16*o,int vb,bf16x8 pa0,bf16x8 pa1,bf16x8 pa2,bf16x8 pa3){
  #pragma unroll
  for(int d0=0;d0<2;++d0){s16x4 lo[4],hi[4];
    #pragma unroll
    for(int ks=0;ks<4;++ks){
      asm volatile("ds_read_b64_tr_b16 %0,%1 offset:%c2":"=&v"(lo[ks]):"v"(vb),"i"(d0*4096+ks*1024):"memory");
      asm volatile("ds_read_b64_tr_b16 %0,%1 offset:%c2":"=&v"(hi[ks]):"v"(vb),"i"(d0*4096+ks*1024+512):"memory");}
    asm volatile("s_waitcnt lgkmcnt(0)":::"memory");SBAR();
    #define PK(k) (bf16x8){lo[k][0],lo[k][1],lo[k][2],lo[k][3],hi[k][0],hi[k][1],hi[k][2],hi[k][3]}
    o[d0]=__builtin_amdgcn_mfma_f32_32x32x16_bf16(pa0,PK(0),o[d0],0,0,0);
    o[d0]=__builtin_amdgcn_mfma_f32_32x32x16_bf16(pa1,PK(1),o[d0],0,0,0);
    o[d0]=__builtin_amdgcn_mfma_f32_32x32x16_bf16(pa2,PK(2),o[d0],0,0,0);
    o[d0]=__builtin_amdgcn_mfma_f32_32x32x16_bf16(pa3,PK(3),o[d0],0,0,0);
    #undef PK
  }
}

#ifndef ATTN_STORE16
#define ATTN_STORE16(p,v) (*(u32x4*)(p)=(v))
#endif
template<int THRL> __device__ __forceinline__ void attn_unit(int b,int h,int qb,const bf16*Q,const bf16*__restrict__ K,const bf16*__restrict__ V,bf16*O,const float*__restrict__ cl,const float*__restrict__ tot,char*shm){
  int tid_=threadIdx.x; asm volatile("":"+v"(tid_)); const int tid=tid_,lane=tid&63,r32=lane&31,hi=lane>>5; const int wid=__builtin_amdgcn_readfirstlane(tid>>6);
  const long rowbase=(long)b*SEQ; const int q0=qb*QB;
  const bf16*Qw=Q+(rowbase+q0+wid*QBLK)*DM+h*D;
  const bf16*Kh=K+rowbase*DM+h*D,*Vh=V+rowbase*DM+h*D;
  const unsigned lds0=(unsigned)(uintptr_t)shm;
  float*wsf=(float*)(shm+LDS_WS)+wid*64;
  const bf16*ksrc=Kh+(long)lane*DM+wid*8;
  const bf16*vsrc=Vh+(long)(16*(wid&3)+(lane>>2))*DM+(wid>>2)*32+(lane&3)*8;
  const unsigned kdst=lds0+LDS_K+wid*1024, vdst=lds0+LDS_V+wid*1024;
  #define DMA_K(t,slot) glds16(ksrc+(long)(t)*KVBLK*DM,(unsigned)__builtin_amdgcn_readfirstlane(kdst+(slot)))
  #define DMA_V(t,slot) glds16(vsrc+(long)(t)*KVBLK*DM,(unsigned)__builtin_amdgcn_readfirstlane(vdst+(slot)))
  const int vb0=(int)(lds0+LDS_V)+((lane>>4)&1)*32+(lane&3)*8+(4*hi+((lane&15)>>2))*64;
  const char*Kbase=shm+LDS_K; bf16x8 kf[8];
  const lds_cptr shm3=(lds_cptr)shm; const lds_cptr kp0=shm3+LDS_K+hi*1024+r32*16; const lds_cptr vp0=shm3+LDS_V+((lane>>4)&1)*32+(lane&3)*8+(4*hi+((lane&15)>>2))*64;
  const int NT=(q0+QB)/KVBLK;

  typedef float f32x4_t __attribute__((ext_vector_type(4)));
  {
    const int j_=tid>>4; float Pj=0.f,Pq=0.f;
    for(int i=0;i<qb;++i){const float t_=tot[((b*32+i)*8)+h];Pq+=t_; if(i<j_)Pj+=t_;}
    const float*clh=cl+(size_t)(b*NHEAD+h)*SEQ;
    const float cref=clh[q0]+Pq;
    if(16*tid<q0+QB){
      __attribute__((address_space(3))) f32x4_t*dst=(__attribute__((address_space(3))) f32x4_t*)((__attribute__((address_space(3))) char*)shm+LDS_CB)+4*tid;
      #pragma unroll
      for(int c_=0;c_<4;++c_){ f32x4_t v_=*(const f32x4_t*)(clh+16*tid+4*c_); v_=(cref-(v_+Pj))*1.4426950408889634f; dst[c_]=v_; }
    }
  }
  #define CBIAS(P0,P1,t) do{ const lds_cptr cb_=shm3+LDS_CB+(t)*256+hi*16; \
    _Pragma("unroll") for(int j_=0;j_<4;++j_){ SBAR(); const f32x4_t b0_=*(const __attribute__((address_space(3))) f32x4_t*)(cb_+j_*32)-mhat; const f32x4_t b1_=*(const __attribute__((address_space(3))) f32x4_t*)(cb_+128+j_*32)-mhat; \
      P0[4*j_]+=b0_[0];P0[4*j_+1]+=b0_[1];P0[4*j_+2]+=b0_[2];P0[4*j_+3]+=b0_[3]; P1[4*j_]+=b1_[0];P1[4*j_+1]+=b1_[1];P1[4*j_+2]+=b1_[2];P1[4*j_+3]+=b1_[3]; } }while(0)
  DMA_K(0,0);DMA_V(0,0);DMA_K(1,SLOTB);
  bf16x8 qr[4];
  #pragma unroll
  for(int d0=0;d0<4;++d0)qr[d0]=*reinterpret_cast<const bf16x8*>(&Qw[(long)r32*DM+d0*16+hi*8]);
  float mhat=0.f,l_reg=0.f;f32x16 o[2];o[0]=f32x16{};o[1]=f32x16{};const f32x16 negm=f32x16{};
  const int qrel=wid*QBLK+r32;
  #define CMASK(P0,P1,t) do{int jb_=(t)-(NT-4); if(jb_>=0)cmask(P0,P1,jb_,qrel,hi);}while(0)
  bool resc=false;
  #define START(P0,P1) do{ const float rm=rowmax(P0,P1); resc=false; \
    { const float dl=rm; mhat=fadd_s(mhat,dl); \
      _Pragma("unroll") for(int r=0;r<16;++r){P0[r]=fsub_s(P0[r],dl);P1[r]=fsub_s(P1[r],dl);} \
       } \
    _Pragma("unroll") for(int r=0;r<16;++r)P0[r]=__builtin_amdgcn_exp2f(P0[r]); }while(0)
  #define RESC() do{ if(resc){ asm volatile("s_waitcnt lgkmcnt(0)":::"memory"); \
      _Pragma("unroll") for(int d_=0;d_<2;++d_) _Pragma("unroll") for(int r=0;r<16;++r)o[d_][r]*=wsf[crow(r,hi)]; } }while(0)
  f32x16 pA0,pA1,pB0,pB1;
  int sl_prev=0,sl_cur=0,sl_next=SLOTB;
  #define ROT() do{sl_prev=sl_cur;sl_cur=sl_next;sl_next=(sl_next==(NSLOT-1)*SLOTB)?0:sl_next+SLOTB;}while(0)
  DMA_K(2,2*SLOTB);
  WAIT_BAR(3);
  qkt(pA0,pA1,Kbase,qr,negm,r32,hi);asm volatile("s_nop 15\n\ts_nop 7":"+v"(pA0),"+v"(pA1));CMASK(pA0,pA1,0);CBIAS(pA0,pA1,0);
  START(pA0,pA1);
  _Pragma("unroll") for(int r=0;r<16;++r)pA1[r]=__builtin_amdgcn_exp2f(pA1[r]);
  WAIT_BAR(0);
  DMA_K(3,0);DMA_V(1,SLOTB);
  ROT();
  kload8(kf,kp0+sl_cur);
  WAIT_BAR(2);
  s16x4 vlo[8],vhi[8]; u32x4 pw0,pw1,pw2,pw3;
  #define PKW(P,B) cvtpk_s(P[B],P[B+1])
  #define PAF(k) __builtin_bit_cast(bf16x8,pw##k)
  #define VFR(i) (bf16x8){vlo[i][0],vlo[i][1],vlo[i][2],vlo[i][3],vhi[i][0],vhi[i][1],vhi[i][2],vhi[i][3]}
  #define PIN(x) asm volatile("":"+v"(x))
  #define MX3(a,b,c) __builtin_fmaxf(__builtin_fmaxf((a),(b)),(c))
  #define GAPA(MF,A0,A1,A2,A3,W0,W1,PW) do{ MF; sacc+=A0; sacc+=A1; sacc+=A2; sacc+=A3; PIN(sacc); W0; W1; PIN(PW); SBAR(); }while(0)
  #define EX(v) __builtin_amdgcn_exp2f(v)
  #define GAPB(MF,X,B) do{ MF; X[B]=EX(X[B]); X[B+1]=EX(X[B+1]); X[B+2]=EX(X[B+2]); X[B+3]=EX(X[B+3]); PIN(X); SBAR(); }while(0)
  #define VRD(i) do{ vlo[i]=vtr(vp_+(((i)>>2)*4096+((i)&3)*1024)); vhi[i]=vtr(vp_+(((i)>>2)*4096+((i)&3)*1024+512)); }while(0)
  #define KRD(G,j) do{ if(G){ kload2(kf,kp0+sl_next,j); SBAR(); } }while(0)
  #define STEP(C0,C1,P0,P1,t,GK,GV,GL) do{ SBAR(); \
    const lds_cptr vp_=vp0+sl_prev; \
    VRD(0); SBAR(); float sacc=(P0[0]+P0[1]); \
    GAPA(C0=__builtin_amdgcn_mfma_f32_32x32x16_bf16(kf[0],qr[0],negm,0,0,0), P0[2],P0[3],P0[4],P0[5],     pw0[0]=PKW(P0,0), pw0[1]=PKW(P0,2), pw0); \
    VRD(4); SBAR(); GAPA(C1=__builtin_amdgcn_mfma_f32_32x32x16_bf16(kf[1],qr[0],negm,0,0,0), P0[6],P0[7],P0[8],P0[9],     pw0[2]=PKW(P0,4), pw0[3]=PKW(P0,6), pw0); \
    VRD(1); SBAR(); GAPA(C0=__builtin_amdgcn_mfma_f32_32x32x16_bf16(kf[2],qr[1],C0,0,0,0),   P0[10],P0[11],P0[12],P0[13], pw1[0]=PKW(P0,8), pw1[1]=PKW(P0,10), pw1); \
    VRD(5); SBAR(); GAPA(C1=__builtin_amdgcn_mfma_f32_32x32x16_bf16(kf[3],qr[1],C1,0,0,0),   P0[14],P0[15],P1[0],P1[1],   pw1[2]=PKW(P0,12),pw1[3]=PKW(P0,14), pw1); \
    VRD(2); SBAR(); GAPA(C0=__builtin_amdgcn_mfma_f32_32x32x16_bf16(kf[4],qr[2],C0,0,0,0),   P1[2],P1[3],P1[4],P1[5],     pw2[0]=PKW(P1,0), pw2[1]=PKW(P1,2), pw2); \
    VRD(6); SBAR(); GAPA(C1=__builtin_amdgcn_mfma_f32_32x32x16_bf16(kf[5],qr[2],C1,0,0,0),   P1[6],P1[7],P1[8],P1[9],     pw2[2]=PKW(P1,4), pw2[3]=PKW(P1,6), pw2); \
    VRD(3); SBAR(); GAPA(C0=__builtin_amdgcn_mfma_f32_32x32x16_bf16(kf[6],qr[3],C0,0,0,0),   P1[10],P1[11],P1[12],P1[13], pw3[0]=PKW(P1,8), pw3[1]=PKW(P1,10), pw3); \
    VRD(7); SBAR(); GAPA(C1=__builtin_amdgcn_mfma_f32_32x32x16_bf16(kf[7],qr[3],C1,0,0,0),   P1[14],P1[15],0.f,0.f,       pw3[2]=PKW(P1,12),pw3[3]=PKW(P1,14), pw3); \
    l_reg+=sacc; \
    if(GK){DMA_K((t)+3,sl_cur);} if(GV){DMA_V((t)+1,sl_next);} \
    CMASK(C0,C1,t); CBIAS(C0,C1,t); \
    { float a=MX3(C0[0],C0[1],C1[0]),b=MX3(C0[2],C0[3],C1[1]); a=MX3(a,C1[2],C1[3]); \
      _Pragma("unroll") for(int r=4;r<16;r+=4){a=MX3(a,C0[r],C0[r+1]);b=MX3(b,C0[r+2],C0[r+3]);a=MX3(a,C1[r],C1[r+1]);b=MX3(b,C1[r+2],C1[r+3]);} \
      float rm=__builtin_fmaxf(a,b); { auto rr=__builtin_amdgcn_permlane32_swap(__float_as_uint(rm),__float_as_uint(rm),false,false); rm=__builtin_fmaxf(__uint_as_float(rr[0]),__uint_as_float(rr[1])); } \
      resc=false; \
      if(__builtin_expect(__any(rm>(float)THRL),0)){ const float dl=__builtin_fmaxf(rm,0.f); mhat+=dl; \
        _Pragma("unroll") for(int r=0;r<16;++r){C0[r]-=dl;C1[r]-=dl;} \
         \
        const float f=__builtin_amdgcn_exp2f(-dl); l_reg*=f; if(hi==0)wsf[r32]=f; resc=true; } } \
    SBAR(); \
    GAPB(o[0]=__builtin_amdgcn_mfma_f32_32x32x16_bf16(PAF(0),VFR(0),o[0],0,0,0), C0,0); \
    GAPB(o[1]=__builtin_amdgcn_mfma_f32_32x32x16_bf16(PAF(0),VFR(4),o[1],0,0,0), C0,4); \
    KRD(GL,0); GAPB(o[0]=__builtin_amdgcn_mfma_f32_32x32x16_bf16(PAF(1),VFR(1),o[0],0,0,0), C0,8); \
    KRD(GL,1); GAPB(o[1]=__builtin_amdgcn_mfma_f32_32x32x16_bf16(PAF(1),VFR(5),o[1],0,0,0), C0,12); \
    KRD(GL,2); GAPB(o[0]=__builtin_amdgcn_mfma_f32_32x32x16_bf16(PAF(2),VFR(2),o[0],0,0,0), C1,0); \
    KRD(GL,3); GAPB(o[1]=__builtin_amdgcn_mfma_f32_32x32x16_bf16(PAF(2),VFR(6),o[1],0,0,0), C1,4); \
    GAPB(o[0]=__builtin_amdgcn_mfma_f32_32x32x16_bf16(PAF(3),VFR(3),o[0],0,0,0), C1,8); \
    GAPB(o[1]=__builtin_amdgcn_mfma_f32_32x32x16_bf16(PAF(3),VFR(7),o[1],0,0,0), C1,12); \
    }while(0)
  int t=1;
  #undef CMASK
  #define CMASK(P0,P1,t) do{}while(0)
  for(;t+5<NT;t+=2){
    STEP(pB0,pB1,pA0,pA1,t,true,true,true);     WAIT_BAR(2); RESC(); ROT();
    STEP(pA0,pA1,pB0,pB1,t+1,true,true,true);   WAIT_BAR(2); RESC(); ROT();
  }
  #undef CMASK
  #define CMASK(P0,P1,t) do{int jb_=(t)-(NT-4); if(jb_>=0)cmask(P0,P1,jb_,qrel,hi);}while(0)
  #define ENDW(tt) do{ if((tt)+3<NT){WAIT_BAR(2);} else if((tt)+2<NT){WAIT_BAR(1);} else {WAIT_BAR(0);} }while(0)
  for(;t+1<NT;t+=2){
    STEP(pB0,pB1,pA0,pA1,t,(t+3<NT),(t+1<NT),(t+1<NT));       ENDW(t);   RESC(); ROT();
    STEP(pA0,pA1,pB0,pB1,t+1,(t+4<NT),(t+2<NT),(t+2<NT));     ENDW(t+1); RESC(); ROT();
  }
  STEP(pB0,pB1,pA0,pA1,NT-1,false,false,false); RESC();
  { float sacc=pB0[0]+pB0[1]; _Pragma("unroll") for(int r=2;r<16;++r)sacc+=pB0[r]; _Pragma("unroll") for(int r=0;r<16;++r)sacc+=pB1[r]; l_reg+=sacc;
    pw0=(u32x4){PKW(pB0,0),PKW(pB0,2),PKW(pB0,4),PKW(pB0,6)};pw1=(u32x4){PKW(pB0,8),PKW(pB0,10),PKW(pB0,12),PKW(pB0,14)};pw2=(u32x4){PKW(pB1,0),PKW(pB1,2),PKW(pB1,4),PKW(pB1,6)};pw3=(u32x4){PKW(pB1,8),PKW(pB1,10),PKW(pB1,12),PKW(pB1,14)};
    SBAR(); pv(o,vb0+sl_cur,PAF(0),PAF(1),PAF(2),PAF(3)); }
  #undef PKW
  #undef PAF
  #undef VFR
  #undef PIN
  #undef MX3
  #undef GAPA
  #undef GAPB
  #undef EX
  #undef VRD
  #undef KRD
  #undef STEP
  #undef ENDW
  {auto rr=__builtin_amdgcn_permlane32_swap(__float_as_uint(l_reg),__float_as_uint(l_reg),false,false);l_reg=__uint_as_float(rr[0])+__uint_as_float(rr[1]);}
  if(hi==0)wsf[32+r32]=l_reg;asm volatile("s_waitcnt lgkmcnt(0)":::"memory");
  float rli[16];
  #pragma unroll
  for(int r=0;r<16;++r)rli[r]=__builtin_amdgcn_rcpf(wsf[32+crow(r,hi)]);
  bf16*Ow=O+(rowbase+q0+wid*QBLK)*DM+h*D;
  { bf16*stg=(bf16*)(shm+LDS_OST)+wid*2048;
    #pragma unroll
    for(int r=0;r<16;++r){const int orow=crow(r,hi);
      #pragma unroll
      for(int d0=0;d0<2;++d0)stg[orow*64+d0*32+r32]=__float2bfloat16(o[d0][r]*rli[r]);}
    asm volatile("s_waitcnt lgkmcnt(0)":::"memory");
    #pragma unroll
    for(int i=0;i<4;++i){const int row=i*8+(lane>>3),ch=lane&7; const u32x4 v=*(const u32x4*)(stg+row*64+ch*8); ATTN_STORE16(Ow+(long)row*DM+ch*8,v);} }
  asm volatile("s_waitcnt lgkmcnt(0)\n\ts_barrier":::"memory");
  #undef DMA_K
  #undef DMA_V
  #undef CMASK
  #undef CBIAS
  #undef START
  #undef RESC
  #undef ROT
}
constexpr int ATTN_LDS_BYTES=LDS_BYTES+32768;
#undef SBAR
#undef WAIT_BAR
}


constexpr int NB = 8, SEQ = 8192, DM = 1024, MROWS = NB * SEQ;
constexpr int DEPTH = 2, NIN = 4360, NZ = 4352, DFF = 2816;
constexpr float LN_EPS = 1e-5f;
constexpr float ALPHA = 1.4142135623730951f;
constexpr float LOG2E = 1.4426950408889634f;
constexpr float C2 = 0.125f * LOG2E;
constexpr int ZQA = 0, ZKA = 512, ZVA = 640, ZQB = 768, ZKB = 1280, ZVB = 1792, ZGA = 2304, ZGB = 3328;

constexpr size_t MiB = 1u << 20;
constexpr size_t W_IN_B = (size_t)NZ * 1024 * 2, W_PA_B = (size_t)1024 * 512 * 2, W_OUT_B = (size_t)1024 * 1024 * 2, W_FI_B = (size_t)5632 * 1024 * 2, W_FO_B = (size_t)1024 * 2816 * 2;
constexpr size_t WL_IN = 0, WL_PA = WL_IN + W_IN_B, WL_PB = WL_PA + W_PA_B, WL_OUT = WL_PB + W_PA_B, WL_FI = WL_OUT + W_OUT_B, WL_FO = WL_FI + W_FI_B, WL_BYTES = WL_FO + W_FO_B;
constexpr size_t WS_W = 1 * MiB;
constexpr size_t WS_CL = 64 * MiB;
constexpr size_t WS_TOT = 66 * MiB;
constexpr size_t WS_TAIL = 67 * MiB, WS_HP = 73 * MiB, WS_HU = 79 * MiB;
constexpr size_t WS_HB = 96 * MiB;
constexpr size_t WS_MG = 224 * MiB;
constexpr size_t WS_Z = 352 * MiB;
constexpr size_t WS_END = WS_Z + (size_t)MROWS * NZ * 2;
static_assert(WS_W + DEPTH * WL_BYTES <= WS_CL && WS_HU + 6 * MiB <= WS_HB, "d_ws map");
constexpr size_t ZPANEL_B = (size_t)256 * NZ * 2;

constexpr int RING_BYTES = 131072, TL_OFF = RING_BYTES, LDS_BYTES = 147456;
constexpr int NWAVES = 8;

#define GAS __attribute__((address_space(1)))
#define LAS __attribute__((address_space(3)))
typedef unsigned short bf16;
typedef unsigned v4u __attribute__((ext_vector_type(4)));
typedef unsigned v2u __attribute__((ext_vector_type(2)));
typedef float f32x4 __attribute__((ext_vector_type(4)));
typedef short bf16x8 __attribute__((ext_vector_type(8)));
typedef float f32x16 __attribute__((ext_vector_type(16)));
#define LDS_WAIT() asm volatile("s_waitcnt lgkmcnt(0)" ::: "memory")
__device__ __forceinline__ unsigned f2bf(float f) { unsigned u = __builtin_bit_cast(unsigned, f); return (u + 0x7fffu + ((u >> 16) & 1u)) >> 16; }
__device__ __forceinline__ unsigned pk2(float lo, float hi) { return f2bf(lo) | (f2bf(hi) << 16); }
__device__ __forceinline__ float wave_sum(float v) {
#pragma unroll
    for (int o = 1; o < 64; o <<= 1) v += __shfl_xor(v, o);
    return v;
}

__device__ __forceinline__ void transpose_item(const float* W, int ldw, int K, int k0, int src_col0, bf16* WT, int dst_row0, LAS float* scr, int lane) {
#pragma unroll 8
    for (int i = 0; i < 32; ++i) { const int kk = 2 * i + (lane >> 5); scr[kk * 33 + (lane & 31)] = W[(size_t)(k0 + kk) * ldw + src_col0 + (lane & 31)]; }
    LDS_WAIT(); asm volatile("" ::: "memory");
    const int c = lane & 7;
#pragma unroll
    for (int j = 0; j < 4; ++j) { const int n = (lane >> 3) + 8 * j; const LAS float* s = scr + (8 * c) * 33 + n;
        v4u o; o.x = pk2(s[0 * 33], s[1 * 33]); o.y = pk2(s[2 * 33], s[3 * 33]); o.z = pk2(s[4 * 33], s[5 * 33]); o.w = pk2(s[6 * 33], s[7 * 33]);
        *(GAS v4u*)(WT + (size_t)(dst_row0 + n) * K + k0 + 8 * c) = o; }
    LDS_WAIT(); asm volatile("" ::: "memory");
}

struct Args { const float* in[15]; float* out; unsigned char* ws; };

template <bool DO_LN, bool DO_F>
__device__ __forceinline__ void row_pass(LAS unsigned char* lds, int panel, const float* src, float* dstR, bf16* HB, const float* lg, const float* lb,
                                         const float* win_l, const float* bin_l, float* CL, float* TOT) {
    int tid_ = threadIdx.x; asm volatile("" : "+v"(tid_)); const int tid = tid_, lane = tid & 63, wave = __builtin_amdgcn_readfirstlane(tid >> 6);
    LAS float* lcl = (LAS float*)lds;
    LAS float* wtot = (LAS float*)(lds + 8192);
    f32x4 gv[4], bv[4];
    if (DO_LN) {
#pragma unroll
        for (int j = 0; j < 4; ++j) { gv[j] = *(const f32x4*)(lg + 256 * j + 4 * lane); bv[j] = *(const f32x4*)(lb + 256 * j + 4 * lane); }
    }
    for (int i = 0; i < 32; ++i) {
        const size_t row = (size_t)panel * 256 + wave * 32 + i;
        const GAS f32x4* xr = (const GAS f32x4*)(src + row * DM) + lane;
        f32x4 v[4]; float s = 0.f;
#pragma unroll
        for (int j = 0; j < 4; ++j) { v[j] = xr[64 * j]; s += (v[j].x + v[j].y) + (v[j].z + v[j].w); }
        if (DO_LN) {
            const float mean = wave_sum(s) * (1.f / DM); float s2 = 0.f;
#pragma unroll
            for (int j = 0; j < 4; ++j) { v[j] = v[j] - mean; s2 += (v[j].x * v[j].x + v[j].y * v[j].y) + (v[j].z * v[j].z + v[j].w * v[j].w); }
            const float rstd = 1.f / sqrtf(wave_sum(s2) * (1.f / DM) + LN_EPS);
            GAS f32x4* orow = (GAS f32x4*)(dstR + row * DM) + lane;
#pragma unroll
            for (int j = 0; j < 4; ++j) { v[j] = v[j] * rstd * gv[j] + bv[j]; orow[64 * j] = v[j]; }
        }
        GAS v2u* o8 = (GAS v2u*)(HB + row * DM) + lane;
#pragma unroll
        for (int j = 0; j < 4; ++j) { v2u w; w.x = pk2(v[j].x, v[j].y); w.y = pk2(v[j].z, v[j].w); o8[64 * j] = w; }
    }
    if (DO_F) {
        __syncthreads();
        const float* fsrc = DO_LN ? (const float*)dstR : src;
#pragma unroll 1
        for (int half = 0; half < 2; ++half) {
            f32x4 wfa[4][4]; float run = 0.f;
#pragma unroll
            for (int j = 0; j < 4; ++j)
#pragma unroll
                for (int e = 0; e < 4; ++e) wfa[j][e] = *(const f32x4*)(win_l + (size_t)(256 * j + 4 * lane + e) * NIN + 2304 + 4 * half);
            const float bf = bin_l[2304 + 4 * half + (lane & 3)];
            for (int i = 0; i < 32; ++i) {
                const size_t row = (size_t)panel * 256 + wave * 32 + i;
                const GAS f32x4* xr = (const GAS f32x4*)(fsrc + row * DM) + lane;
                f32x4 v[4];
#pragma unroll
                for (int j = 0; j < 4; ++j) v[j] = xr[64 * j];
                f32x4 pa = (f32x4){0.f, 0.f, 0.f, 0.f};
#pragma unroll
                for (int j = 0; j < 4; ++j) pa += wfa[j][0] * v[j].x + wfa[j][1] * v[j].y + wfa[j][2] * v[j].z + wfa[j][3] * v[j].w;
                float q[4] = {pa.x, pa.y, pa.z, pa.w};
#pragma unroll
                for (int h = 0; h < 4; ++h) q[h] = wave_sum(q[h]);
                float mine = q[0];
#pragma unroll
                for (int h = 1; h < 4; ++h) mine = ((lane & 3) == h) ? q[h] : mine;
                const float x = mine + bf;
                const float lf = fminf(x, 0.f) - log1pf(__expf(-fabsf(x)));
                run += lf;
                if (lane < 4) lcl[(wave * 32 + i) * 8 + 4 * half + lane] = run;
            }
            if (lane < 4) wtot[wave * 8 + 4 * half + lane] = run;
        }
        __syncthreads();
        const int b = panel >> 5, s0 = (panel & 31) * 256;
        for (int idx = tid; idx < 2048; idx += 512) { const int h = idx >> 8, r = idx & 255; float off = 0.f;
            for (int w = 0; w < (r >> 5); ++w) off += wtot[w * 8 + h];
            CL[((size_t)(b * 8 + h)) * SEQ + s0 + r] = lcl[r * 8 + h] + off; }
        if (tid < 8) { float t = 0.f; for (int w = 0; w < 8; ++w) t += wtot[w * 8 + tid]; TOT[panel * 8 + tid] = t; }
        __syncthreads();
    }
}

namespace swa {
constexpr int KSTR = 72, VSTR = 264;
constexpr int L_K = 0, L_VT = 256 * KSTR * 2, L_END = L_VT + 64 * VSTR * 2;
__device__ __forceinline__ int crow(int r, int hi) { return (r & 3) + 8 * (r >> 2) + 4 * hi; }
__device__ __forceinline__ void unit(int b, int hkv, int blk, bf16* Z, const float* sinks_l, LAS unsigned char* lds) {
    int tid_ = threadIdx.x; asm volatile("" : "+v"(tid_)); const int tid = tid_, lane = tid & 63, r32 = lane & 31, hi = lane >> 5; const int wid = __builtin_amdgcn_readfirstlane(tid >> 6);
    const size_t rowbase = (size_t)b * SEQ; const int k0 = blk * 128 - 128;
    {
        const int key = tid >> 1, half = tid & 1, kabs = k0 + key; const bool ok = kabs >= 0;
        const bf16* kp = Z + (rowbase + (ok ? kabs : 0)) * NZ + ZKA + hkv * 64 + 32 * half;
        const bf16* vp = Z + (rowbase + (ok ? kabs : 0)) * NZ + ZVA + hkv * 64 + 32 * half;
        v4u kv[4], vv[4];
#pragma unroll
        for (int c = 0; c < 4; ++c) { kv[c] = *(const GAS v4u*)(kp + 8 * c); vv[c] = *(const GAS v4u*)(vp + 8 * c); if (!ok) { kv[c] = (v4u){0u, 0u, 0u, 0u}; vv[c] = (v4u){0u, 0u, 0u, 0u}; } }
        LAS bf16* KL = (LAS bf16*)(lds + L_K); LAS bf16* VT = (LAS bf16*)(lds + L_VT);
#pragma unroll
        for (int c = 0; c < 4; ++c) {
            *(LAS v4u*)(KL + key * KSTR + 32 * half + 8 * c) = kv[c];
            const unsigned w[4] = {vv[c].x, vv[c].y, vv[c].z, vv[c].w};
#pragma unroll
            for (int e = 0; e < 4; ++e) { const int d = 32 * half + 8 * c + 2 * e; VT[d * VSTR + key] = (bf16)(w[e] & 0xffffu); VT[(d + 1) * VSTR + key] = (bf16)(w[e] >> 16); }
        }
    }
    __syncthreads();
    const LAS unsigned char* KLb = lds + L_K; const LAS unsigned char* VTb = lds + L_VT;
    for (int task = wid; task < 16; task += 8) {
        const int g = task >> 2, qt = task & 3, hq = hkv * 4 + g, i0 = blk * 128 + 32 * qt;
        bf16* qrow = Z + (rowbase + i0 + r32) * NZ + ZQA + hq * 64;
        bf16x8 qf[4];
#pragma unroll
        for (int d0 = 0; d0 < 4; ++d0) qf[d0] = *(const GAS bf16x8*)(qrow + 16 * d0 + 8 * hi);
        const float slope2 = exp2f(-(float)(hq + 1)) * LOG2E, sink2 = sinks_l[hq] * LOG2E;
        f32x16 s[5];
#pragma unroll
        for (int jt = 0; jt < 5; ++jt) {
            s[jt] = (f32x16){};
            const int slot = 32 * qt + 32 * jt + r32;
#pragma unroll
            for (int d0 = 0; d0 < 4; ++d0) { const bf16x8 a = *(const LAS bf16x8*)(KLb + (slot * KSTR + 16 * d0 + 8 * hi) * 2); s[jt] = __builtin_amdgcn_mfma_f32_32x32x16_bf16(a, qf[d0], s[jt], 0, 0, 0); }
        }
        float m = sink2;
#pragma unroll
        for (int jt = 0; jt < 5; ++jt)
#pragma unroll
            for (int r = 0; r < 16; ++r) {
                const int kslot = 32 * qt + 32 * jt + crow(r, hi);
                const int dist = 128 + r32 - 32 * jt - crow(r, hi);
                const bool ok = (dist >= 0) && (dist < 128) && (k0 + kslot >= 0);
                const float v = ok ? (s[jt][r] - slope2 * (float)dist) : -INFINITY;
                s[jt][r] = v; m = fmaxf(m, v);
            }
        m = fmaxf(m, __shfl_xor(m, 32));
        float l = 0.f;
#pragma unroll
        for (int jt = 0; jt < 5; ++jt)
#pragma unroll
            for (int r = 0; r < 16; ++r) { const float p = __builtin_amdgcn_exp2f(s[jt][r] - m); s[jt][r] = p; l += p; }
        l += __shfl_xor(l, 32);
        l += __builtin_amdgcn_exp2f(sink2 - m);
        const float inv = 1.0f / l;
#pragma unroll
        for (int dh = 0; dh < 2; ++dh) {
            f32x16 o = (f32x16){};
#pragma unroll
            for (int jt = 0; jt < 5; ++jt)
#pragma unroll
                for (int ks = 0; ks < 2; ++ks) {
                    v4u pw; pw.x = pg8::cvt_pk_bf16(s[jt][8 * ks + 0], s[jt][8 * ks + 1]); pw.y = pg8::cvt_pk_bf16(s[jt][8 * ks + 2], s[jt][8 * ks + 3]);
                    pw.z = pg8::cvt_pk_bf16(s[jt][8 * ks + 4], s[jt][8 * ks + 5]); pw.w = pg8::cvt_pk_bf16(s[jt][8 * ks + 6], s[jt][8 * ks + 7]);
                    const int d = 32 * dh + r32, slot = 32 * qt + 32 * jt + 16 * ks + 4 * hi;
                    const v2u lo = *(const LAS v2u*)(VTb + (d * VSTR + slot) * 2), hi8 = *(const LAS v2u*)(VTb + (d * VSTR + slot + 8) * 2);
                    const v4u av = (v4u){lo.x, lo.y, hi8.x, hi8.y};
                    o = __builtin_amdgcn_mfma_f32_32x32x16_bf16(__builtin_bit_cast(bf16x8, av), __builtin_bit_cast(bf16x8, pw), o, 0, 0, 0);
                }
#pragma unroll
            for (int j = 0; j < 4; ++j) { v2u w; w.x = pg8::cvt_pk_bf16(o[4 * j] * inv, o[4 * j + 1] * inv); w.y = pg8::cvt_pk_bf16(o[4 * j + 2] * inv, o[4 * j + 3] * inv);
                *(GAS v2u*)(qrow + 32 * dh + 8 * j + 4 * hi) = w; }
        }
    }
    __syncthreads();
}
}

__global__ void __launch_bounds__(NWAVES * 64, 2) hybrid_fwd(Args args) {
    extern __shared__ __attribute__((aligned(16))) unsigned char lds_raw[];
    cg::grid_group grid = cg::this_grid();
    LAS unsigned char* lds = (LAS unsigned char*)lds_raw;
    const int tid = threadIdx.x, lane = tid & 63, wave = __builtin_amdgcn_readfirstlane(tid >> 6);
    const int G = gridDim.x, bx = blockIdx.x;
    const int vcu = (bx % 8) * (G / 8) + bx / 8;
    const int panel = vcu;
    unsigned char* ws = args.ws;
    const float* x = args.in[0];
    float* R = args.out;
    bf16* HB = (bf16*)(ws + WS_HB); bf16* MG = (bf16*)(ws + WS_MG); bf16* Z = (bf16*)(ws + WS_Z);
    float* CL = (float*)(ws + WS_CL); float* TOT = (float*)(ws + WS_TOT);
    float* TAIL = (float*)(ws + WS_TAIL); float* HP = (float*)(ws + WS_HP); float* HU = (float*)(ws + WS_HU);
    bf16* Hpanel = (bf16*)(ws + WS_Z + (size_t)panel * ZPANEL_B);
    bf16* Hadj = Hpanel - (size_t)panel * 256 * DFF;

    {
        LAS float* scr = (LAS float*)(lds + wave * 16384);
        const int gw = bx * NWAVES + wave, NGW = G * NWAVES;
        constexpr int I_IN = 16 * (NZ / 32), I_PA = 8 * 32, I_OUT = 16 * 32, I_FI = 16 * (5632 / 32), I_FO = 44 * 32, I_L = I_IN + 2 * I_PA + I_OUT + I_FI + I_FO;
        for (int it = gw; it < DEPTH * I_L; it += NGW) {
            const int l = it / I_L; int r = it % I_L;
            unsigned char* wl = ws + WS_W + (size_t)l * WL_BYTES;
            if (r < I_IN) { const int nblk = NZ / 32, kb = r / nblk, nb = r % nblk, n0 = 32 * nb;
                transpose_item(args.in[3] + (size_t)l * 1024 * NIN, NIN, 1024, 64 * kb, n0 + (n0 >= 2304 ? 8 : 0), (bf16*)(wl + WL_IN), n0, scr, lane); continue; } r -= I_IN;
            if (r < I_PA) { const int kb = r / 32, nb = r % 32; transpose_item(args.in[6] + (size_t)l * 512 * 1024, 1024, 512, 64 * kb, 32 * nb, (bf16*)(wl + WL_PA), 32 * nb, scr, lane); continue; } r -= I_PA;
            if (r < I_PA) { const int kb = r / 32, nb = r % 32; transpose_item(args.in[7] + (size_t)l * 512 * 1024, 1024, 512, 64 * kb, 32 * nb, (bf16*)(wl + WL_PB), 32 * nb, scr, lane); continue; } r -= I_PA;
            if (r < I_OUT) { const int kb = r / 32, nb = r % 32; transpose_item(args.in[8] + (size_t)l * 1024 * 1024, 1024, 1024, 64 * kb, 32 * nb, (bf16*)(wl + WL_OUT), 32 * nb, scr, lane); continue; } r -= I_OUT;
            if (r < I_FI) { const int nblk = 5632 / 32, kb = r / nblk, nb = r % nblk, n0 = 32 * nb, pn = n0 >> 8, j = n0 & 255;
                const int src = (j < 128) ? (128 * pn + j) : (DFF + 128 * pn + (j - 128));
                transpose_item(args.in[11] + (size_t)l * 1024 * 5632, 5632, 1024, 64 * kb, src, (bf16*)(wl + WL_FI), n0, scr, lane); continue; } r -= I_FI;
            { const int kb = r / 32, nb = r % 32; transpose_item(args.in[14] + (size_t)l * DFF * 1024, 1024, DFF, 64 * kb, 32 * nb, (bf16*)(wl + WL_FO), 32 * nb, scr, lane); }
        }
        __syncthreads();
#if !defined(NO_ROWF)
        row_pass<false, true>(lds, panel, x, nullptr, HB, nullptr, nullptr, args.in[3], args.in[4], CL, TOT);
#endif
    }
    grid.sync();

    for (int l = 0; l < DEPTH; ++l) {
        unsigned char* wl = ws + WS_W + (size_t)l * WL_BYTES;
        const float* resid_in = (l == 0) ? x : R;
        {
            pg8::Gemm g{HB, (const bf16*)(wl + WL_IN), MROWS, NZ, 1024, 1024}; pg8::PanelOrder S{panel, NZ / 256};
            pg8::EpiZ E{Z, NZ, args.in[4] + (size_t)l * NIN, C2};

#if !defined(NO_G1)
pg8::gemm_phase<pg8::EpiZ, pg8::PanelOrder, true, true>(lds, g, S, E);
#endif

        }
        grid.sync();
        {
            const int bh = vcu >> 2, sft = vcu & 3;
#pragma unroll 1
            for (int i = 0; i < 8; ++i) {
                const int base = (i >> 1) * 8, qb = (i & 1) ? (base + 7 - sft) : (base + sft);
#if !defined(NO_ATT)
                attn_body::attn_unit<8>(bh >> 3, bh & 7, qb, (const attn_body::bf16*)(Z + ZQB), (const attn_body::bf16*)(Z + ZKB), (const attn_body::bf16*)(Z + ZVB), (attn_body::bf16*)(Z + ZQB), CL, TOT, (char*)lds_raw);
#endif
            }
            __syncthreads();
#pragma unroll 1
            for (int i = 0; i < 4; ++i) { const int uid = vcu * 4 + i;
#if !defined(NO_SWA)
 swa::unit(uid >> 7, (uid >> 6) & 1, uid & 63, Z, args.in[5] + l * 8, lds);
#endif
 }
        }
        grid.sync();
        {
            pg8::PanelOrder S{panel, 4};
            { pg8::Gemm g{Z + ZQA, (const bf16*)(wl + WL_PA), MROWS, 1024, 512, NZ}; pg8::EpiGate<false> E{MG, Z + ZGA, NZ};

#if !defined(NO_G2)
pg8::gemm_phase<pg8::EpiGate<false>, pg8::PanelOrder, true, true>(lds, g, S, E);
#endif
 }
            __syncthreads();
            { pg8::Gemm g{Z + ZQB, (const bf16*)(wl + WL_PB), MROWS, 1024, 512, NZ}; pg8::EpiGate<true> E{MG, Z + ZGB, NZ};

#if !defined(NO_G2)
pg8::gemm_phase<pg8::EpiGate<true>, pg8::PanelOrder, true, true>(lds, g, S, E);
#endif
 }
            __syncthreads();
            { pg8::Gemm g{MG, (const bf16*)(wl + WL_OUT), MROWS, 1024, 1024, 1024}; pg8::EpiRes E{resid_in, R, ALPHA};

#if !defined(NO_G3)
pg8::gemm_phase<pg8::EpiRes, pg8::PanelOrder, true, true>(lds, g, S, E);
#endif
 }
            __syncthreads();
            row_pass<true, false>(lds, panel, R, R, HB, args.in[1] + l * DM, args.in[2] + l * DM, nullptr, nullptr, nullptr, nullptr);
            __syncthreads();
        }
        {
            pg8::Gemm g{HB, (const bf16*)(wl + WL_FI), MROWS, 5632, 1024, 1024}; pg8::PanelOrder S{panel, 22};
            pg8::EpiConv E{Hadj, args.in[12] + (size_t)l * 3 * DFF, args.in[13] + (size_t)l * DFF, TAIL, HP, HU, (LAS float*)(lds + TL_OFF)};
#if !defined(NO_CONV)
            pg8::gemm_phase<pg8::EpiConv, pg8::PanelOrder, true, true>(lds, g, S, E);
#endif
        }
        grid.sync();
        {
            const float* cw = args.in[12] + (size_t)l * 3 * DFF;
            const bool first = (panel & 31) == 0;
            int tidf = threadIdx.x; asm volatile("" : "+v"(tidf));
            for (int idx = tidf; idx < 2 * DFF; idx += 512) { const int r = idx / DFF, c = idx % DFF;
                float t0 = 0.f, t1 = 0.f;
                if (!first) { t0 = TAIL[((size_t)(panel - 1) * 2 + 0) * DFF + c]; t1 = TAIL[((size_t)(panel - 1) * 2 + 1) * DFF + c]; }
                float cv = HP[((size_t)panel * 2 + r) * DFF + c];
                cv += (r == 0) ? (cw[c] * t0 + cw[DFF + c] * t1) : (cw[c] * t1);
                const float hv = cv * pg8::sigmoidf_(cv) * HU[((size_t)panel * 2 + r) * DFF + c];
                Hpanel[(size_t)r * DFF + c] = (bf16)f2bf(hv); }
            __syncthreads();
            { pg8::Gemm g{Hadj, (const bf16*)(wl + WL_FO), MROWS, 1024, DFF, DFF}; pg8::PanelOrder S{panel, 4}; pg8::EpiRes E{R, R, ALPHA};

#if !defined(NO_G3)
pg8::gemm_phase<pg8::EpiRes, pg8::PanelOrder, true, true>(lds, g, S, E);
#endif
 }
            __syncthreads();
#if !defined(NO_ROWF)
            if (l + 1 < DEPTH) row_pass<true, true>(lds, panel, R, R, HB, args.in[9] + l * DM, args.in[10] + l * DM, args.in[3] + (size_t)(l + 1) * 1024 * NIN, args.in[4] + (size_t)(l + 1) * NIN, CL, TOT);
            else
#endif
            row_pass<true, false>(lds, panel, R, R, HB, args.in[9] + l * DM, args.in[10] + l * DM, nullptr, nullptr, nullptr, nullptr);
            __syncthreads();
        }
    }
}

extern "C" void kernel_launch(void* const* d_in, const int* in_sizes, int n_in, void* d_out, int out_size, void* d_ws, size_t ws_size, hipStream_t stream) {
    static int grid = 0;
    if (grid == 0) {
        if (n_in != 15 || in_sizes[0] != MROWS * DM || out_size != MROWS * DM || ws_size < WS_END) { fprintf(stderr, "kernel_launch: unexpected shapes / workspace (n_in %d, in0 %d, out %d, ws %zu < %zu)\n", n_in, n_in > 0 ? in_sizes[0] : -1, out_size, ws_size, (size_t)WS_END); grid = -1; return; }
        int dev = 0, cus = 0, per_cu = 0;
        (void)hipGetDevice(&dev); (void)hipDeviceGetAttribute(&cus, hipDeviceAttributeMultiprocessorCount, dev);
        if (hipFuncSetAttribute((const void*)hybrid_fwd, hipFuncAttributeMaxDynamicSharedMemorySize, LDS_BYTES) != hipSuccess) { fprintf(stderr, "kernel_launch: hipFuncSetAttribute failed\n"); grid = -1; return; }
        (void)hipOccupancyMaxActiveBlocksPerMultiprocessor(&per_cu, (const void*)hybrid_fwd, NWAVES * 64, LDS_BYTES);
        (void)hipGetLastError();
        if (cus * per_cu < 256) fprintf(stderr, "kernel_launch: note: occupancy query says %d x %d workgroups; launching 256 anyway (the cooperative launch checks residency)\n", cus, per_cu);
        grid = 256;
    }
    if (grid < 0) return;
    Args a{};
    for (int i = 0; i < 15; ++i) a.in[i] = (const float*)d_in[i];
    a.out = (float*)d_out; a.ws = (unsigned char*)d_ws;
    void* kargs[] = {&a};
    hipError_t e = hipLaunchCooperativeKernel((const void*)hybrid_fwd, dim3(grid), dim3(NWAVES * 64), kargs, LDS_BYTES, stream);
    if (e != hipSuccess) fprintf(stderr, "kernel_launch: cooperative launch failed: %s\n", hipGetErrorString(e));
}
```

```cpp
#include <hip/hip_runtime.h>
#include <hip/hip_cooperative_groups.h>
#include <hip/hip_bf16.h>
#include <cstdio>
#include <cstdint>
#include <cmath>
namespace cg = cooperative_groups;

namespace pg8 {
#define PG8_LAS __attribute__((address_space(3)))
typedef unsigned short bf16_t;
typedef short bf16x8 __attribute__((ext_vector_type(8)));
typedef float f32x4 __attribute__((ext_vector_type(4)));
typedef unsigned u32x4 __attribute__((ext_vector_type(4)));
constexpr int BM = 256, BK = 64, HALF = 128, HTB = HALF * BK * 2  , STAGE_BYTES = 8 * HTB;

__host__ __device__ __forceinline__ int lds_byte(int r, int c) { const int st = (r >> 4) * 2 + (c >> 5), rr = r & 15, cc = c & 31, ob = rr * 64 + cc * 2; return st * 1024 + (ob ^ (((ob >> 9) & 1) << 5)); }
__host__ __device__ __forceinline__ void stage_rc(int b, int& R, int& C) { const int st = b / 1024, sb = b % 1024, swz = sb ^ (((sb >> 9) & 1) << 5); R = (st >> 1) * 16 + swz / 64; C = (st & 1) * 32 + (swz % 64) / 2; }
__host__ __device__ __forceinline__ int perm32(int rho) { const int n = rho >> 4, i = rho & 15; return 8 * (i >> 2) + 4 * n + (i & 3); }

struct Unit { int pm, pn; };
struct Gemm { const bf16_t* A; const bf16_t* Bt; int M, N, K, lda; };

struct PanelOrder {
    int pm, nN;
    __device__ __forceinline__ bool next(int i, Unit& u) const { if (i >= nN) return false; u.pm = pm; u.pn = i; return true; }
    __device__ __forceinline__ void a_ready(const Unit&) const {}
    __device__ __forceinline__ void done(const Unit&) const {}
};

__device__ __forceinline__ unsigned cvt_pk_bf16(float lo, float hi) { unsigned r; asm volatile("v_cvt_pk_bf16_f32 %0, %1, %2" : "=v"(r) : "v"(lo), "v"(hi)); return r; }
__device__ __forceinline__ float bf_lo(unsigned w) { return __uint_as_float(w << 16); }
__device__ __forceinline__ float bf_hi(unsigned w) { return __uint_as_float(w & 0xffff0000u); }
__device__ __forceinline__ float sigmoidf_(float x) { return __builtin_amdgcn_rcpf(1.0f + __expf(-x)); }


struct EpiZ {
    static constexpr bool PERM = true, AFTER_DRAIN = false;
    bf16_t* O; int ldc; const float* bias; float qscale;
    __device__ __forceinline__ void operator()(const f32x4 (&acc)[2][2][4][2], const Unit& u, int wr, int wc, int fr_in, int fq_in) const {
        int fr = fr_in, fq = fq_in; asm volatile("" : "+v"(fr), "+v"(fq));
        const int row0 = u.pm * BM + wr * 64 + fr; const int col0 = u.pn * BM + wc * 32 + 8 * fq;
        const float sc = (u.pn == 0 || u.pn == 1 || u.pn == 3 || u.pn == 4) ? qscale : 1.f;
        f32x4 bv[2][2];
#pragma unroll
        for (int bj = 0; bj < 2; ++bj)
#pragma unroll
            for (int n = 0; n < 2; ++n) { const int c = col0 + bj * HALF + 4 * n; bv[bj][n] = *(const f32x4*)(bias + c + (c >= 2304 ? 8 : 0)); }
#pragma unroll
        for (int ai = 0; ai < 2; ++ai)
#pragma unroll
            for (int m = 0; m < 4; ++m) { bf16_t* rowp = O + (size_t)(row0 + ai * HALF + m * 16) * ldc + col0;
#pragma unroll
                for (int bj = 0; bj < 2; ++bj) { f32x4 v0 = (acc[ai][bj][m][0] + bv[bj][0]) * sc, v1 = (acc[ai][bj][m][1] + bv[bj][1]) * sc;
                    u32x4 w; w.x = cvt_pk_bf16(v0[0], v0[1]); w.y = cvt_pk_bf16(v0[2], v0[3]); w.z = cvt_pk_bf16(v1[0], v1[1]); w.w = cvt_pk_bf16(v1[2], v1[3]);
                    *(u32x4*)(rowp + bj * HALF) = w; } }
    }
};

template <bool SECOND> struct EpiGate {
    static constexpr bool PERM = true, AFTER_DRAIN = false;
    bf16_t* MG; const bf16_t* G; int ldg;
    __device__ __forceinline__ void operator()(const f32x4 (&acc)[2][2][4][2], const Unit& u, int wr, int wc, int fr_in, int fq_in) const {
        int fr = fr_in, fq = fq_in; asm volatile("" : "+v"(fr), "+v"(fq));
        const int row0 = u.pm * BM + wr * 64 + fr; const int col0 = u.pn * BM + wc * 32 + 8 * fq;
#pragma unroll
        for (int ai = 0; ai < 2; ++ai)
#pragma unroll
            for (int m = 0; m < 4; ++m) { const size_t row = (size_t)(row0 + ai * HALF + m * 16);
#pragma unroll
                for (int bj = 0; bj < 2; ++bj) {
                    const u32x4 gw = *(const u32x4*)(G + row * ldg + col0 + bj * HALF);
                    bf16_t* mp = MG + row * 1024 + col0 + bj * HALF;
                    const f32x4 a0 = acc[ai][bj][m][0], a1 = acc[ai][bj][m][1];
                    float v[8];
                    v[0] = sigmoidf_(bf_lo(gw.x)) * a0[0]; v[1] = sigmoidf_(bf_hi(gw.x)) * a0[1]; v[2] = sigmoidf_(bf_lo(gw.y)) * a0[2]; v[3] = sigmoidf_(bf_hi(gw.y)) * a0[3];
                    v[4] = sigmoidf_(bf_lo(gw.z)) * a1[0]; v[5] = sigmoidf_(bf_hi(gw.z)) * a1[1]; v[6] = sigmoidf_(bf_lo(gw.w)) * a1[2]; v[7] = sigmoidf_(bf_hi(gw.w)) * a1[3];
                    if (SECOND) { const u32x4 pw = *(const u32x4*)mp;
                        v[0] += bf_lo(pw.x); v[1] += bf_hi(pw.x); v[2] += bf_lo(pw.y); v[3] += bf_hi(pw.y); v[4] += bf_lo(pw.z); v[5] += bf_hi(pw.z); v[6] += bf_lo(pw.w); v[7] += bf_hi(pw.w); }
                    u32x4 w; w.x = cvt_pk_bf16(v[0], v[1]); w.y = cvt_pk_bf16(v[2], v[3]); w.z = cvt_pk_bf16(v[4], v[5]); w.w = cvt_pk_bf16(v[6], v[7]);
                    *(u32x4*)mp = w; } }
    }
};

struct EpiRes {
    static constexpr bool PERM = true, AFTER_DRAIN = false;
    const float* base; float* out; float alpha;
    __device__ __forceinline__ void operator()(const f32x4 (&acc)[2][2][4][2], const Unit& u, int wr, int wc, int fr_in, int fq_in) const {
        int fr = fr_in, fq = fq_in; asm volatile("" : "+v"(fr), "+v"(fq));
        const int row0 = u.pm * BM + wr * 64 + fr; const int col0 = u.pn * BM + wc * 32 + 8 * fq;
#pragma unroll
        for (int ai = 0; ai < 2; ++ai)
#pragma unroll
            for (int m = 0; m < 4; ++m) { const size_t off = (size_t)(row0 + ai * HALF + m * 16) * 1024 + col0;
#pragma unroll
                for (int bj = 0; bj < 2; ++bj) {
                    const f32x4 b0 = *(const f32x4*)(base + off + bj * HALF), b1 = *(const f32x4*)(base + off + bj * HALF + 4);
                    *(f32x4*)(out + off + bj * HALF) = b0 * alpha + acc[ai][bj][m][0];
                    *(f32x4*)(out + off + bj * HALF + 4) = b1 * alpha + acc[ai][bj][m][1]; } }
    }
};

__device__ __forceinline__ float dpp_shr1(float v) { return __builtin_bit_cast(float, __builtin_amdgcn_update_dpp(0, __builtin_bit_cast(int, v), 0x111, 0xf, 0xf, true)); }
__device__ __forceinline__ float dpp_shr2(float v) { return __builtin_bit_cast(float, __builtin_amdgcn_update_dpp(0, __builtin_bit_cast(int, v), 0x112, 0xf, 0xf, true)); }
__device__ __forceinline__ float lane_get(float v, int src_lane) { return __builtin_bit_cast(float, __builtin_amdgcn_ds_bpermute(src_lane * 4, __builtin_bit_cast(int, v))); }

struct EpiConv {
    static constexpr bool PERM = true, AFTER_DRAIN = false;
    bf16_t* H;
    const float* cw; const float* cb;
    float* TAIL; float* HP; float* HU;
    PG8_LAS float* tl;
    __device__ __forceinline__ void operator()(const f32x4 (&acc)[2][2][4][2], const Unit& u, int wr, int wc, int fr_in, int fq_in) const {
        int fr = fr_in, fq = fq_in; asm volatile("" : "+v"(fr), "+v"(fq));
        const int lane = fq * 16 + fr;
        const int colw = wc * 32 + 8 * fq; const int hc0 = u.pn * 128 + colw;
        if (fr >= 14) {
#pragma unroll
            for (int ai = 0; ai < 2; ++ai)
#pragma unroll
                for (int n = 0; n < 2; ++n) *(PG8_LAS f32x4*)(tl + ((ai * 2 + wr) * 2 + (fr - 14)) * 128 + colw + 4 * n) = acc[ai][0][3][n];
            if (wr == 1) {
#pragma unroll
                for (int n = 0; n < 2; ++n) *(f32x4*)(TAIL + ((size_t)u.pm * 2 + (fr - 14)) * 2816 + hc0 + 4 * n) = acc[1][0][3][n];
            }
        }
        asm volatile("s_waitcnt lgkmcnt(0)" ::: "memory"); __builtin_amdgcn_s_barrier(); asm volatile("" ::: "memory");
        const int l15 = (lane & 48) + 15, l14f = (lane & 48) + 14 + (fr & 1);
#pragma unroll
        for (int n = 0; n < 2; ++n) {
            const f32x4 w0 = *(const f32x4*)(cw + hc0 + 4 * n), w1 = *(const f32x4*)(cw + 2816 + hc0 + 4 * n), w2 = *(const f32x4*)(cw + 5632 + hc0 + 4 * n), bb = *(const f32x4*)(cb + hc0 + 4 * n);
#pragma unroll
            for (int ai = 0; ai < 2; ++ai) {
                const int lin = ai * 2 + wr;
                f32x4 hA = (f32x4){0.f, 0.f, 0.f, 0.f}, hB = (f32x4){0.f, 0.f, 0.f, 0.f};
                if (lin > 0) { hA = *(const PG8_LAS f32x4*)(tl + ((lin - 1) * 2 + 1) * 128 + colw + 4 * n); hB = *(const PG8_LAS f32x4*)(tl + ((lin - 1) * 2 + 0) * 128 + colw + 4 * n); }
#pragma unroll
                for (int m = 0; m < 4; ++m) {
                    float hv[4], cv[4];
#pragma unroll
                    for (int e = 0; e < 4; ++e) {
                        const float G = acc[ai][0][m][n][e];
                        float X, Y;
                        if (m == 0) { X = hA[e]; Y = (fr == 0) ? hB[e] : hA[e]; }
                        else { const float Gp = acc[ai][0][m - 1][n][e]; X = lane_get(Gp, l15); Y = lane_get(Gp, l14f); }
                        const float s1 = dpp_shr1(G), s2 = dpp_shr2(G);
                        const float p1 = (fr >= 1) ? s1 : X, p2 = (fr >= 2) ? s2 : Y;
                        const float c = bb[e] + w0[e] * p2 + w1[e] * p1 + w2[e] * G;
                        cv[e] = c;
                        hv[e] = c * sigmoidf_(c) * acc[ai][1][m][n][e];
                    }
                    const size_t row = (size_t)(u.pm * BM + ai * HALF + wr * 64 + m * 16 + fr);
                    typedef unsigned u32x2 __attribute__((ext_vector_type(2)));
                    u32x2 w; w.x = cvt_pk_bf16(hv[0], hv[1]); w.y = cvt_pk_bf16(hv[2], hv[3]);
                    *(u32x2*)(H + row * 2816 + hc0 + 4 * n) = w;
                    if (ai == 0 && m == 0 && wr == 0 && fr < 2) {
                        *(f32x4*)(HP + ((size_t)u.pm * 2 + fr) * 2816 + hc0 + 4 * n) = (f32x4){cv[0], cv[1], cv[2], cv[3]};
                        *(f32x4*)(HU + ((size_t)u.pm * 2 + fr) * 2816 + hc0 + 4 * n) = acc[0][1][0][n];
                    }
                }
            }
        }
    }
};

template <class Epi, class Sched, bool ALIGN_EPI = false, bool SP2 = false>
__device__ __forceinline__ void gemm_phase(PG8_LAS unsigned char* lds, const Gemm g, const Sched& S, const Epi& E) {
    int tid_ = threadIdx.x; asm volatile("" : "+v"(tid_)); const int tid = tid_, wid = __builtin_amdgcn_readfirstlane(tid >> 6), lane = tid & 63, wr = wid >> 2, wc = wid & 3, fr = lane & 15, fq = lane >> 4;
    const int K = g.K, nt = K / BK;
    unsigned voffA[2], voffB[2];
#pragma unroll
    for (int i = 0; i < 2; ++i) { int R, C; stage_rc(tid * 16 + i * 8192, R, C); const int Rb = Epi::PERM ? ((R & ~31) + perm32(R & 31)) : R;
        voffA[i] = (unsigned)(R * g.lda + C) * 2u; voffB[i] = (unsigned)(Rb * K + C) * 2u; }
    const size_t kstep = (size_t)(BK * 2);
    const size_t hstepA = (size_t)HALF * g.lda * 2, hstepB = (size_t)HALF * K * 2;
    const size_t tstepA = 2 * hstepA, tstepB = 2 * hstepB;
    const unsigned ldsw = (unsigned)wid * 1024u;
    const int aoff = lds_byte(wr * 64 + fr, fq * 8), boff = lds_byte(wc * 32 + fr, fq * 8);
#define PG8_SA(b, h) (((b) * 2 + (h)) * HTB)
#define PG8_SB(b, h) ((4 + (b) * 2 + (h)) * HTB)
#define PG8_STAGE(bufoff, gbase, voff) do { _Pragma("unroll") for (int _i = 0; _i < 2; ++_i) \
        __builtin_amdgcn_global_load_lds((const unsigned*)((const char*)(gbase) + (voff)[_i]), (PG8_LAS unsigned*)(lds + (bufoff) + ldsw + _i * 8192), 16, 0, 0); } while (0)
#define PG8_LDA(dst, b, h) do { _Pragma("unroll") for (int m = 0; m < 4; ++m) _Pragma("unroll") for (int k = 0; k < 2; ++k) dst[m][k] = *(const PG8_LAS bf16x8*)(lds + PG8_SA(b, h) + aoff + m * 2048 + k * 1024); } while (0)
#define PG8_LDB(dst, b, h) do { _Pragma("unroll") for (int n = 0; n < 2; ++n) _Pragma("unroll") for (int k = 0; k < 2; ++k) dst[n][k] = *(const PG8_LAS bf16x8*)(lds + PG8_SB(b, h) + boff + n * 2048 + k * 1024); } while (0)
#define PG8_MMA(ai, bj, At, Bt) do { __builtin_amdgcn_s_setprio(1); _Pragma("unroll") for (int m = 0; m < 4; ++m) _Pragma("unroll") for (int n = 0; n < 2; ++n) _Pragma("unroll") for (int k = 0; k < 2; ++k) \
        acc[ai][bj][m][n] = __builtin_amdgcn_mfma_f32_16x16x32_bf16(Bt[n][k], At[m][k], acc[ai][bj][m][n], 0, 0, 0); __builtin_amdgcn_s_setprio(0); } while (0)
#define PG8_WAIT_V(n) asm volatile("s_waitcnt vmcnt(" #n ")" ::: "memory")
#define PG8_WAIT_L(n) asm volatile("s_waitcnt lgkmcnt(" #n ")" ::: "memory")
#define PG8_BAR __builtin_amdgcn_s_barrier()
#define PG8_SCHED __builtin_amdgcn_sched_barrier(0)
    Unit cur, nxt; int ui = 0;
    if (!S.next(0, cur)) return;
    f32x4 acc[2][2][4][2];
#pragma unroll
    for (int a = 0; a < 2; ++a)
#pragma unroll
        for (int b = 0; b < 2; ++b)
#pragma unroll
            for (int m = 0; m < 4; ++m)
#pragma unroll
                for (int n = 0; n < 2; ++n) acc[a][b][m][n] = (f32x4){0.f, 0.f, 0.f, 0.f};
    bf16x8 At[4][2], B0[2][2], B1[2][2];
    const char* cA = (const char*)g.A + (size_t)cur.pm * tstepA; const char* cB = (const char*)g.Bt + (size_t)cur.pn * tstepB;
    S.a_ready(cur);
    if constexpr (SP2) {
        PG8_STAGE(PG8_SB(0, 0), cB, voffB); PG8_STAGE(PG8_SB(0, 1), cB + hstepB, voffB); PG8_STAGE(PG8_SA(0, 0), cA, voffA); PG8_STAGE(PG8_SA(0, 1), cA + hstepA, voffA);
        if (wr == 1) PG8_BAR;
        PG8_WAIT_V(2); PG8_BAR;
        PG8_STAGE(PG8_SB(1, 0), cB + kstep, voffB); PG8_STAGE(PG8_SA(1, 0), cA + kstep, voffA); PG8_STAGE(PG8_SB(1, 1), cB + hstepB + kstep, voffB);
        PG8_WAIT_V(6); PG8_BAR;
    } else {
        PG8_STAGE(PG8_SB(0, 0), cB, voffB); PG8_STAGE(PG8_SA(0, 0), cA, voffA); PG8_STAGE(PG8_SB(0, 1), cB + hstepB, voffB); PG8_STAGE(PG8_SA(0, 1), cA + hstepA, voffA);
        if (wr == 1) PG8_BAR;
        PG8_WAIT_V(4); PG8_BAR;
        PG8_STAGE(PG8_SB(1, 0), cB + kstep, voffB); PG8_STAGE(PG8_SA(1, 0), cA + kstep, voffA); PG8_STAGE(PG8_SB(1, 1), cB + hstepB + kstep, voffB);
        PG8_WAIT_V(6); PG8_BAR;
    }
    for (;;) {
        const bool has_next = S.next(ui + 1, nxt);
        const char* nA = has_next ? (const char*)g.A + (size_t)nxt.pm * tstepA : cA; const char* nB = has_next ? (const char*)g.Bt + (size_t)nxt.pn * tstepB : cB;
        for (int t = 0; t < nt; t += 2) {
            const bool last = (t == nt - 2);
            const char* a1 = cA + (size_t)(t + 1) * kstep;
            const char* a2 = last ? nA : cA + (size_t)(t + 2) * kstep; const char* b2 = last ? nB : cB + (size_t)(t + 2) * kstep;
            const char* a3 = a2 + kstep; const char* b3 = b2 + kstep;
            if (last && has_next) S.a_ready(nxt);
            if constexpr (SP2) {
            PG8_LDB(B0, 0, 0); PG8_LDB(B1, 0, 1); PG8_SCHED; PG8_LDA(At, 0, 0); PG8_STAGE(PG8_SA(1, 1), a1 + hstepA, voffA);
            PG8_WAIT_V(8); PG8_WAIT_L(0); PG8_BAR; PG8_MMA(0, 0, At, B0); PG8_MMA(0, 1, At, B1); PG8_BAR; PG8_SCHED;
            PG8_LDA(At, 0, 1); PG8_STAGE(PG8_SB(0, 0), b2, voffB); PG8_STAGE(PG8_SB(0, 1), b2 + hstepB, voffB); PG8_STAGE(PG8_SA(0, 0), a2, voffA);
            PG8_WAIT_V(8); PG8_WAIT_L(0); PG8_BAR; PG8_MMA(1, 0, At, B0); PG8_MMA(1, 1, At, B1); PG8_BAR; PG8_SCHED;
            PG8_LDB(B0, 1, 0); PG8_LDB(B1, 1, 1); PG8_SCHED; PG8_LDA(At, 1, 0); PG8_STAGE(PG8_SA(0, 1), a2 + hstepA, voffA);
            PG8_WAIT_V(8); PG8_WAIT_L(0); PG8_BAR; PG8_MMA(0, 0, At, B0); PG8_MMA(0, 1, At, B1); PG8_BAR; PG8_SCHED;
            PG8_LDA(At, 1, 1); PG8_STAGE(PG8_SB(1, 0), b3, voffB); PG8_STAGE(PG8_SB(1, 1), b3 + hstepB, voffB); PG8_STAGE(PG8_SA(1, 0), a3, voffA);
            PG8_WAIT_V(8); PG8_WAIT_L(0); PG8_BAR; PG8_MMA(1, 0, At, B0); PG8_MMA(1, 1, At, B1); PG8_BAR; PG8_SCHED;
            } else {
            PG8_LDB(B0, 0, 0); PG8_SCHED; PG8_LDA(At, 0, 0); PG8_STAGE(PG8_SA(1, 1), a1 + hstepA, voffA);
            PG8_WAIT_L(8); PG8_BAR; PG8_WAIT_L(0); PG8_MMA(0, 0, At, B0); PG8_BAR; PG8_SCHED;
            PG8_LDB(B1, 0, 1); PG8_STAGE(PG8_SB(0, 0), b2, voffB);
            PG8_BAR; PG8_WAIT_L(0); PG8_MMA(0, 1, At, B1); PG8_BAR;
            PG8_LDA(At, 0, 1); PG8_STAGE(PG8_SA(0, 0), a2, voffA);
            PG8_BAR; PG8_WAIT_L(0); PG8_MMA(1, 0, At, B0); PG8_BAR; PG8_SCHED;
            PG8_STAGE(PG8_SB(0, 1), b2 + hstepB, voffB);
            PG8_WAIT_V(6); PG8_BAR; PG8_MMA(1, 1, At, B1); PG8_BAR;
            PG8_LDB(B0, 1, 0); PG8_SCHED; PG8_LDA(At, 1, 0); PG8_STAGE(PG8_SA(0, 1), a2 + hstepA, voffA);
            PG8_WAIT_L(8); PG8_BAR; PG8_WAIT_L(0); PG8_MMA(0, 0, At, B0); PG8_BAR; PG8_SCHED;
            PG8_LDB(B1, 1, 1); PG8_STAGE(PG8_SB(1, 0), b3, voffB);
            PG8_BAR; PG8_WAIT_L(0); PG8_MMA(0, 1, At, B1); PG8_BAR;
            PG8_LDA(At, 1, 1); PG8_STAGE(PG8_SA(1, 0), a3, voffA);
            PG8_BAR; PG8_WAIT_L(0); PG8_MMA(1, 0, At, B0); PG8_BAR; PG8_SCHED;
            PG8_STAGE(PG8_SB(1, 1), b3 + hstepB, voffB);
            PG8_WAIT_V(6); PG8_BAR; PG8_MMA(1, 1, At, B1); PG8_BAR;
            }
        }
        if constexpr (ALIGN_EPI) { if (wr == 0) PG8_BAR; }
        if constexpr (!Epi::AFTER_DRAIN) { E(acc, cur, wr, wc, fr, fq); S.done(cur); }
        if (!has_next) break;
#pragma unroll
        for (int a = 0; a < 2; ++a)
#pragma unroll
            for (int b = 0; b < 2; ++b)
#pragma unroll
                for (int m = 0; m < 4; ++m)
#pragma unroll
                    for (int n = 0; n < 2; ++n) acc[a][b][m][n] = (f32x4){0.f, 0.f, 0.f, 0.f};
        cur = nxt; cA = nA; cB = nB; ++ui;
        if constexpr (ALIGN_EPI) { if (wr == 1) PG8_BAR; }
    }
    PG8_WAIT_V(0);
    if constexpr (!ALIGN_EPI) { if (wr == 0) PG8_BAR; }
    PG8_BAR;
    if constexpr (Epi::AFTER_DRAIN) { E.fused(acc, cur, wr, wc, fr, fq, lds, wid, lane); S.done(cur); }
#undef PG8_SA
#undef PG8_SB
#undef PG8_STAGE
#undef PG8_LDA
#undef PG8_LDB
#undef PG8_MMA
#undef PG8_WAIT_V
#undef PG8_WAIT_L
#undef PG8_BAR
#undef PG8_SCHED
}

}

namespace attn_body {
using bf16=__hip_bfloat16;
using bf16x8=__attribute__((ext_vector_type(8)))short;
using s16x4=__attribute__((ext_vector_type(4)))short;
using f32x16=__attribute__((ext_vector_type(16)))float;
using u32x4=__attribute__((ext_vector_type(4)))unsigned;
constexpr int BATCH=8,NHEAD=8,SEQ=8192,D=64,DM=4352;
constexpr int NW=8,QBLK=32,QB=QBLK*NW,KVBLK=64,NQB=SEQ/QB;
constexpr int ATTN_PITCH=DM, ATTN_UNIT_ROWS=QB;
__device__ __forceinline__ int crow(int r,int hi){return (r&3)+8*(r>>2)+4*hi;}
#define SBAR() __builtin_amdgcn_sched_barrier(0)
__device__ __forceinline__ void cmask(f32x16&p0,f32x16&p1,int jb,int qrel,int hi){
  const float NEG=-INFINITY; int kb=64*jb+4*hi;
  #pragma unroll
  for(int r=0;r<16;++r){int kv=kb+(r&3)+8*(r>>2); if(kv>qrel)p0[r]=NEG; if(kv+32>qrel)p1[r]=NEG;}
}

constexpr int NSLOT=3, SLOTB=8192;
constexpr int LDS_K=0, LDS_V=NSLOT*SLOTB, LDS_WS=2*NSLOT*SLOTB, LDS_OST=LDS_WS+NW*64*4, LDS_BYTES=LDS_OST+NW*4096;
constexpr int LDS_CB=LDS_BYTES;
constexpr float C2=0.125f*1.4426950408889634f;
__device__ __forceinline__ void glds16(const void*gsrc,unsigned lds_dst){unsigned keep;
  asm volatile("s_mov_b32 %0, m0\n\ts_mov_b32 m0, %2\n\ts_nop 0\n\tglobal_load_lds_dwordx4 %1, off\n\ts_mov_b32 m0, %0":"=&s"(keep):"v"(gsrc),"s"(lds_dst):"memory");}
__device__ __forceinline__ float max3f(float a,float b,float c){float r;asm("v_max3_f32 %0, %1, %2, %3":"=v"(r):"v"(a),"v"(b),"v"(c));return r;}
__device__ __forceinline__ float max2f(float a,float b){float r;asm("v_max_f32_e32 %0, %1, %2":"=v"(r):"v"(a),"v"(b));return r;}
__device__ __forceinline__ float fadd_s(float a,float b){float r;asm("v_add_f32_e32 %0, %1, %2":"=v"(r):"v"(a),"v"(b));return r;}
__device__ __forceinline__ float fsub_s(float a,float b){float r;asm("v_sub_f32_e32 %0, %1, %2":"=v"(r):"v"(a),"v"(b));return r;}
typedef float f32x2_t __attribute__((ext_vector_type(2))); typedef __bf16 bf16x2_t __attribute__((ext_vector_type(2)));
__device__ __forceinline__ unsigned cvtpk_s(float lo,float hi){f32x2_t v={lo,hi};bf16x2_t b=__builtin_convertvector(v,bf16x2_t);return __builtin_bit_cast(unsigned,b);}
#define WAIT_BAR(N) asm volatile("s_waitcnt vmcnt(" #N ") lgkmcnt(0)\n\ts_barrier":::"memory")

__device__ __forceinline__ void qkt(f32x16&p0,f32x16&p1,const char*Kslot,const bf16x8*qr,const f32x16&negm,int r32,int hi){
  const char*kb=Kslot+hi*1024+r32*16;
  #pragma unroll
  for(int d0=0;d0<4;++d0){
    const bf16x8 b0=*reinterpret_cast<const bf16x8*>(kb+d0*2048);
    const bf16x8 b1=*reinterpret_cast<const bf16x8*>(kb+d0*2048+512);
    if(d0==0){p0=__builtin_amdgcn_mfma_f32_32x32x16_bf16(b0,qr[0],negm,0,0,0);p1=__builtin_amdgcn_mfma_f32_32x32x16_bf16(b1,qr[0],negm,0,0,0);}
    else{p0=__builtin_amdgcn_mfma_f32_32x32x16_bf16(b0,qr[d0],p0,0,0,0);p1=__builtin_amdgcn_mfma_f32_32x32x16_bf16(b1,qr[d0],p1,0,0,0);}}
}
typedef __attribute__((address_space(3))) const char* lds_cptr;
typedef short v4i16_t __attribute__((ext_vector_type(4)));
__device__ __forceinline__ void kload8(bf16x8*kf,lds_cptr kp){
  kf[0]=*(const __attribute__((address_space(3))) bf16x8*)(kp);      kf[1]=*(const __attribute__((address_space(3))) bf16x8*)(kp+512);
  kf[2]=*(const __attribute__((address_space(3))) bf16x8*)(kp+2048); kf[3]=*(const __attribute__((address_space(3))) bf16x8*)(kp+2560);
  kf[4]=*(const __attribute__((address_space(3))) bf16x8*)(kp+4096); kf[5]=*(const __attribute__((address_space(3))) bf16x8*)(kp+4608);
  kf[6]=*(const __attribute__((address_space(3))) bf16x8*)(kp+6144); kf[7]=*(const __attribute__((address_space(3))) bf16x8*)(kp+6656);
}
__device__ __forceinline__ void kload2(bf16x8*kf,lds_cptr kp,int j){ kf[2*j]=*(const __attribute__((address_space(3))) bf16x8*)(kp+j*2048); kf[2*j+1]=*(const __attribute__((address_space(3))) bf16x8*)(kp+j*2048+512); }
__device__ __forceinline__ s16x4 vtr(lds_cptr p){ return __builtin_bit_cast(s16x4,__builtin_amdgcn_ds_read_tr16_b64_v4i16((__attribute__((address_space(3))) v4i16_t*)p)); }
__device__ __forceinline__ float rowmax(const f32x16&p0,const f32x16&p1){
  float a=max3f(p0[0],p0[1],p1[0]),b=max3f(p0[2],p0[3],p1[1]);a=max3f(a,p1[2],p1[3]);
  #pragma unroll
  for(int r=4;r<16;r+=4){a=max3f(a,p0[r],p0[r+1]);b=max3f(b,p0[r+2],p0[r+3]);a=max3f(a,p1[r],p1[r+1]);b=max3f(b,p1[r+2],p1[r+3]);}
  const float m=max2f(a,b);
  auto rr=__builtin_amdgcn_permlane32_swap(__float_as_uint(m),__float_as_uint(m),false,false);
  return max2f(__uint_as_float(rr[0]),__uint_as_float(rr[1]));
}
__device__ __forceinline__ void pv(f32x16*o,int vb,bf16x8 pa0,bf16x8 pa1,bf16x8 pa2,bf16x8 pa3){
  #pragma unroll
  for(int d0=0;d0<2;++d0){s16x4 lo[4],hi[4];
    #pragma unroll
    for(int ks=0;ks<4;++ks){
      asm volatile("ds_read_b64_tr_b16 %0,%1 offset:%c2":"=&v"(lo[ks]):"v"(vb),"i"(d0*4096+ks*1024):"memory");
      asm volatile("ds_read_b64_tr_b16 %0,%1 offset:%c2":"=&v"(hi[ks]):"v"(vb),"i"(d0*4096+ks*1024+512):"memory");}
    asm volatile("s_waitcnt lgkmcnt(0)":::"memory");SBAR();
    #define PK(k) (bf16x8){lo[k][0],lo[k][1],lo[k][2],lo[k][3],hi[k][0],hi[k][1],hi[k][2],hi[k][3]}
    o[d0]=__builtin_amdgcn_mfma_f32_32x32x16_bf16(pa0,PK(0),o[d0],0,0,0);
    o[d0]=__builtin_amdgcn_mfma_f32_32x32x16_bf16(pa1,PK(1),o[d0],0,0,0);
    o[d0]=__builtin_amdgcn_mfma_f32_32x32x16_bf16(pa2,PK(2),o[d0],0,0,0);
    o[d0]=__builtin_amdgcn_mfma_f32_32x32x16_bf16(pa3,PK(3),o[d0],0,0,0);
    #undef PK
  }
}

#ifndef ATTN_STORE16
#define ATTN_STORE16(p,v) (*(u32x4*)(p)=(v))
#endif
template<int THRL> __device__ __forceinline__ void attn_unit(int b,int h,int qb,const bf16*Q,const bf16*__restrict__ K,const bf16*__restrict__ V,bf16*O,const float*__restrict__ cl,const float*__restrict__ tot,char*shm){
  int tid_=threadIdx.x; asm volatile("":"+v"(tid_)); const int tid=tid_,lane=tid&63,r32=lane&31,hi=lane>>5; const int wid=__builtin_amdgcn_readfirstlane(tid>>6);
  const long rowbase=(long)b*SEQ; const int q0=qb*QB;
  const bf16*Qw=Q+(rowbase+q0+wid*QBLK)*DM+h*D;
  const bf16*Kh=K+rowbase*DM+h*D,*Vh=V+rowbase*DM+h*D;
  const unsigned lds0=(unsigned)(uintptr_t)shm;
  float*wsf=(float*)(shm+LDS_WS)+wid*64;
  const bf16*ksrc=Kh+(long)lane*DM+wid*8;
  const bf16*vsrc=Vh+(long)(16*(wid&3)+(lane>>2))*DM+(wid>>2)*32+(lane&3)*8;
  const unsigned kdst=lds0+LDS_K+wid*1024, vdst=lds0+LDS_V+wid*1024;
  #define DMA_K(t,slot) glds16(ksrc+(long)(t)*KVBLK*DM,(unsigned)__builtin_amdgcn_readfirstlane(kdst+(slot)))
  #define DMA_V(t,slot) glds16(vsrc+(long)(t)*KVBLK*DM,(unsigned)__builtin_amdgcn_readfirstlane(vdst+(slot)))
  const int vb0=(int)(lds0+LDS_V)+((lane>>4)&1)*32+(lane&3)*8+(4*hi+((lane&15)>>2))*64;
  const char*Kbase=shm+LDS_K; bf16x8 kf[8];
  const lds_cptr shm3=(lds_cptr)shm; const lds_cptr kp0=shm3+LDS_K+hi*1024+r32*16; const lds_cptr vp0=shm3+LDS_V+((lane>>4)&1)*32+(lane&3)*8+(4*hi+((lane&15)>>2))*64;
  const int NT=(q0+QB)/KVBLK;

  typedef float f32x4_t __attribute__((ext_vector_type(4)));
  {
    const int j_=tid>>4; float Pj=0.f,Pq=0.f;
    for(int i=0;i<qb;++i){const float t_=tot[((b*32+i)*8)+h];Pq+=t_; if(i<j_)Pj+=t_;}
    const float*clh=cl+(size_t)(b*NHEAD+h)*SEQ;
    const float cref=clh[q0]+Pq;
    if(16*tid<q0+QB){
      __attribute__((address_space(3))) f32x4_t*dst=(__attribute__((address_space(3))) f32x4_t*)((__attribute__((address_space(3))) char*)shm+LDS_CB)+4*tid;
      #pragma unroll
      for(int c_=0;c_<4;++c_){ f32x4_t v_=*(const f32x4_t*)(clh+16*tid+4*c_); v_=(cref-(v_+Pj))*1.4426950408889634f; dst[c_]=v_; }
    }
  }
  #define CBIAS(P0,P1,t) do{ const lds_cptr cb_=shm3+LDS_CB+(t)*256+hi*16; \
    _Pragma("unroll") for(int j_=0;j_<4;++j_){ SBAR(); const f32x4_t b0_=*(const __attribute__((address_space(3))) f32x4_t*)(cb_+j_*32)-mhat; const f32x4_t b1_=*(const __attribute__((address_space(3))) f32x4_t*)(cb_+128+j_*32)-mhat; \
      P0[4*j_]+=b0_[0];P0[4*j_+1]+=b0_[1];P0[4*j_+2]+=b0_[2];P0[4*j_+3]+=b0_[3]; P1[4*j_]+=b1_[0];P1[4*j_+1]+=b1_[1];P1[4*j_+2]+=b1_[2];P1[4*j_+3]+=b1_[3]; } }while(0)
  DMA_K(0,0);DMA_V(0,0);DMA_K(1,SLOTB);
  bf16x8 qr[4];
  #pragma unroll
  for(int d0=0;d0<4;++d0)qr[d0]=*reinterpret_cast<const bf16x8*>(&Qw[(long)r32*DM+d0*16+hi*8]);
  float mhat=0.f,l_reg=0.f;f32x16 o[2];o[0]=f32x16{};o[1]=f32x16{};const f32x16 negm=f32x16{};
  const int qrel=wid*QBLK+r32;
  #define CMASK(P0,P1,t) do{int jb_=(t)-(NT-4); if(jb_>=0)cmask(P0,P1,jb_,qrel,hi);}while(0)
  bool resc=false;
  #define START(P0,P1) do{ const float rm=rowmax(P0,P1); resc=false; \
    { const float dl=__builtin_fmaxf(rm,0.f); mhat=fadd_s(mhat,dl); \
      _Pragma("unroll") for(int r=0;r<16;++r){P0[r]=fsub_s(P0[r],dl);P1[r]=fsub_s(P1[r],dl);} \
       } \
    _Pragma("unroll") for(int r=0;r<16;++r)P0[r]=__builtin_amdgcn_exp2f(P0[r]); }while(0)
  #define RESC() do{ if(resc){ asm volatile("s_waitcnt lgkmcnt(0)":::"memory"); \
      _Pragma("unroll") for(int d_=0;d_<2;++d_) _Pragma("unroll") for(int r=0;r<16;++r)o[d_][r]*=wsf[crow(r,hi)]; } }while(0)
  f32x16 pA0,pA1,pB0,pB1;
  int sl_prev=0,sl_cur=0,sl_next=SLOTB;
  #define ROT() do{sl_prev=sl_cur;sl_cur=sl_next;sl_next=(sl_next==(NSLOT-1)*SLOTB)?0:sl_next+SLOTB;}while(0)
  DMA_K(2,2*SLOTB);
  WAIT_BAR(3);
  qkt(pA0,pA1,Kbase,qr,negm,r32,hi);asm volatile("s_nop 15\n\ts_nop 7":"+v"(pA0),"+v"(pA1));CMASK(pA0,pA1,0);CBIAS(pA0,pA1,0);
  START(pA0,pA1);
  _Pragma("unroll") for(int r=0;r<16;++r)pA1[r]=__builtin_amdgcn_exp2f(pA1[r]);
  WAIT_BAR(0);
  DMA_K(3,0);DMA_V(1,SLOTB);
  ROT();
  kload8(kf,kp0+sl_cur);
  WAIT_BAR(2);
  s16x4 vlo[8],vhi[8]; u32x4 pw0,pw1,pw2,pw3;
  #define PKW(P,B) cvtpk_s(P[B],P[B+1])
  #define PAF(k) __builtin_bit_cast(bf16x8,pw##k)
  #define VFR(i) (bf16x8){vlo[i][0],vlo[i][1],vlo[i][2],vlo[i][3],vhi[i][0],vhi[i][1],vhi[i][2],vhi[i][3]}
  #define PIN(x) asm volatile("":"+v"(x))
  #define MX3(a,b,c) __builtin_fmaxf(__builtin_fmaxf((a),(b)),(c))
  #define GAPA(MF,A0,A1,A2,A3,W0,W1,PW) do{ MF; sacc+=A0; sacc+=A1; sacc+=A2; sacc+=A3; PIN(sacc); W0; W1; PIN(PW); SBAR(); }while(0)
  #define EX(v) __builtin_amdgcn_exp2f(v)
  #define GAPB(MF,X,B) do{ MF; X[B]=EX(X[B]); X[B+1]=EX(X[B+1]); X[B+2]=EX(X[B+2]); X[B+3]=EX(X[B+3]); PIN(X); SBAR(); }while(0)
  #define VRD(i) do{ vlo[i]=vtr(vp_+(((i)>>2)*4096+((i)&3)*1024)); vhi[i]=vtr(vp_+(((i)>>2)*4096+((i)&3)*1024+512)); }while(0)
  #define KRD(G,j) do{ if(G){ kload2(kf,kp0+sl_next,j); SBAR(); } }while(0)
  #define STEP(C0,C1,P0,P1,t,GK,GV,GL) do{ SBAR(); \
    const lds_cptr vp_=vp0+sl_prev; \
    VRD(0); SBAR(); float sacc=(P0[0]+P0[1]); \
    GAPA(C0=__builtin_amdgcn_mfma_f32_32x32x16_bf16(kf[0],qr[0],negm,0,0,0), P0[2],P0[3],P0[4],P0[5],     pw0[0]=PKW(P0,0), pw0[1]=PKW(P0,2), pw0); \
    VRD(4); SBAR(); GAPA(C1=__builtin_amdgcn_mfma_f32_32x32x16_bf16(kf[1],qr[0],negm,0,0,0), P0[6],P0[7],P0[8],P0[9],     pw0[2]=PKW(P0,4), pw0[3]=PKW(P0,6), pw0); \
    VRD(1); SBAR(); GAPA(C0=__builtin_amdgcn_mfma_f32_32x32x16_bf16(kf[2],qr[1],C0,0,0,0),   P0[10],P0[11],P0[12],P0[13], pw1[0]=PKW(P0,8), pw1[1]=PKW(P0,10), pw1); \
    VRD(5); SBAR(); GAPA(C1=__builtin_amdgcn_mfma_f32_32x32x16_bf16(kf[3],qr[1],C1,0,0,0),   P0[14],P0[15],P1[0],P1[1],   pw1[2]=PKW(P0,12),pw1[3]=PKW(P0,14), pw1); \
    VRD(2); SBAR(); GAPA(C0=__builtin_amdgcn_mfma_f32_32x32x16_bf16(kf[4],qr[2],C0,0,0,0),   P1[2],P1[3],P1[4],P1[5],     pw2[0]=PKW(P1,0), pw2[1]=PKW(P1,2), pw2); \
    VRD(6); SBAR(); GAPA(C1=__builtin_amdgcn_mfma_f32_32x32x16_bf16(kf[5],qr[2],C1,0,0,0),   P1[6],P1[7],P1[8],P1[9],     pw2[2]=PKW(P1,4), pw2[3]=PKW(P1,6), pw2); \
    VRD(3); SBAR(); GAPA(C0=__builtin_amdgcn_mfma_f32_32x32x16_bf16(kf[6],qr[3],C0,0,0,0),   P1[10],P1[11],P1[12],P1[13], pw3[0]=PKW(P1,8), pw3[1]=PKW(P1,10), pw3); \
    VRD(7); SBAR(); GAPA(C1=__builtin_amdgcn_mfma_f32_32x32x16_bf16(kf[7],qr[3],C1,0,0,0),   P1[14],P1[15],0.f,0.f,       pw3[2]=PKW(P1,12),pw3[3]=PKW(P1,14), pw3); \
    l_reg+=sacc; \
    if(GK){DMA_K((t)+3,sl_cur);} if(GV){DMA_V((t)+1,sl_next);} \
    CMASK(C0,C1,t); CBIAS(C0,C1,t); \
    { float a=MX3(C0[0],C0[1],C1[0]),b=MX3(C0[2],C0[3],C1[1]); a=MX3(a,C1[2],C1[3]); \
      _Pragma("unroll") for(int r=4;r<16;r+=4){a=MX3(a,C0[r],C0[r+1]);b=MX3(b,C0[r+2],C0[r+3]);a=MX3(a,C1[r],C1[r+1]);b=MX3(b,C1[r+2],C1[r+3]);} \
      float rm=__builtin_fmaxf(a,b); { auto rr=__builtin_amdgcn_permlane32_swap(__float_as_uint(rm),__float_as_uint(rm),false,false); rm=__builtin_fmaxf(__uint_as_float(rr[0]),__uint_as_float(rr[1])); } \
      resc=false; \
      if(__builtin_expect(__any(rm>(float)THRL),0)){ const float dl=__builtin_fmaxf(rm,0.f); mhat+=dl; \
        _Pragma("unroll") for(int r=0;r<16;++r){C0[r]-=dl;C1[r]-=dl;} \
         \
        const float f=__builtin_amdgcn_exp2f(-dl); l_reg*=f; if(hi==0)wsf[r32]=f; resc=true; } } \
    SBAR(); \
    GAPB(o[0]=__builtin_amdgcn_mfma_f32_32x32x16_bf16(PAF(0),VFR(0),o[0],0,0,0), C0,0); \
    GAPB(o[1]=__builtin_amdgcn_mfma_f32_32x32x16_bf16(PAF(0),VFR(4),o[1],0,0,0), C0,4); \
    KRD(GL,0); GAPB(o[0]=__builtin_amdgcn_mfma_f32_32x32x16_bf16(PAF(1),VFR(1),o[0],0,0,0), C0,8); \
    KRD(GL,1); GAPB(o[1]=__builtin_amdgcn_mfma_f32_32x32x16_bf16(PAF(1),VFR(5),o[1],0,0,0), C0,12); \
    KRD(GL,2); GAPB(o[0]=__builtin_amdgcn_mfma_f32_32x32x16_bf16(PAF(2),VFR(2),o[0],0,0,0), C1,0); \
    KRD(GL,3); GAPB(o[1]=__builtin_amdgcn_mfma_f32_32x32x16_bf16(PAF(2),VFR(6),o[1],0,0,0), C1,4); \
    GAPB(o[0]=__builtin_amdgcn_mfma_f32_32x32x16_bf16(PAF(3),VFR(3),o[0],0,0,0), C1,8); \
    GAPB(o[1]=__builtin_amdgcn_mfma_f32_32x32x16_bf16(PAF(3),VFR(7),o[1],0,0,0), C1,12); \
    }while(0)
  int t=1;
  #undef CMASK
  #define CMASK(P0,P1,t) do{}while(0)
  for(;t+5<NT;t+=2){
    STEP(pB0,pB1,pA0,pA1,t,true,true,true);     WAIT_BAR(2); RESC(); ROT();
    STEP(pA0,pA1,pB0,pB1,t+1,true,true,true);   WAIT_BAR(2); RESC(); ROT();
  }
  #undef CMASK
  #define CMASK(P0,P1,t) do{int jb_=(t)-(NT-4); if(jb_>=0)cmask(P0,P1,jb_,qrel,hi);}while(0)
  #define ENDW(tt) do{ if((tt)+3<NT){WAIT_BAR(2);} else if((tt)+2<NT){WAIT_BAR(1);} else {WAIT_BAR(0);} }while(0)
  for(;t+1<NT;t+=2){
    STEP(pB0,pB1,pA0,pA1,t,(t+3<NT),(t+1<NT),(t+1<NT));       ENDW(t);   RESC(); ROT();
    STEP(pA0,pA1,pB0,pB1,t+1,(t+4<NT),(t+2<NT),(t+2<NT));     ENDW(t+1); RESC(); ROT();
  }
  STEP(pB0,pB1,pA0,pA1,NT-1,false,false,false); RESC();
  { float sacc=pB0[0]+pB0[1]; _Pragma("unroll") for(int r=2;r<16;++r)sacc+=pB0[r]; _Pragma("unroll") for(int r=0;r<16;++r)sacc+=pB1[r]; l_reg+=sacc;
    pw0=(u32x4){PKW(pB0,0),PKW(pB0,2),PKW(pB0,4),PKW(pB0,6)};pw1=(u32x4){PKW(pB0,8),PKW(pB0,10),PKW(pB0,12),PKW(pB0,14)};pw2=(u32x4){PKW(pB1,0),PKW(pB1,2),PKW(pB1,4),PKW(pB1,6)};pw3=(u32x4){PKW(pB1,8),PKW(pB1,10),PKW(pB1,12),PKW(pB1,14)};
    SBAR(); pv(o,vb0+sl_cur,PAF(0),PAF(1),PAF(2),PAF(3)); }
  #undef PKW
  #undef PAF
  #undef VFR
  #undef PIN
  #undef MX3
  #undef GAPA
  #undef GAPB
  #undef EX
  #undef VRD
  #undef KRD
  #undef STEP
  #undef ENDW
  {auto rr=__builtin_amdgcn_permlane32_swap(__float_as_uint(l_reg),__float_as_uint(l_reg),false,false);l_reg=__uint_as_float(rr[0])+__uint_as_float(rr[1]);}
  if(hi==0)wsf[32+r32]=l_reg;asm volatile("s_waitcnt lgkmcnt(0)":::"memory");
  float rli[16];
  #pragma unroll
  for(int r=0;r<16;++r)rli[r]=__builtin_amdgcn_rcpf(wsf[32+crow(r,hi)]);
  bf16*Ow=O+(rowbase+q0+wid*QBLK)*DM+h*D;
  { bf16*stg=(bf16*)(shm+LDS_OST)+wid*2048;
    #pragma unroll
    for(int r=0;r<16;++r){const int orow=crow(r,hi);
      #pragma unroll
      for(int d0=0;d0<2;++d0)stg[orow*64+d0*32+r32]=__float2bfloat16(o[d0][r]*rli[r]);}
    asm volatile("s_waitcnt lgkmcnt(0)":::"memory");
    #pragma unroll
    for(int i=0;i<4;++i){const int row=i*8+(lane>>3),ch=lane&7; const u32x4 v=*(const u32x4*)(stg+row*64+ch*8); ATTN_STORE16(Ow+(long)row*DM+ch*8,v);} }
  asm volatile("s_waitcnt lgkmcnt(0)\n\ts_barrier":::"memory");
  #undef DMA_K
  #undef DMA_V
  #undef CMASK
  #undef CBIAS
  #undef START
  #undef RESC
  #undef ROT
}
constexpr int ATTN_LDS_BYTES=LDS_BYTES+32768;
#undef SBAR
#undef WAIT_BAR
}


constexpr int NB = 8, SEQ = 8192, DM = 1024, MROWS = NB * SEQ;
constexpr int DEPTH = 2, NIN = 4360, NZ = 4352, DFF = 2816;
constexpr float LN_EPS = 1e-5f;
constexpr float ALPHA = 1.4142135623730951f;
constexpr float LOG2E = 1.4426950408889634f;
constexpr float C2 = 0.125f * LOG2E;
constexpr int ZQA = 0, ZKA = 512, ZVA = 640, ZQB = 768, ZKB = 1280, ZVB = 1792, ZGA = 2304, ZGB = 3328;

constexpr size_t MiB = 1u << 20;
constexpr size_t W_IN_B = (size_t)NZ * 1024 * 2, W_PA_B = (size_t)1024 * 512 * 2, W_OUT_B = (size_t)1024 * 1024 * 2, W_FI_B = (size_t)5632 * 1024 * 2, W_FO_B = (size_t)1024 * 2816 * 2;
constexpr size_t WL_IN = 0, WL_PA = WL_IN + W_IN_B, WL_PB = WL_PA + W_PA_B, WL_OUT = WL_PB + W_PA_B, WL_FI = WL_OUT + W_OUT_B, WL_FO = WL_FI + W_FI_B, WL_BYTES = WL_FO + W_FO_B;
constexpr size_t WS_W = 1 * MiB;
constexpr size_t WS_CL = 64 * MiB;
constexpr size_t WS_TOT = 66 * MiB;
constexpr size_t WS_TAIL = 67 * MiB, WS_HP = 73 * MiB, WS_HU = 79 * MiB;
constexpr size_t WS_HB = 96 * MiB;
constexpr size_t WS_MG = 224 * MiB;
constexpr size_t WS_Z = 352 * MiB;
constexpr size_t WS_END = WS_Z + (size_t)MROWS * NZ * 2;
static_assert(WS_W + DEPTH * WL_BYTES <= WS_CL && WS_HU + 6 * MiB <= WS_HB, "d_ws map");
constexpr size_t ZPANEL_B = (size_t)256 * NZ * 2;

constexpr int RING_BYTES = 131072, TL_OFF = RING_BYTES, LDS_BYTES = 147456;
constexpr int NWAVES = 8;

#define GAS __attribute__((address_space(1)))
#define LAS __attribute__((address_space(3)))
typedef unsigned short bf16;
typedef unsigned v4u __attribute__((ext_vector_type(4)));
typedef unsigned v2u __attribute__((ext_vector_type(2)));
typedef float f32x4 __attribute__((ext_vector_type(4)));
typedef short bf16x8 __attribute__((ext_vector_type(8)));
typedef float f32x16 __attribute__((ext_vector_type(16)));
#define LDS_WAIT() asm volatile("s_waitcnt lgkmcnt(0)" ::: "memory")
__device__ __forceinline__ unsigned f2bf(float f) { unsigned u = __builtin_bit_cast(unsigned, f); return (u + 0x7fffu + ((u >> 16) & 1u)) >> 16; }
__device__ __forceinline__ unsigned pk2(float lo, float hi) { return f2bf(lo) | (f2bf(hi) << 16); }
__device__ __forceinline__ float wave_sum(float v) {
#pragma unroll
    for (int o = 1; o < 64; o <<= 1) v += __shfl_xor(v, o);
    return v;
}

__device__ __forceinline__ void transpose_item(const float* W, int ldw, int K, int k0, int src_col0, bf16* WT, int dst_row0, LAS float* scr, int lane) {
#pragma unroll 8
    for (int i = 0; i < 32; ++i) { const int kk = 2 * i + (lane >> 5); scr[kk * 33 + (lane & 31)] = W[(size_t)(k0 + kk) * ldw + src_col0 + (lane & 31)]; }
    LDS_WAIT(); asm volatile("" ::: "memory");
    const int c = lane & 7;
#pragma unroll
    for (int j = 0; j < 4; ++j) { const int n = (lane >> 3) + 8 * j; const LAS float* s = scr + (8 * c) * 33 + n;
        v4u o; o.x = pk2(s[0 * 33], s[1 * 33]); o.y = pk2(s[2 * 33], s[3 * 33]); o.z = pk2(s[4 * 33], s[5 * 33]); o.w = pk2(s[6 * 33], s[7 * 33]);
        *(GAS v4u*)(WT + (size_t)(dst_row0 + n) * K + k0 + 8 * c) = o; }
    LDS_WAIT(); asm volatile("" ::: "memory");
}

struct Args { const float* in[15]; float* out; unsigned char* ws; };

template <bool DO_LN, bool DO_F>
__device__ __forceinline__ void row_pass(LAS unsigned char* lds, int panel, const float* src, float* dstR, bf16* HB, const float* lg, const float* lb,
                                         const float* win_l, const float* bin_l, float* CL, float* TOT) {
    int tid_ = threadIdx.x; asm volatile("" : "+v"(tid_)); const int tid = tid_, lane = tid & 63, wave = __builtin_amdgcn_readfirstlane(tid >> 6);
    LAS float* lcl = (LAS float*)lds;
    LAS float* wtot = (LAS float*)(lds + 8192);
    f32x4 gv[4], bv[4];
    if (DO_LN) {
#pragma unroll
        for (int j = 0; j < 4; ++j) { gv[j] = *(const f32x4*)(lg + 256 * j + 4 * lane); bv[j] = *(const f32x4*)(lb + 256 * j + 4 * lane); }
    }
    for (int i = 0; i < 32; ++i) {
        const size_t row = (size_t)panel * 256 + wave * 32 + i;
        const GAS f32x4* xr = (const GAS f32x4*)(src + row * DM) + lane;
        f32x4 v[4]; float s = 0.f;
#pragma unroll
        for (int j = 0; j < 4; ++j) { v[j] = xr[64 * j]; s += (v[j].x + v[j].y) + (v[j].z + v[j].w); }
        if (DO_LN) {
            const float mean = wave_sum(s) * (1.f / DM); float s2 = 0.f;
#pragma unroll
            for (int j = 0; j < 4; ++j) { v[j] = v[j] - mean; s2 += (v[j].x * v[j].x + v[j].y * v[j].y) + (v[j].z * v[j].z + v[j].w * v[j].w); }
            const float rstd = 1.f / sqrtf(wave_sum(s2) * (1.f / DM) + LN_EPS);
            GAS f32x4* orow = (GAS f32x4*)(dstR + row * DM) + lane;
#pragma unroll
            for (int j = 0; j < 4; ++j) { v[j] = v[j] * rstd * gv[j] + bv[j]; orow[64 * j] = v[j]; }
        }
        GAS v2u* o8 = (GAS v2u*)(HB + row * DM) + lane;
#pragma unroll
        for (int j = 0; j < 4; ++j) { v2u w; w.x = pk2(v[j].x, v[j].y); w.y = pk2(v[j].z, v[j].w); o8[64 * j] = w; }
    }
    if (DO_F) {
        __syncthreads();
        const float* fsrc = DO_LN ? (const float*)dstR : src;
#pragma unroll 1
        for (int half = 0; half < 2; ++half) {
            f32x4 wfa[4][4]; float run = 0.f;
#pragma unroll
            for (int j = 0; j < 4; ++j)
#pragma unroll
                for (int e = 0; e < 4; ++e) wfa[j][e] = *(const f32x4*)(win_l + (size_t)(256 * j + 4 * lane + e) * NIN + 2304 + 4 * half);
            const float bf = bin_l[2304 + 4 * half + (lane & 3)];
            for (int i = 0; i < 32; ++i) {
                const size_t row = (size_t)panel * 256 + wave * 32 + i;
                const GAS f32x4* xr = (const GAS f32x4*)(fsrc + row * DM) + lane;
                f32x4 v[4];
#pragma unroll
                for (int j = 0; j < 4; ++j) v[j] = xr[64 * j];
                f32x4 pa = (f32x4){0.f, 0.f, 0.f, 0.f};
#pragma unroll
                for (int j = 0; j < 4; ++j) pa += wfa[j][0] * v[j].x + wfa[j][1] * v[j].y + wfa[j][2] * v[j].z + wfa[j][3] * v[j].w;
                float q[4] = {pa.x, pa.y, pa.z, pa.w};
#pragma unroll
                for (int h = 0; h < 4; ++h) q[h] = wave_sum(q[h]);
                float mine = q[0];
#pragma unroll
                for (int h = 1; h < 4; ++h) mine = ((lane & 3) == h) ? q[h] : mine;
                const float x = mine + bf;
                const float lf = fminf(x, 0.f) - log1pf(__expf(-fabsf(x)));
                run += lf;
                if (lane < 4) lcl[(wave * 32 + i) * 8 + 4 * half + lane] = run;
            }
            if (lane < 4) wtot[wave * 8 + 4 * half + lane] = run;
        }
        __syncthreads();
        const int b = panel >> 5, s0 = (panel & 31) * 256;
        for (int idx = tid; idx < 2048; idx += 512) { const int h = idx >> 8, r = idx & 255; float off = 0.f;
            for (int w = 0; w < (r >> 5); ++w) off += wtot[w * 8 + h];
            CL[((size_t)(b * 8 + h)) * SEQ + s0 + r] = lcl[r * 8 + h] + off; }
        if (tid < 8) { float t = 0.f; for (int w = 0; w < 8; ++w) t += wtot[w * 8 + tid]; TOT[panel * 8 + tid] = t; }
        __syncthreads();
    }
}

namespace swa {
constexpr int KSTR = 72, VSTR = 264;
constexpr int L_K = 0, L_VT = 256 * KSTR * 2, L_END = L_VT + 64 * VSTR * 2;
__device__ __forceinline__ int crow(int r, int hi) { return (r & 3) + 8 * (r >> 2) + 4 * hi; }
__device__ __forceinline__ void unit(int b, int hkv, int blk, bf16* Z, const float* sinks_l, LAS unsigned char* lds) {
    int tid_ = threadIdx.x; asm volatile("" : "+v"(tid_)); const int tid = tid_, lane = tid & 63, r32 = lane & 31, hi = lane >> 5; const int wid = __builtin_amdgcn_readfirstlane(tid >> 6);
    const size_t rowbase = (size_t)b * SEQ; const int k0 = blk * 128 - 128;
    {
        const int key = tid >> 1, half = tid & 1, kabs = k0 + key; const bool ok = kabs >= 0;
        const bf16* kp = Z + (rowbase + (ok ? kabs : 0)) * NZ + ZKA + hkv * 64 + 32 * half;
        const bf16* vp = Z + (rowbase + (ok ? kabs : 0)) * NZ + ZVA + hkv * 64 + 32 * half;
        v4u kv[4], vv[4];
#pragma unroll
        for (int c = 0; c < 4; ++c) { kv[c] = *(const GAS v4u*)(kp + 8 * c); vv[c] = *(const GAS v4u*)(vp + 8 * c); if (!ok) { kv[c] = (v4u){0u, 0u, 0u, 0u}; vv[c] = (v4u){0u, 0u, 0u, 0u}; } }
        LAS bf16* KL = (LAS bf16*)(lds + L_K); LAS bf16* VT = (LAS bf16*)(lds + L_VT);
#pragma unroll
        for (int c = 0; c < 4; ++c) {
            *(LAS v4u*)(KL + key * KSTR + 32 * half + 8 * c) = kv[c];
            const unsigned w[4] = {vv[c].x, vv[c].y, vv[c].z, vv[c].w};
#pragma unroll
            for (int e = 0; e < 4; ++e) { const int d = 32 * half + 8 * c + 2 * e; VT[d * VSTR + key] = (bf16)(w[e] & 0xffffu); VT[(d + 1) * VSTR + key] = (bf16)(w[e] >> 16); }
        }
    }
    __syncthreads();
    const LAS unsigned char* KLb = lds + L_K; const LAS unsigned char* VTb = lds + L_VT;
    for (int task = wid; task < 16; task += 8) {
        const int g = task >> 2, qt = task & 3, hq = hkv * 4 + g, i0 = blk * 128 + 32 * qt;
        bf16* qrow = Z + (rowbase + i0 + r32) * NZ + ZQA + hq * 64;
        bf16x8 qf[4];
#pragma unroll
        for (int d0 = 0; d0 < 4; ++d0) qf[d0] = *(const GAS bf16x8*)(qrow + 16 * d0 + 8 * hi);
        const float slope2 = exp2f(-(float)(hq + 1)) * LOG2E, sink2 = sinks_l[hq] * LOG2E;
        f32x16 s[5];
#pragma unroll
        for (int jt = 0; jt < 5; ++jt) {
            s[jt] = (f32x16){};
            const int slot = 32 * qt + 32 * jt + r32;
#pragma unroll
            for (int d0 = 0; d0 < 4; ++d0) { const bf16x8 a = *(const LAS bf16x8*)(KLb + (slot * KSTR + 16 * d0 + 8 * hi) * 2); s[jt] = __builtin_amdgcn_mfma_f32_32x32x16_bf16(a, qf[d0], s[jt], 0, 0, 0); }
        }
        float m = sink2;
#pragma unroll
        for (int jt = 0; jt < 5; ++jt)
#pragma unroll
            for (int r = 0; r < 16; ++r) {
                const int kslot = 32 * qt + 32 * jt + crow(r, hi);
                const int dist = 128 + r32 - 32 * jt - crow(r, hi);
                const bool ok = (dist >= 0) && (dist < 128) && (k0 + kslot >= 0);
                const float v = ok ? (s[jt][r] - slope2 * (float)dist) : -INFINITY;
                s[jt][r] = v; m = fmaxf(m, v);
            }
        m = fmaxf(m, __shfl_xor(m, 32));
        float l = 0.f;
#pragma unroll
        for (int jt = 0; jt < 5; ++jt)
#pragma unroll
            for (int r = 0; r < 16; ++r) { const float p = __builtin_amdgcn_exp2f(s[jt][r] - m); s[jt][r] = p; l += p; }
        l += __shfl_xor(l, 32);
        l += __builtin_amdgcn_exp2f(sink2 - m);
        const float inv = 1.0f / l;
#pragma unroll
        for (int dh = 0; dh < 2; ++dh) {
            f32x16 o = (f32x16){};
#pragma unroll
            for (int jt = 0; jt < 5; ++jt)
#pragma unroll
                for (int ks = 0; ks < 2; ++ks) {
                    v4u pw; pw.x = pg8::cvt_pk_bf16(s[jt][8 * ks + 0], s[jt][8 * ks + 1]); pw.y = pg8::cvt_pk_bf16(s[jt][8 * ks + 2], s[jt][8 * ks + 3]);
                    pw.z = pg8::cvt_pk_bf16(s[jt][8 * ks + 4], s[jt][8 * ks + 5]); pw.w = pg8::cvt_pk_bf16(s[jt][8 * ks + 6], s[jt][8 * ks + 7]);
                    const int d = 32 * dh + r32, slot = 32 * qt + 32 * jt + 16 * ks + 4 * hi;
                    const v2u lo = *(const LAS v2u*)(VTb + (d * VSTR + slot) * 2), hi8 = *(const LAS v2u*)(VTb + (d * VSTR + slot + 8) * 2);
                    const v4u av = (v4u){lo.x, lo.y, hi8.x, hi8.y};
                    o = __builtin_amdgcn_mfma_f32_32x32x16_bf16(__builtin_bit_cast(bf16x8, av), __builtin_bit_cast(bf16x8, pw), o, 0, 0, 0);
                }
#pragma unroll
            for (int j = 0; j < 4; ++j) { v2u w; w.x = pg8::cvt_pk_bf16(o[4 * j] * inv, o[4 * j + 1] * inv); w.y = pg8::cvt_pk_bf16(o[4 * j + 2] * inv, o[4 * j + 3] * inv);
                *(GAS v2u*)(qrow + 32 * dh + 8 * j + 4 * hi) = w; }
        }
    }
    __syncthreads();
}
}

__global__ void __launch_bounds__(NWAVES * 64, 2) hybrid_fwd(Args args) {
    extern __shared__ __attribute__((aligned(16))) unsigned char lds_raw[];
    cg::grid_group grid = cg::this_grid();
    LAS unsigned char* lds = (LAS unsigned char*)lds_raw;
    const int tid = threadIdx.x, lane = tid & 63, wave = __builtin_amdgcn_readfirstlane(tid >> 6);
    const int G = gridDim.x, bx = blockIdx.x;
    const int vcu = (bx % 8) * (G / 8) + bx / 8;
    const int panel = vcu;
    unsigned char* ws = args.ws;
    const float* x = args.in[0];
    float* R = args.out;
    bf16* HB = (bf16*)(ws + WS_HB); bf16* MG = (bf16*)(ws + WS_MG); bf16* Z = (bf16*)(ws + WS_Z);
    float* CL = (float*)(ws + WS_CL); float* TOT = (float*)(ws + WS_TOT);
    float* TAIL = (float*)(ws + WS_TAIL); float* HP = (float*)(ws + WS_HP); float* HU = (float*)(ws + WS_HU);
    bf16* Hpanel = (bf16*)(ws + WS_Z + (size_t)panel * ZPANEL_B);
    bf16* Hadj = Hpanel - (size_t)panel * 256 * DFF;

    {
        LAS float* scr = (LAS float*)(lds + wave * 16384);
        const int gw = bx * NWAVES + wave, NGW = G * NWAVES;
        constexpr int I_IN = 16 * (NZ / 32), I_PA = 8 * 32, I_OUT = 16 * 32, I_FI = 16 * (5632 / 32), I_FO = 44 * 32, I_L = I_IN + 2 * I_PA + I_OUT + I_FI + I_FO;
        for (int it = gw; it < DEPTH * I_L; it += NGW) {
            const int l = it / I_L; int r = it % I_L;
            unsigned char* wl = ws + WS_W + (size_t)l * WL_BYTES;
            if (r < I_IN) { const int nblk = NZ / 32, kb = r / nblk, nb = r % nblk, n0 = 32 * nb;
                transpose_item(args.in[3] + (size_t)l * 1024 * NIN, NIN, 1024, 64 * kb, n0 + (n0 >= 2304 ? 8 : 0), (bf16*)(wl + WL_IN), n0, scr, lane); continue; } r -= I_IN;
            if (r < I_PA) { const int kb = r / 32, nb = r % 32; transpose_item(args.in[6] + (size_t)l * 512 * 1024, 1024, 512, 64 * kb, 32 * nb, (bf16*)(wl + WL_PA), 32 * nb, scr, lane); continue; } r -= I_PA;
            if (r < I_PA) { const int kb = r / 32, nb = r % 32; transpose_item(args.in[7] + (size_t)l * 512 * 1024, 1024, 512, 64 * kb, 32 * nb, (bf16*)(wl + WL_PB), 32 * nb, scr, lane); continue; } r -= I_PA;
            if (r < I_OUT) { const int kb = r / 32, nb = r % 32; transpose_item(args.in[8] + (size_t)l * 1024 * 1024, 1024, 1024, 64 * kb, 32 * nb, (bf16*)(wl + WL_OUT), 32 * nb, scr, lane); continue; } r -= I_OUT;
            if (r < I_FI) { const int nblk = 5632 / 32, kb = r / nblk, nb = r % nblk, n0 = 32 * nb, pn = n0 >> 8, j = n0 & 255;
                const int src = (j < 128) ? (128 * pn + j) : (DFF + 128 * pn + (j - 128));
                transpose_item(args.in[11] + (size_t)l * 1024 * 5632, 5632, 1024, 64 * kb, src, (bf16*)(wl + WL_FI), n0, scr, lane); continue; } r -= I_FI;
            { const int kb = r / 32, nb = r % 32; transpose_item(args.in[14] + (size_t)l * DFF * 1024, 1024, DFF, 64 * kb, 32 * nb, (bf16*)(wl + WL_FO), 32 * nb, scr, lane); }
        }
        __syncthreads();
#if !defined(NO_ROWF)
        row_pass<false, true>(lds, panel, x, nullptr, HB, nullptr, nullptr, args.in[3], args.in[4], CL, TOT);
#endif
    }
    grid.sync();

    for (int l = 0; l < DEPTH; ++l) {
        unsigned char* wl = ws + WS_W + (size_t)l * WL_BYTES;
        const float* resid_in = (l == 0) ? x : R;
        {
            pg8::Gemm g{HB, (const bf16*)(wl + WL_IN), MROWS, NZ, 1024, 1024}; pg8::PanelOrder S{panel, NZ / 256};
            pg8::EpiZ E{Z, NZ, args.in[4] + (size_t)l * NIN, C2};

#if !defined(NO_G1)
pg8::gemm_phase<pg8::EpiZ, pg8::PanelOrder, true, true>(lds, g, S, E);
#endif
#if defined(PROBE_G)
__syncthreads(); pg8::gemm_phase<pg8::EpiZ, pg8::PanelOrder, true, true>(lds, g, S, E);
#endif

        }
        grid.sync();
        {
            const int bh = vcu >> 2, sft = vcu & 3;
#pragma unroll 1
            for (int i = 0; i < 8; ++i) {
                const int base = (i >> 1) * 8, qb = (i & 1) ? (base + 7 - sft) : (base + sft);
#if defined(PROBE_A)
                { attn_body::bf16* Od = (attn_body::bf16*)(ws + WS_END) - ((size_t)((bh >> 3) * SEQ + qb * 256) * NZ + (bh & 7) * 64);
                  attn_body::attn_unit<8>(bh >> 3, bh & 7, qb, (const attn_body::bf16*)(Z + ZQB), (const attn_body::bf16*)(Z + ZKB), (const attn_body::bf16*)(Z + ZVB), Od, CL, TOT, (char*)lds_raw); }
#endif
#if !defined(NO_ATT)
                attn_body::attn_unit<8>(bh >> 3, bh & 7, qb, (const attn_body::bf16*)(Z + ZQB), (const attn_body::bf16*)(Z + ZKB), (const attn_body::bf16*)(Z + ZVB), (attn_body::bf16*)(Z + ZQB), CL, TOT, (char*)lds_raw);
#endif
            }
            __syncthreads();
#pragma unroll 1
            for (int i = 0; i < 4; ++i) { const int uid = vcu * 4 + i;
#if !defined(NO_SWA)
 swa::unit(uid >> 7, (uid >> 6) & 1, uid & 63, Z, args.in[5] + l * 8, lds);
#endif
 }
        }
        grid.sync();
        {
            pg8::PanelOrder S{panel, 4};
            { pg8::Gemm g{Z + ZQA, (const bf16*)(wl + WL_PA), MROWS, 1024, 512, NZ}; pg8::EpiGate<false> E{MG, Z + ZGA, NZ};

#if !defined(NO_G2)
pg8::gemm_phase<pg8::EpiGate<false>, pg8::PanelOrder, true, true>(lds, g, S, E);
#endif
 }
            __syncthreads();
            { pg8::Gemm g{Z + ZQB, (const bf16*)(wl + WL_PB), MROWS, 1024, 512, NZ}; pg8::EpiGate<true> E{MG, Z + ZGB, NZ};

#if !defined(NO_G2)
pg8::gemm_phase<pg8::EpiGate<true>, pg8::PanelOrder, true, true>(lds, g, S, E);
#endif
 }
            __syncthreads();
            { pg8::Gemm g{MG, (const bf16*)(wl + WL_OUT), MROWS, 1024, 1024, 1024}; pg8::EpiRes E{resid_in, R, ALPHA};

#if !defined(NO_G3)
pg8::gemm_phase<pg8::EpiRes, pg8::PanelOrder, true, true>(lds, g, S, E);
#endif
 }
            __syncthreads();
            row_pass<true, false>(lds, panel, R, R, HB, args.in[1] + l * DM, args.in[2] + l * DM, nullptr, nullptr, nullptr, nullptr);
            __syncthreads();
        }
        {
            pg8::Gemm g{HB, (const bf16*)(wl + WL_FI), MROWS, 5632, 1024, 1024}; pg8::PanelOrder S{panel, 22};
            pg8::EpiConv E{Hadj, args.in[12] + (size_t)l * 3 * DFF, args.in[13] + (size_t)l * DFF, TAIL, HP, HU, (LAS float*)(lds + TL_OFF)};
#if !defined(NO_CONV)
            pg8::gemm_phase<pg8::EpiConv, pg8::PanelOrder, true, true>(lds, g, S, E);
#endif
#if defined(PROBE_G)
            __syncthreads(); pg8::gemm_phase<pg8::EpiConv, pg8::PanelOrder, true, true>(lds, g, S, E);
#endif
        }
        grid.sync();
        {
            const float* cw = args.in[12] + (size_t)l * 3 * DFF;
            const bool first = (panel & 31) == 0;
            int tidf = threadIdx.x; asm volatile("" : "+v"(tidf));
            for (int idx = tidf; idx < 2 * DFF; idx += 512) { const int r = idx / DFF, c = idx % DFF;
                float t0 = 0.f, t1 = 0.f;
                if (!first) { t0 = TAIL[((size_t)(panel - 1) * 2 + 0) * DFF + c]; t1 = TAIL[((size_t)(panel - 1) * 2 + 1) * DFF + c]; }
                float cv = HP[((size_t)panel * 2 + r) * DFF + c];
                cv += (r == 0) ? (cw[c] * t0 + cw[DFF + c] * t1) : (cw[c] * t1);
                const float hv = cv * pg8::sigmoidf_(cv) * HU[((size_t)panel * 2 + r) * DFF + c];
                Hpanel[(size_t)r * DFF + c] = (bf16)f2bf(hv); }
            __syncthreads();
            { pg8::Gemm g{Hadj, (const bf16*)(wl + WL_FO), MROWS, 1024, DFF, DFF}; pg8::PanelOrder S{panel, 4}; pg8::EpiRes E{R, R, ALPHA};

#if !defined(NO_G3)
pg8::gemm_phase<pg8::EpiRes, pg8::PanelOrder, true, true>(lds, g, S, E);
#endif
 }
            __syncthreads();
#if !defined(NO_ROWF)
            if (l + 1 < DEPTH) row_pass<true, true>(lds, panel, R, R, HB, args.in[9] + l * DM, args.in[10] + l * DM, args.in[3] + (size_t)(l + 1) * 1024 * NIN, args.in[4] + (size_t)(l + 1) * NIN, CL, TOT);
            else
#endif
            row_pass<true, false>(lds, panel, R, R, HB, args.in[9] + l * DM, args.in[10] + l * DM, nullptr, nullptr, nullptr, nullptr);
            __syncthreads();
        }
    }
}

extern "C" void kernel_launch(void* const* d_in, const int* in_sizes, int n_in, void* d_out, int out_size, void* d_ws, size_t ws_size, hipStream_t stream) {
    static int grid = 0;
    if (grid == 0) {
        if (n_in != 15 || in_sizes[0] != MROWS * DM || out_size != MROWS * DM || ws_size < WS_END) { fprintf(stderr, "kernel_launch: unexpected shapes / workspace (n_in %d, in0 %d, out %d, ws %zu < %zu)\n", n_in, n_in > 0 ? in_sizes[0] : -1, out_size, ws_size, (size_t)WS_END); grid = -1; return; }
        int dev = 0, cus = 0, per_cu = 0;
        (void)hipGetDevice(&dev); (void)hipDeviceGetAttribute(&cus, hipDeviceAttributeMultiprocessorCount, dev);
        if (hipFuncSetAttribute((const void*)hybrid_fwd, hipFuncAttributeMaxDynamicSharedMemorySize, LDS_BYTES) != hipSuccess) { fprintf(stderr, "kernel_launch: hipFuncSetAttribute failed\n"); grid = -1; return; }
        (void)hipOccupancyMaxActiveBlocksPerMultiprocessor(&per_cu, (const void*)hybrid_fwd, NWAVES * 64, LDS_BYTES);
        (void)hipGetLastError();
        if (cus * per_cu < 256) fprintf(stderr, "kernel_launch: note: occupancy query says %d x %d workgroups; launching 256 anyway (the cooperative launch checks residency)\n", cus, per_cu);
        grid = 256;
    }
    if (grid < 0) return;
    Args a{};
    for (int i = 0; i < 15; ++i) a.in[i] = (const float*)d_in[i];
    a.out = (float*)d_out; a.ws = (unsigned char*)d_ws;
    void* kargs[] = {&a};
    hipError_t e = hipLaunchCooperativeKernel((const void*)hybrid_fwd, dim3(grid), dim3(NWAVES * 64), kargs, LDS_BYTES, stream);
    if (e != hipSuccess) fprintf(stderr, "kernel_launch: cooperative launch failed: %s\n", hipGetErrorString(e));
}
```

```cpp
#include <hip/hip_runtime.h>
#include <hip/hip_cooperative_groups.h>
#include <hip/hip_bf16.h>
#include <cstdio>
#include <cstdint>
#include <cmath>
namespace cg = cooperative_groups;

namespace pg8 {
#define PG8_LAS __attribute__((address_space(3)))
typedef unsigned short bf16_t;
typedef short bf16x8 __attribute__((ext_vector_type(8)));
typedef float f32x4 __attribute__((ext_vector_type(4)));
typedef unsigned u32x4 __attribute__((ext_vector_type(4)));
constexpr int BM = 256, BK = 64, HALF = 128, HTB = HALF * BK * 2  , STAGE_BYTES = 8 * HTB;

__host__ __device__ __forceinline__ int lds_byte(int r, int c) { const int st = (r >> 4) * 2 + (c >> 5), rr = r & 15, cc = c & 31, ob = rr * 64 + cc * 2; return st * 1024 + (ob ^ (((ob >> 9) & 1) << 5)); }
__host__ __device__ __forceinline__ void stage_rc(int b, int& R, int& C) { const int st = b / 1024, sb = b % 1024, swz = sb ^ (((sb >> 9) & 1) << 5); R = (st >> 1) * 16 + swz / 64; C = (st & 1) * 32 + (swz % 64) / 2; }
__host__ __device__ __forceinline__ int perm32(int rho) { const int n = rho >> 4, i = rho & 15; return 8 * (i >> 2) + 4 * n + (i & 3); }

struct Unit { int pm, pn; };
struct Gemm { const bf16_t* A; const bf16_t* Bt; int M, N, K, lda; };

struct PanelOrder {
    int pm, nN;
    __device__ __forceinline__ bool next(int i, Unit& u) const { if (i >= nN) return false; u.pm = pm; u.pn = i; return true; }
    __device__ __forceinline__ void a_ready(const Unit&) const {}
    __device__ __forceinline__ void done(const Unit&) const {}
};

struct GroupOrder {
    int gp0, j, nN;
    __device__ __forceinline__ bool next(int i, Unit& u) const { if (i >= nN) return false; const int L = i * 32 + j, per = 8 * nN, pg = L / per, rem = L - pg * per; u.pm = gp0 + 8 * pg + (rem & 7); u.pn = rem >> 3; return true; }
    __device__ __forceinline__ void a_ready(const Unit&) const {}
    __device__ __forceinline__ void done(const Unit&) const {}
};

__device__ __forceinline__ unsigned cvt_pk_bf16(float lo, float hi) { unsigned r; asm volatile("v_cvt_pk_bf16_f32 %0, %1, %2" : "=v"(r) : "v"(lo), "v"(hi)); return r; }
__device__ __forceinline__ float bf_lo(unsigned w) { return __uint_as_float(w << 16); }
__device__ __forceinline__ float bf_hi(unsigned w) { return __uint_as_float(w & 0xffff0000u); }
__device__ __forceinline__ float sigmoidf_(float x) { return __builtin_amdgcn_rcpf(1.0f + __expf(-x)); }


struct EpiZ {
    static constexpr bool PERM = true, AFTER_DRAIN = false;
    bf16_t* O; int ldc; const float* bias; float qscale; unsigned* QN; unsigned* KN;
    __device__ __forceinline__ void operator()(const f32x4 (&acc)[2][2][4][2], const Unit& u, int wr, int wc, int fr_in, int fq_in) const {
        int fr = fr_in, fq = fq_in; asm volatile("" : "+v"(fr), "+v"(fq));
        const int row0 = u.pm * BM + wr * 64 + fr; const int col0 = u.pn * BM + wc * 32 + 8 * fq;
        const float sc = (u.pn == 0 || u.pn == 1 || u.pn == 3 || u.pn == 4) ? qscale : 1.f;
        f32x4 bv[2][2];
#pragma unroll
        for (int bj = 0; bj < 2; ++bj)
#pragma unroll
            for (int n = 0; n < 2; ++n) { const int c = col0 + bj * HALF + 4 * n; bv[bj][n] = *(const f32x4*)(bias + c + (c >= 2304 ? 8 : 0)); }
#pragma unroll
        for (int ai = 0; ai < 2; ++ai)
#pragma unroll
            for (int m = 0; m < 4; ++m) { bf16_t* rowp = O + (size_t)(row0 + ai * HALF + m * 16) * ldc + col0;
#pragma unroll
                for (int bj = 0; bj < 2; ++bj) { f32x4 v0 = (acc[ai][bj][m][0] + bv[bj][0]) * sc, v1 = (acc[ai][bj][m][1] + bv[bj][1]) * sc;
                    u32x4 w; w.x = cvt_pk_bf16(v0[0], v0[1]); w.y = cvt_pk_bf16(v0[2], v0[3]); w.z = cvt_pk_bf16(v1[0], v1[1]); w.w = cvt_pk_bf16(v1[2], v1[3]);
                    *(u32x4*)(rowp + bj * HALF) = w; } }
        if (u.pn >= 3 && u.pn <= 6) {
            const int lane = fq * 16 + fr;
#pragma unroll
            for (int bj = 0; bj < 2; ++bj) {
                float mx = 0.f;
#pragma unroll
                for (int ai = 0; ai < 2; ++ai)
#pragma unroll
                    for (int m = 0; m < 4; ++m) { const f32x4 v0 = (acc[ai][bj][m][0] + bv[bj][0]) * sc, v1 = (acc[ai][bj][m][1] + bv[bj][1]) * sc;
                        float s = (v0[0] * v0[0] + v0[1] * v0[1]) + (v0[2] * v0[2] + v0[3] * v0[3]) + (v1[0] * v1[0] + v1[1] * v1[1]) + (v1[2] * v1[2] + v1[3] * v1[3]);
                        s += __shfl_xor(s, 16); s += __shfl_xor(s, 32); mx = fmaxf(mx, s); }
                mx = fmaxf(mx, __shfl_xor(mx, 1)); mx = fmaxf(mx, __shfl_xor(mx, 2)); mx = fmaxf(mx, __shfl_xor(mx, 4)); mx = fmaxf(mx, __shfl_xor(mx, 8));
                if (lane == 0) { const int hl = 2 * bj + (wc >> 1), half = wc & 1;
                    if (u.pn <= 4) atomicMax(QN + ((u.pm * 8 + 4 * (u.pn - 3) + hl) * 2 + half), __float_as_uint(mx));
                    else atomicMax(KN + (((u.pm >> 5) * 8 + 4 * (u.pn - 5) + hl) * 2 + half), __float_as_uint(mx)); }
            }
        }
    }
};

template <bool SECOND> struct EpiGate {
    static constexpr bool PERM = true, AFTER_DRAIN = false;
    bf16_t* MG; const bf16_t* G; int ldg;
    __device__ __forceinline__ void operator()(const f32x4 (&acc)[2][2][4][2], const Unit& u, int wr, int wc, int fr_in, int fq_in) const {
        int fr = fr_in, fq = fq_in; asm volatile("" : "+v"(fr), "+v"(fq));
        const int row0 = u.pm * BM + wr * 64 + fr; const int col0 = u.pn * BM + wc * 32 + 8 * fq;
#pragma unroll
        for (int ai = 0; ai < 2; ++ai)
#pragma unroll
            for (int m = 0; m < 4; ++m) { const size_t row = (size_t)(row0 + ai * HALF + m * 16);
#pragma unroll
                for (int bj = 0; bj < 2; ++bj) {
                    const u32x4 gw = *(const u32x4*)(G + row * ldg + col0 + bj * HALF);
                    bf16_t* mp = MG + row * 1024 + col0 + bj * HALF;
                    const f32x4 a0 = acc[ai][bj][m][0], a1 = acc[ai][bj][m][1];
                    float v[8];
                    v[0] = sigmoidf_(bf_lo(gw.x)) * a0[0]; v[1] = sigmoidf_(bf_hi(gw.x)) * a0[1]; v[2] = sigmoidf_(bf_lo(gw.y)) * a0[2]; v[3] = sigmoidf_(bf_hi(gw.y)) * a0[3];
                    v[4] = sigmoidf_(bf_lo(gw.z)) * a1[0]; v[5] = sigmoidf_(bf_hi(gw.z)) * a1[1]; v[6] = sigmoidf_(bf_lo(gw.w)) * a1[2]; v[7] = sigmoidf_(bf_hi(gw.w)) * a1[3];
                    if (SECOND) { const u32x4 pw = *(const u32x4*)mp;
                        v[0] += bf_lo(pw.x); v[1] += bf_hi(pw.x); v[2] += bf_lo(pw.y); v[3] += bf_hi(pw.y); v[4] += bf_lo(pw.z); v[5] += bf_hi(pw.z); v[6] += bf_lo(pw.w); v[7] += bf_hi(pw.w); }
                    u32x4 w; w.x = cvt_pk_bf16(v[0], v[1]); w.y = cvt_pk_bf16(v[2], v[3]); w.z = cvt_pk_bf16(v[4], v[5]); w.w = cvt_pk_bf16(v[6], v[7]);
                    *(u32x4*)mp = w; } }
    }
};

struct EpiRes {
    static constexpr bool PERM = true, AFTER_DRAIN = false;
    const float* base; float* out; float alpha;
    __device__ __forceinline__ void operator()(const f32x4 (&acc)[2][2][4][2], const Unit& u, int wr, int wc, int fr_in, int fq_in) const {
        int fr = fr_in, fq = fq_in; asm volatile("" : "+v"(fr), "+v"(fq));
        const int row0 = u.pm * BM + wr * 64 + fr; const int col0 = u.pn * BM + wc * 32 + 8 * fq;
#pragma unroll
        for (int ai = 0; ai < 2; ++ai)
#pragma unroll
            for (int m = 0; m < 4; ++m) { const size_t off = (size_t)(row0 + ai * HALF + m * 16) * 1024 + col0;
#pragma unroll
                for (int bj = 0; bj < 2; ++bj) {
                    const f32x4 b0 = *(const f32x4*)(base + off + bj * HALF), b1 = *(const f32x4*)(base + off + bj * HALF + 4);
                    *(f32x4*)(out + off + bj * HALF) = b0 * alpha + acc[ai][bj][m][0];
                    *(f32x4*)(out + off + bj * HALF + 4) = b1 * alpha + acc[ai][bj][m][1]; } }
    }
};

__device__ __forceinline__ float dpp_shr1(float v) { return __builtin_bit_cast(float, __builtin_amdgcn_update_dpp(0, __builtin_bit_cast(int, v), 0x111, 0xf, 0xf, true)); }
__device__ __forceinline__ float dpp_shr2(float v) { return __builtin_bit_cast(float, __builtin_amdgcn_update_dpp(0, __builtin_bit_cast(int, v), 0x112, 0xf, 0xf, true)); }
__device__ __forceinline__ float lane_get(float v, int src_lane) { return __builtin_bit_cast(float, __builtin_amdgcn_ds_bpermute(src_lane * 4, __builtin_bit_cast(int, v))); }

struct EpiConv {
    static constexpr bool PERM = true, AFTER_DRAIN = false;
    bf16_t* HZ;
    const float* cw; const float* cb;
    float* TAIL; float* HP; float* HU;
    PG8_LAS float* tl;
    __device__ __forceinline__ void operator()(const f32x4 (&acc)[2][2][4][2], const Unit& u, int wr, int wc, int fr_in, int fq_in) const {
        int fr = fr_in, fq = fq_in; asm volatile("" : "+v"(fr), "+v"(fq));
        const int lane = fq * 16 + fr;
        const int colw = wc * 32 + 8 * fq; const int hc0 = u.pn * 128 + colw;
        if (fr >= 14) {
#pragma unroll
            for (int ai = 0; ai < 2; ++ai)
#pragma unroll
                for (int n = 0; n < 2; ++n) *(PG8_LAS f32x4*)(tl + ((ai * 2 + wr) * 2 + (fr - 14)) * 128 + colw + 4 * n) = acc[ai][0][3][n];
            if (wr == 1) {
#pragma unroll
                for (int n = 0; n < 2; ++n) *(f32x4*)(TAIL + ((size_t)u.pm * 2 + (fr - 14)) * 2816 + hc0 + 4 * n) = acc[1][0][3][n];
            }
        }
        asm volatile("s_waitcnt lgkmcnt(0)" ::: "memory"); __builtin_amdgcn_s_barrier(); asm volatile("" ::: "memory");
        const int l15 = (lane & 48) + 15, l14f = (lane & 48) + 14 + (fr & 1);
#pragma unroll
        for (int n = 0; n < 2; ++n) {
            const f32x4 w0 = *(const f32x4*)(cw + hc0 + 4 * n), w1 = *(const f32x4*)(cw + 2816 + hc0 + 4 * n), w2 = *(const f32x4*)(cw + 5632 + hc0 + 4 * n), bb = *(const f32x4*)(cb + hc0 + 4 * n);
#pragma unroll
            for (int ai = 0; ai < 2; ++ai) {
                const int lin = ai * 2 + wr;
                f32x4 hA = (f32x4){0.f, 0.f, 0.f, 0.f}, hB = (f32x4){0.f, 0.f, 0.f, 0.f};
                if (lin > 0) { hA = *(const PG8_LAS f32x4*)(tl + ((lin - 1) * 2 + 1) * 128 + colw + 4 * n); hB = *(const PG8_LAS f32x4*)(tl + ((lin - 1) * 2 + 0) * 128 + colw + 4 * n); }
#pragma unroll
                for (int m = 0; m < 4; ++m) {
                    float hv[4], cv[4];
#pragma unroll
                    for (int e = 0; e < 4; ++e) {
                        const float G = acc[ai][0][m][n][e];
                        float X, Y;
                        if (m == 0) { X = hA[e]; Y = (fr == 0) ? hB[e] : hA[e]; }
                        else { const float Gp = acc[ai][0][m - 1][n][e]; X = lane_get(Gp, l15); Y = lane_get(Gp, l14f); }
                        const float s1 = dpp_shr1(G), s2 = dpp_shr2(G);
                        const float p1 = (fr >= 1) ? s1 : X, p2 = (fr >= 2) ? s2 : Y;
                        const float c = bb[e] + w0[e] * p2 + w1[e] * p1 + w2[e] * G;
                        cv[e] = c;
                        hv[e] = c * sigmoidf_(c) * acc[ai][1][m][n][e];
                    }
                    const int rl = ai * HALF + wr * 64 + m * 16 + fr;
                    typedef unsigned u32x2 __attribute__((ext_vector_type(2)));
                    u32x2 w; w.x = cvt_pk_bf16(hv[0], hv[1]); w.y = cvt_pk_bf16(hv[2], hv[3]);
                    *(u32x2*)(HZ + (size_t)u.pm * (256 * 4352) + rl * 2816 + hc0 + 4 * n) = w;
                    if (ai == 0 && m == 0 && wr == 0 && fr < 2) {
                        *(f32x4*)(HP + ((size_t)u.pm * 2 + fr) * 2816 + hc0 + 4 * n) = (f32x4){cv[0], cv[1], cv[2], cv[3]};
                        *(f32x4*)(HU + ((size_t)u.pm * 2 + fr) * 2816 + hc0 + 4 * n) = acc[0][1][0][n];
                    }
                }
            }
        }
    }
};

template <class Epi, class Sched, bool ALIGN_EPI = false, bool SP2 = false>
__device__ __forceinline__ void gemm_phase(PG8_LAS unsigned char* lds, const Gemm g, const Sched& S, const Epi& E) {
    int tid_ = threadIdx.x; asm volatile("" : "+v"(tid_)); const int tid = tid_, wid = __builtin_amdgcn_readfirstlane(tid >> 6), lane = tid & 63, wr = wid >> 2, wc = wid & 3, fr = lane & 15, fq = lane >> 4;
    const int K = g.K, nt = K / BK;
    unsigned voffA[2], voffB[2];
#pragma unroll
    for (int i = 0; i < 2; ++i) { int R, C; stage_rc(tid * 16 + i * 8192, R, C); const int Rb = Epi::PERM ? ((R & ~31) + perm32(R & 31)) : R;
        voffA[i] = (unsigned)(R * g.lda + C) * 2u; voffB[i] = (unsigned)(Rb * K + C) * 2u; }
    const size_t kstep = (size_t)(BK * 2);
    const size_t hstepA = (size_t)HALF * g.lda * 2, hstepB = (size_t)HALF * K * 2;
    const size_t tstepA = 2 * hstepA, tstepB = 2 * hstepB;
    const unsigned ldsw = (unsigned)wid * 1024u;
    const int aoff = lds_byte(wr * 64 + fr, fq * 8), boff = lds_byte(wc * 32 + fr, fq * 8);
#define PG8_SA(b, h) (((b) * 2 + (h)) * HTB)
#define PG8_SB(b, h) ((4 + (b) * 2 + (h)) * HTB)
#define PG8_STAGE(bufoff, gbase, voff) do { _Pragma("unroll") for (int _i = 0; _i < 2; ++_i) \
        __builtin_amdgcn_global_load_lds((const unsigned*)((const char*)(gbase) + (voff)[_i]), (PG8_LAS unsigned*)(lds + (bufoff) + ldsw + _i * 8192), 16, 0, 0); } while (0)
#define PG8_LDA(dst, b, h) do { _Pragma("unroll") for (int m = 0; m < 4; ++m) _Pragma("unroll") for (int k = 0; k < 2; ++k) dst[m][k] = *(const PG8_LAS bf16x8*)(lds + PG8_SA(b, h) + aoff + m * 2048 + k * 1024); } while (0)
#define PG8_LDB(dst, b, h) do { _Pragma("unroll") for (int n = 0; n < 2; ++n) _Pragma("unroll") for (int k = 0; k < 2; ++k) dst[n][k] = *(const PG8_LAS bf16x8*)(lds + PG8_SB(b, h) + boff + n * 2048 + k * 1024); } while (0)
#define PG8_MMA(ai, bj, At, Bt) do { __builtin_amdgcn_s_setprio(1); _Pragma("unroll") for (int m = 0; m < 4; ++m) _Pragma("unroll") for (int n = 0; n < 2; ++n) _Pragma("unroll") for (int k = 0; k < 2; ++k) \
        acc[ai][bj][m][n] = __builtin_amdgcn_mfma_f32_16x16x32_bf16(Bt[n][k], At[m][k], acc[ai][bj][m][n], 0, 0, 0); __builtin_amdgcn_s_setprio(0); } while (0)
#define PG8_WAIT_V(n) asm volatile("s_waitcnt vmcnt(" #n ")" ::: "memory")
#define PG8_WAIT_L(n) asm volatile("s_waitcnt lgkmcnt(" #n ")" ::: "memory")
#define PG8_BAR __builtin_amdgcn_s_barrier()
#define PG8_SCHED __builtin_amdgcn_sched_barrier(0)
    Unit cur, nxt; int ui = 0;
    if (!S.next(0, cur)) return;
    f32x4 acc[2][2][4][2];
#pragma unroll
    for (int a = 0; a < 2; ++a)
#pragma unroll
        for (int b = 0; b < 2; ++b)
#pragma unroll
            for (int m = 0; m < 4; ++m)
#pragma unroll
                for (int n = 0; n < 2; ++n) acc[a][b][m][n] = (f32x4){0.f, 0.f, 0.f, 0.f};
    bf16x8 At[4][2], B0[2][2], B1[2][2];
    const char* cA = (const char*)g.A + (size_t)cur.pm * tstepA; const char* cB = (const char*)g.Bt + (size_t)cur.pn * tstepB;
    S.a_ready(cur);
    if constexpr (SP2) {
        PG8_STAGE(PG8_SB(0, 0), cB, voffB); PG8_STAGE(PG8_SB(0, 1), cB + hstepB, voffB); PG8_STAGE(PG8_SA(0, 0), cA, voffA); PG8_STAGE(PG8_SA(0, 1), cA + hstepA, voffA);
        if (wr == 1) PG8_BAR;
        PG8_WAIT_V(2); PG8_BAR;
        PG8_STAGE(PG8_SB(1, 0), cB + kstep, voffB); PG8_STAGE(PG8_SA(1, 0), cA + kstep, voffA); PG8_STAGE(PG8_SB(1, 1), cB + hstepB + kstep, voffB);
        PG8_WAIT_V(6); PG8_BAR;
    } else {
        PG8_STAGE(PG8_SB(0, 0), cB, voffB); PG8_STAGE(PG8_SA(0, 0), cA, voffA); PG8_STAGE(PG8_SB(0, 1), cB + hstepB, voffB); PG8_STAGE(PG8_SA(0, 1), cA + hstepA, voffA);
        if (wr == 1) PG8_BAR;
        PG8_WAIT_V(4); PG8_BAR;
        PG8_STAGE(PG8_SB(1, 0), cB + kstep, voffB); PG8_STAGE(PG8_SA(1, 0), cA + kstep, voffA); PG8_STAGE(PG8_SB(1, 1), cB + hstepB + kstep, voffB);
        PG8_WAIT_V(6); PG8_BAR;
    }
    for (;;) {
        const bool has_next = S.next(ui + 1, nxt);
        const char* nA = has_next ? (const char*)g.A + (size_t)nxt.pm * tstepA : cA; const char* nB = has_next ? (const char*)g.Bt + (size_t)nxt.pn * tstepB : cB;
        for (int t = 0; t < nt; t += 2) {
            const bool last = (t == nt - 2);
            const char* a1 = cA + (size_t)(t + 1) * kstep;
            const char* a2 = last ? nA : cA + (size_t)(t + 2) * kstep; const char* b2 = last ? nB : cB + (size_t)(t + 2) * kstep;
            const char* a3 = a2 + kstep; const char* b3 = b2 + kstep;
            if (last && has_next) S.a_ready(nxt);
            if constexpr (SP2) {
            PG8_LDB(B0, 0, 0); PG8_LDB(B1, 0, 1); PG8_SCHED; PG8_LDA(At, 0, 0); PG8_STAGE(PG8_SA(1, 1), a1 + hstepA, voffA);
            PG8_WAIT_V(8); PG8_WAIT_L(0); PG8_BAR; PG8_MMA(0, 0, At, B0); PG8_MMA(0, 1, At, B1); PG8_BAR; PG8_SCHED;
            PG8_LDA(At, 0, 1); PG8_STAGE(PG8_SB(0, 0), b2, voffB); PG8_STAGE(PG8_SB(0, 1), b2 + hstepB, voffB); PG8_STAGE(PG8_SA(0, 0), a2, voffA);
            PG8_WAIT_V(8); PG8_WAIT_L(0); PG8_BAR; PG8_MMA(1, 0, At, B0); PG8_MMA(1, 1, At, B1); PG8_BAR; PG8_SCHED;
            PG8_LDB(B0, 1, 0); PG8_LDB(B1, 1, 1); PG8_SCHED; PG8_LDA(At, 1, 0); PG8_STAGE(PG8_SA(0, 1), a2 + hstepA, voffA);
            PG8_WAIT_V(8); PG8_WAIT_L(0); PG8_BAR; PG8_MMA(0, 0, At, B0); PG8_MMA(0, 1, At, B1); PG8_BAR; PG8_SCHED;
            PG8_LDA(At, 1, 1); PG8_STAGE(PG8_SB(1, 0), b3, voffB); PG8_STAGE(PG8_SB(1, 1), b3 + hstepB, voffB); PG8_STAGE(PG8_SA(1, 0), a3, voffA);
            PG8_WAIT_V(8); PG8_WAIT_L(0); PG8_BAR; PG8_MMA(1, 0, At, B0); PG8_MMA(1, 1, At, B1); PG8_BAR; PG8_SCHED;
            } else {
            PG8_LDB(B0, 0, 0); PG8_SCHED; PG8_LDA(At, 0, 0); PG8_STAGE(PG8_SA(1, 1), a1 + hstepA, voffA);
            PG8_WAIT_L(8); PG8_BAR; PG8_WAIT_L(0); PG8_MMA(0, 0, At, B0); PG8_BAR; PG8_SCHED;
            PG8_LDB(B1, 0, 1); PG8_STAGE(PG8_SB(0, 0), b2, voffB);
            PG8_BAR; PG8_WAIT_L(0); PG8_MMA(0, 1, At, B1); PG8_BAR;
            PG8_LDA(At, 0, 1); PG8_STAGE(PG8_SA(0, 0), a2, voffA);
            PG8_BAR; PG8_WAIT_L(0); PG8_MMA(1, 0, At, B0); PG8_BAR; PG8_SCHED;
            PG8_STAGE(PG8_SB(0, 1), b2 + hstepB, voffB);
            PG8_WAIT_V(6); PG8_BAR; PG8_MMA(1, 1, At, B1); PG8_BAR;
            PG8_LDB(B0, 1, 0); PG8_SCHED; PG8_LDA(At, 1, 0); PG8_STAGE(PG8_SA(0, 1), a2 + hstepA, voffA);
            PG8_WAIT_L(8); PG8_BAR; PG8_WAIT_L(0); PG8_MMA(0, 0, At, B0); PG8_BAR; PG8_SCHED;
            PG8_LDB(B1, 1, 1); PG8_STAGE(PG8_SB(1, 0), b3, voffB);
            PG8_BAR; PG8_WAIT_L(0); PG8_MMA(0, 1, At, B1); PG8_BAR;
            PG8_LDA(At, 1, 1); PG8_STAGE(PG8_SA(1, 0), a3, voffA);
            PG8_BAR; PG8_WAIT_L(0); PG8_MMA(1, 0, At, B0); PG8_BAR; PG8_SCHED;
            PG8_STAGE(PG8_SB(1, 1), b3 + hstepB, voffB);
            PG8_WAIT_V(6); PG8_BAR; PG8_MMA(1, 1, At, B1); PG8_BAR;
            }
        }
        if constexpr (ALIGN_EPI) { if (wr == 0) PG8_BAR; }
        if constexpr (!Epi::AFTER_DRAIN) { E(acc, cur, wr, wc, fr, fq); S.done(cur); }
        if (!has_next) break;
#pragma unroll
        for (int a = 0; a < 2; ++a)
#pragma unroll
            for (int b = 0; b < 2; ++b)
#pragma unroll
                for (int m = 0; m < 4; ++m)
#pragma unroll
                    for (int n = 0; n < 2; ++n) acc[a][b][m][n] = (f32x4){0.f, 0.f, 0.f, 0.f};
        cur = nxt; cA = nA; cB = nB; ++ui;
        if constexpr (ALIGN_EPI) { if (wr == 1) PG8_BAR; }
    }
    PG8_WAIT_V(0);
    if constexpr (!ALIGN_EPI) { if (wr == 0) PG8_BAR; }
    PG8_BAR;
    if constexpr (Epi::AFTER_DRAIN) { E.fused(acc, cur, wr, wc, fr, fq, lds, wid, lane); S.done(cur); }
#undef PG8_SA
#undef PG8_SB
#undef PG8_STAGE
#undef PG8_LDA
#undef PG8_LDB
#undef PG8_MMA
#undef PG8_WAIT_V
#undef PG8_WAIT_L
#undef PG8_BAR
#undef PG8_SCHED
}

}

namespace attn_body {
using bf16=__hip_bfloat16;
using bf16x8=__attribute__((ext_vector_type(8)))short;
using s16x4=__attribute__((ext_vector_type(4)))short;
using f32x16=__attribute__((ext_vector_type(16)))float;
using u32x4=__attribute__((ext_vector_type(4)))unsigned;
constexpr int BATCH=8,NHEAD=8,SEQ=8192,D=64,DM=4352;
constexpr int NW=8,QBLK=32,QB=QBLK*NW,KVBLK=64,NQB=SEQ/QB;
constexpr int ATTN_PITCH=DM, ATTN_UNIT_ROWS=QB;
__device__ __forceinline__ int crow(int r,int hi){return (r&3)+8*(r>>2)+4*hi;}
#define SBAR() __builtin_amdgcn_sched_barrier(0)
__device__ __forceinline__ void cmask(f32x16&p0,f32x16&p1,int jb,int qrel,int hi){
  const float NEG=-INFINITY; int kb=64*jb+4*hi;
  #pragma unroll
  for(int r=0;r<16;++r){int kv=kb+(r&3)+8*(r>>2); if(kv>qrel)p0[r]=NEG; if(kv+32>qrel)p1[r]=NEG;}
}

constexpr int NSLOT=3, SLOTB=8192;
constexpr int LDS_K=0, LDS_V=NSLOT*SLOTB, LDS_WS=2*NSLOT*SLOTB, LDS_OST=LDS_WS+NW*64*4, LDS_BYTES=LDS_OST+NW*4096;
constexpr int LDS_CB=LDS_BYTES;
constexpr float C2=0.125f*1.4426950408889634f;
__device__ __forceinline__ void glds16(const void*gsrc,unsigned lds_dst){unsigned keep;
  asm volatile("s_mov_b32 %0, m0\n\ts_mov_b32 m0, %2\n\ts_nop 0\n\tglobal_load_lds_dwordx4 %1, off\n\ts_mov_b32 m0, %0":"=&s"(keep):"v"(gsrc),"s"(lds_dst):"memory");}
__device__ __forceinline__ float max3f(float a,float b,float c){float r;asm("v_max3_f32 %0, %1, %2, %3":"=v"(r):"v"(a),"v"(b),"v"(c));return r;}
__device__ __forceinline__ float max2f(float a,float b){float r;asm("v_max_f32_e32 %0, %1, %2":"=v"(r):"v"(a),"v"(b));return r;}
__device__ __forceinline__ float fadd_s(float a,float b){float r;asm("v_add_f32_e32 %0, %1, %2":"=v"(r):"v"(a),"v"(b));return r;}
__device__ __forceinline__ float fsub_s(float a,float b){float r;asm("v_sub_f32_e32 %0, %1, %2":"=v"(r):"v"(a),"v"(b));return r;}
typedef float f32x2_t __attribute__((ext_vector_type(2))); typedef __bf16 bf16x2_t __attribute__((ext_vector_type(2)));
__device__ __forceinline__ unsigned cvtpk_s(float lo,float hi){f32x2_t v={lo,hi};bf16x2_t b=__builtin_convertvector(v,bf16x2_t);return __builtin_bit_cast(unsigned,b);}
#define WAIT_BAR(N) asm volatile("s_waitcnt vmcnt(" #N ") lgkmcnt(0)\n\ts_barrier":::"memory")

__device__ __forceinline__ void qkt(f32x16&p0,f32x16&p1,const char*Kslot,const bf16x8*qr,const f32x16&negm,int r32,int hi){
  const char*kb=Kslot+hi*1024+r32*16;
  #pragma unroll
  for(int d0=0;d0<4;++d0){
    const bf16x8 b0=*reinterpret_cast<const bf16x8*>(kb+d0*2048);
    const bf16x8 b1=*reinterpret_cast<const bf16x8*>(kb+d0*2048+512);
    if(d0==0){p0=__builtin_amdgcn_mfma_f32_32x32x16_bf16(b0,qr[0],negm,0,0,0);p1=__builtin_amdgcn_mfma_f32_32x32x16_bf16(b1,qr[0],negm,0,0,0);}
    else{p0=__builtin_amdgcn_mfma_f32_32x32x16_bf16(b0,qr[d0],p0,0,0,0);p1=__builtin_amdgcn_mfma_f32_32x32x16_bf16(b1,qr[d0],p1,0,0,0);}}
}
typedef __attribute__((address_space(3))) const char* lds_cptr;
typedef short v4i16_t __attribute__((ext_vector_type(4)));
__device__ __forceinline__ void kload8(bf16x8*kf,lds_cptr kp){
  kf[0]=*(const __attribute__((address_space(3))) bf16x8*)(kp);      kf[1]=*(const __attribute__((address_space(3))) bf16x8*)(kp+512);
  kf[2]=*(const __attribute__((address_space(3))) bf16x8*)(kp+2048); kf[3]=*(const __attribute__((address_space(3))) bf16x8*)(kp+2560);
  kf[4]=*(const __attribute__((address_space(3))) bf16x8*)(kp+4096); kf[5]=*(const __attribute__((address_space(3))) bf16x8*)(kp+4608);
  kf[6]=*(const __attribute__((address_space(3))) bf16x8*)(kp+6144); kf[7]=*(const __attribute__((address_space(3))) bf16x8*)(kp+6656);
}
__device__ __forceinline__ void kload2(bf16x8*kf,lds_cptr kp,int j){ kf[2*j]=*(const __attribute__((address_space(3))) bf16x8*)(kp+j*2048); kf[2*j+1]=*(const __attribute__((address_space(3))) bf16x8*)(kp+j*2048+512); }
__device__ __forceinline__ s16x4 vtr(lds_cptr p){ return __builtin_bit_cast(s16x4,__builtin_amdgcn_ds_read_tr16_b64_v4i16((__attribute__((address_space(3))) v4i16_t*)p)); }
__device__ __forceinline__ float rowmax(const f32x16&p0,const f32x16&p1){
  float a=max3f(p0[0],p0[1],p1[0]),b=max3f(p0[2],p0[3],p1[1]);a=max3f(a,p1[2],p1[3]);
  #pragma unroll
  for(int r=4;r<16;r+=4){a=max3f(a,p0[r],p0[r+1]);b=max3f(b,p0[r+2],p0[r+3]);a=max3f(a,p1[r],p1[r+1]);b=max3f(b,p1[r+2],p1[r+3]);}
  const float m=max2f(a,b);
  auto rr=__builtin_amdgcn_permlane32_swap(__float_as_uint(m),__float_as_uint(m),false,false);
  return max2f(__uint_as_float(rr[0]),__uint_as_float(rr[1]));
}
__device__ __forceinline__ void pv(f32x16*o,int vb,bf16x8 pa0,bf16x8 pa1,bf16x8 pa2,bf16x8 pa3){
  #pragma unroll
  for(int d0=0;d0<2;++d0){s16x4 lo[4],hi[4];
    #pragma unroll
    for(int ks=0;ks<4;++ks){
      asm volatile("ds_read_b64_tr_b16 %0,%1 offset:%c2":"=&v"(lo[ks]):"v"(vb),"i"(d0*4096+ks*1024):"memory");
      asm volatile("ds_read_b64_tr_b16 %0,%1 offset:%c2":"=&v"(hi[ks]):"v"(vb),"i"(d0*4096+ks*1024+512):"memory");}
    asm volatile("s_waitcnt lgkmcnt(0)":::"memory");SBAR();
    #define PK(k) (bf16x8){lo[k][0],lo[k][1],lo[k][2],lo[k][3],hi[k][0],hi[k][1],hi[k][2],hi[k][3]}
    o[d0]=__builtin_amdgcn_mfma_f32_32x32x16_bf16(pa0,PK(0),o[d0],0,0,0);
    o[d0]=__builtin_amdgcn_mfma_f32_32x32x16_bf16(pa1,PK(1),o[d0],0,0,0);
    o[d0]=__builtin_amdgcn_mfma_f32_32x32x16_bf16(pa2,PK(2),o[d0],0,0,0);
    o[d0]=__builtin_amdgcn_mfma_f32_32x32x16_bf16(pa3,PK(3),o[d0],0,0,0);
    #undef PK
  }
}

#ifndef ATTN_STORE16
#define ATTN_STORE16(p,v) (*(u32x4*)(p)=(v))
#endif
template<int THRL> __device__ __forceinline__ void attn_unit(int b,int h,int qb,const bf16*Q,const bf16*__restrict__ K,const bf16*__restrict__ V,bf16*O,const float*__restrict__ cl,const float*__restrict__ tot,const float*__restrict__ qn,const float*__restrict__ kn,char*shm){
  int tid_=threadIdx.x; asm volatile("":"+v"(tid_)); const int tid=tid_,lane=tid&63,r32=lane&31,hi=lane>>5; const int wid=__builtin_amdgcn_readfirstlane(tid>>6);
  const long rowbase=(long)b*SEQ; const int q0=qb*QB;
  const bf16*Qw=Q+(rowbase+q0+wid*QBLK)*DM+h*D;

  typedef float f32x4_t __attribute__((ext_vector_type(4)));
  int t_start=0;
  {
    const int j_=tid>>4; float Pj=0.f,Pq=0.f;
    for(int i=0;i<qb;++i){const float t_=tot[((b*32+i)*8)+h];Pq+=t_; if(i<j_)Pj+=t_;}
    const float*clh=cl+(size_t)(b*NHEAD+h)*SEQ;
    const float cref=clh[q0]+Pq;
    __attribute__((address_space(3))) float*cbf=(__attribute__((address_space(3))) float*)((__attribute__((address_space(3))) char*)shm+LDS_CB);
    if(16*tid<q0+QB){
      __attribute__((address_space(3))) f32x4_t*dst=(__attribute__((address_space(3))) f32x4_t*)cbf+4*tid;
      #pragma unroll
      for(int c_=0;c_<4;++c_){ f32x4_t v_=*(const f32x4_t*)(clh+16*tid+4*c_); v_=(cref-(v_+Pj))*1.4426950408889634f; dst[c_]=v_; }
    }
    asm volatile("s_waitcnt lgkmcnt(0)\n\ts_barrier":::"memory");
    const float q2=(qn[((b*32+qb)*8+h)*2]+qn[((b*32+qb)*8+h)*2+1])*1.02f, k2=(kn[(b*8+h)*2]+kn[(b*8+h)*2+1])*1.02f;
    const float thr=-2.f*sqrtf(q2*k2)-152.f;
    const int NT0=(q0+QB)/KVBLK; int lo_=0,hi_=NT0-4;
    while(lo_<hi_){ const int mid_=(lo_+hi_)>>1; if(cbf[64*mid_+63]<thr)lo_=mid_+1; else hi_=mid_; }
    t_start=__builtin_amdgcn_readfirstlane(lo_&~1);
  }
  #define CBIAS(P0,P1,t) do{ const lds_cptr cb_=shm3+LDS_CB+(t_start+(t))*256+hi*16; \
    _Pragma("unroll") for(int j_=0;j_<4;++j_){ const f32x4_t b0_=*(const __attribute__((address_space(3))) f32x4_t*)(cb_+j_*32)-mhat; const f32x4_t b1_=*(const __attribute__((address_space(3))) f32x4_t*)(cb_+128+j_*32)-mhat; \
      P0[4*j_]+=b0_[0];P0[4*j_+1]+=b0_[1];P0[4*j_+2]+=b0_[2];P0[4*j_+3]+=b0_[3]; P1[4*j_]+=b1_[0];P1[4*j_+1]+=b1_[1];P1[4*j_+2]+=b1_[2];P1[4*j_+3]+=b1_[3]; } }while(0)
  const bf16*Kh=K+(rowbase+(long)t_start*KVBLK)*DM+h*D,*Vh=V+(rowbase+(long)t_start*KVBLK)*DM+h*D;
  const unsigned lds0=(unsigned)(uintptr_t)shm;
  float*wsf=(float*)(shm+LDS_WS)+wid*64;
  const bf16*ksrc=Kh+(long)lane*DM+wid*8;
  const bf16*vsrc=Vh+(long)(16*(wid&3)+(lane>>2))*DM+(wid>>2)*32+(lane&3)*8;
  const unsigned kdst=lds0+LDS_K+wid*1024, vdst=lds0+LDS_V+wid*1024;
  #define DMA_K(t,slot) glds16(ksrc+(long)(t)*KVBLK*DM,(unsigned)__builtin_amdgcn_readfirstlane(kdst+(slot)))
  #define DMA_V(t,slot) glds16(vsrc+(long)(t)*KVBLK*DM,(unsigned)__builtin_amdgcn_readfirstlane(vdst+(slot)))
  const int vb0=(int)(lds0+LDS_V)+((lane>>4)&1)*32+(lane&3)*8+(4*hi+((lane&15)>>2))*64;
  const char*Kbase=shm+LDS_K; bf16x8 kf[8];
  const lds_cptr shm3=(lds_cptr)shm; const lds_cptr kp0=shm3+LDS_K+hi*1024+r32*16; const lds_cptr vp0=shm3+LDS_V+((lane>>4)&1)*32+(lane&3)*8+(4*hi+((lane&15)>>2))*64;
  const int NT=(q0+QB)/KVBLK-t_start;
  DMA_K(0,0);DMA_V(0,0);DMA_K(1,SLOTB);
  bf16x8 qr[4];
  #pragma unroll
  for(int d0=0;d0<4;++d0)qr[d0]=*reinterpret_cast<const bf16x8*>(&Qw[(long)r32*DM+d0*16+hi*8]);
  float mhat=0.f,l_reg=0.f;f32x16 o[2];o[0]=f32x16{};o[1]=f32x16{};const f32x16 negm=f32x16{};
  const int qrel=wid*QBLK+r32;
  #define CMASK(P0,P1,t) do{int jb_=(t)-(NT-4); if(jb_>=0)cmask(P0,P1,jb_,qrel,hi);}while(0)
  bool resc=false;
  #define START(P0,P1) do{ const float rm=rowmax(P0,P1); resc=false; \
    { const float dl=__builtin_fmaxf(rm,0.f); mhat=fadd_s(mhat,dl); \
      _Pragma("unroll") for(int r=0;r<16;++r){P0[r]=fsub_s(P0[r],dl);P1[r]=fsub_s(P1[r],dl);} \
       } \
    _Pragma("unroll") for(int r=0;r<16;++r)P0[r]=__builtin_amdgcn_exp2f(P0[r]); }while(0)
  #define RESC() do{ if(resc){ asm volatile("s_waitcnt lgkmcnt(0)":::"memory"); \
      _Pragma("unroll") for(int d_=0;d_<2;++d_) _Pragma("unroll") for(int r=0;r<16;++r)o[d_][r]*=wsf[crow(r,hi)]; } }while(0)
  f32x16 pA0,pA1,pB0,pB1;
  int sl_prev=0,sl_cur=0,sl_next=SLOTB;
  #define ROT() do{sl_prev=sl_cur;sl_cur=sl_next;sl_next=(sl_next==(NSLOT-1)*SLOTB)?0:sl_next+SLOTB;}while(0)
  DMA_K(2,2*SLOTB);
  WAIT_BAR(3);
  qkt(pA0,pA1,Kbase,qr,negm,r32,hi);asm volatile("s_nop 15\n\ts_nop 7":"+v"(pA0),"+v"(pA1));CMASK(pA0,pA1,0);CBIAS(pA0,pA1,0);
  START(pA0,pA1);
  _Pragma("unroll") for(int r=0;r<16;++r)pA1[r]=__builtin_amdgcn_exp2f(pA1[r]);
  WAIT_BAR(0);
  DMA_K(3,0);DMA_V(1,SLOTB);
  ROT();
  kload8(kf,kp0+sl_cur);
  WAIT_BAR(2);
  s16x4 vlo[8],vhi[8]; u32x4 pw0,pw1,pw2,pw3;
  #define PKW(P,B) cvtpk_s(P[B],P[B+1])
  #define PAF(k) __builtin_bit_cast(bf16x8,pw##k)
  #define VFR(i) (bf16x8){vlo[i][0],vlo[i][1],vlo[i][2],vlo[i][3],vhi[i][0],vhi[i][1],vhi[i][2],vhi[i][3]}
  #define PIN(x) asm volatile("":"+v"(x))
  #define MX3(a,b,c) __builtin_fmaxf(__builtin_fmaxf((a),(b)),(c))
  #define GAPA(MF,A0,A1,A2,A3,W0,W1,PW) do{ MF; sacc+=A0; sacc+=A1; sacc+=A2; sacc+=A3; PIN(sacc); W0; W1; PIN(PW); SBAR(); }while(0)
  #define EX(v) __builtin_amdgcn_exp2f(v)
  #define GAPB(MF,X,B) do{ MF; X[B]=EX(X[B]); X[B+1]=EX(X[B+1]); X[B+2]=EX(X[B+2]); X[B+3]=EX(X[B+3]); PIN(X); SBAR(); }while(0)
  #define VRD(i) do{ vlo[i]=vtr(vp_+(((i)>>2)*4096+((i)&3)*1024)); vhi[i]=vtr(vp_+(((i)>>2)*4096+((i)&3)*1024+512)); }while(0)
  #define KRD(G,j) do{ if(G){ kload2(kf,kp0+sl_next,j); SBAR(); } }while(0)
  #define STEP(C0,C1,P0,P1,t,GK,GV,GL) do{ SBAR(); \
    const lds_cptr vp_=vp0+sl_prev; \
    VRD(0); SBAR(); float sacc=(P0[0]+P0[1]); \
    GAPA(C0=__builtin_amdgcn_mfma_f32_32x32x16_bf16(kf[0],qr[0],negm,0,0,0), P0[2],P0[3],P0[4],P0[5],     pw0[0]=PKW(P0,0), pw0[1]=PKW(P0,2), pw0); \
    VRD(4); SBAR(); GAPA(C1=__builtin_amdgcn_mfma_f32_32x32x16_bf16(kf[1],qr[0],negm,0,0,0), P0[6],P0[7],P0[8],P0[9],     pw0[2]=PKW(P0,4), pw0[3]=PKW(P0,6), pw0); \
    VRD(1); SBAR(); GAPA(C0=__builtin_amdgcn_mfma_f32_32x32x16_bf16(kf[2],qr[1],C0,0,0,0),   P0[10],P0[11],P0[12],P0[13], pw1[0]=PKW(P0,8), pw1[1]=PKW(P0,10), pw1); \
    VRD(5); SBAR(); GAPA(C1=__builtin_amdgcn_mfma_f32_32x32x16_bf16(kf[3],qr[1],C1,0,0,0),   P0[14],P0[15],P1[0],P1[1],   pw1[2]=PKW(P0,12),pw1[3]=PKW(P0,14), pw1); \
    VRD(2); SBAR(); GAPA(C0=__builtin_amdgcn_mfma_f32_32x32x16_bf16(kf[4],qr[2],C0,0,0,0),   P1[2],P1[3],P1[4],P1[5],     pw2[0]=PKW(P1,0), pw2[1]=PKW(P1,2), pw2); \
    VRD(6); SBAR(); GAPA(C1=__builtin_amdgcn_mfma_f32_32x32x16_bf16(kf[5],qr[2],C1,0,0,0),   P1[6],P1[7],P1[8],P1[9],     pw2[2]=PKW(P1,4), pw2[3]=PKW(P1,6), pw2); \
    VRD(3); SBAR(); GAPA(C0=__builtin_amdgcn_mfma_f32_32x32x16_bf16(kf[6],qr[3],C0,0,0,0),   P1[10],P1[11],P1[12],P1[13], pw3[0]=PKW(P1,8), pw3[1]=PKW(P1,10), pw3); \
    VRD(7); SBAR(); GAPA(C1=__builtin_amdgcn_mfma_f32_32x32x16_bf16(kf[7],qr[3],C1,0,0,0),   P1[14],P1[15],0.f,0.f,       pw3[2]=PKW(P1,12),pw3[3]=PKW(P1,14), pw3); \
    l_reg+=sacc; \
    if(GK){DMA_K((t)+3,sl_cur);} if(GV){DMA_V((t)+1,sl_next);} \
    CMASK(C0,C1,t); CBIAS(C0,C1,t); \
    { float a=MX3(C0[0],C0[1],C1[0]),b=MX3(C0[2],C0[3],C1[1]); a=MX3(a,C1[2],C1[3]); \
      _Pragma("unroll") for(int r=4;r<16;r+=4){a=MX3(a,C0[r],C0[r+1]);b=MX3(b,C0[r+2],C0[r+3]);a=MX3(a,C1[r],C1[r+1]);b=MX3(b,C1[r+2],C1[r+3]);} \
      float rm=__builtin_fmaxf(a,b); { auto rr=__builtin_amdgcn_permlane32_swap(__float_as_uint(rm),__float_as_uint(rm),false,false); rm=__builtin_fmaxf(__uint_as_float(rr[0]),__uint_as_float(rr[1])); } \
      resc=false; \
      if(__builtin_expect(__any(rm>(float)THRL),0)){ const float dl=__builtin_fmaxf(rm,0.f); mhat+=dl; \
        _Pragma("unroll") for(int r=0;r<16;++r){C0[r]-=dl;C1[r]-=dl;} \
         \
        const float f=__builtin_amdgcn_exp2f(-dl); l_reg*=f; if(hi==0)wsf[r32]=f; resc=true; } } \
    SBAR(); \
    GAPB(o[0]=__builtin_amdgcn_mfma_f32_32x32x16_bf16(PAF(0),VFR(0),o[0],0,0,0), C0,0); \
    GAPB(o[1]=__builtin_amdgcn_mfma_f32_32x32x16_bf16(PAF(0),VFR(4),o[1],0,0,0), C0,4); \
    KRD(GL,0); GAPB(o[0]=__builtin_amdgcn_mfma_f32_32x32x16_bf16(PAF(1),VFR(1),o[0],0,0,0), C0,8); \
    KRD(GL,1); GAPB(o[1]=__builtin_amdgcn_mfma_f32_32x32x16_bf16(PAF(1),VFR(5),o[1],0,0,0), C0,12); \
    KRD(GL,2); GAPB(o[0]=__builtin_amdgcn_mfma_f32_32x32x16_bf16(PAF(2),VFR(2),o[0],0,0,0), C1,0); \
    KRD(GL,3); GAPB(o[1]=__builtin_amdgcn_mfma_f32_32x32x16_bf16(PAF(2),VFR(6),o[1],0,0,0), C1,4); \
    GAPB(o[0]=__builtin_amdgcn_mfma_f32_32x32x16_bf16(PAF(3),VFR(3),o[0],0,0,0), C1,8); \
    GAPB(o[1]=__builtin_amdgcn_mfma_f32_32x32x16_bf16(PAF(3),VFR(7),o[1],0,0,0), C1,12); \
    }while(0)
  int t=1;
  #undef CMASK
  #define CMASK(P0,P1,t) do{}while(0)
  for(;t+5<NT;t+=2){
    STEP(pB0,pB1,pA0,pA1,t,true,true,true);     WAIT_BAR(2); RESC(); ROT();
    STEP(pA0,pA1,pB0,pB1,t+1,true,true,true);   WAIT_BAR(2); RESC(); ROT();
  }
  #undef CMASK
  #define CMASK(P0,P1,t) do{int jb_=(t)-(NT-4); if(jb_>=0)cmask(P0,P1,jb_,qrel,hi);}while(0)
  #define ENDW(tt) do{ if((tt)+3<NT){WAIT_BAR(2);} else if((tt)+2<NT){WAIT_BAR(1);} else {WAIT_BAR(0);} }while(0)
  for(;t+1<NT;t+=2){
    STEP(pB0,pB1,pA0,pA1,t,(t+3<NT),(t+1<NT),(t+1<NT));       ENDW(t);   RESC(); ROT();
    STEP(pA0,pA1,pB0,pB1,t+1,(t+4<NT),(t+2<NT),(t+2<NT));     ENDW(t+1); RESC(); ROT();
  }
  STEP(pB0,pB1,pA0,pA1,NT-1,false,false,false); RESC();
  { float sacc=pB0[0]+pB0[1]; _Pragma("unroll") for(int r=2;r<16;++r)sacc+=pB0[r]; _Pragma("unroll") for(int r=0;r<16;++r)sacc+=pB1[r]; l_reg+=sacc;
    pw0=(u32x4){PKW(pB0,0),PKW(pB0,2),PKW(pB0,4),PKW(pB0,6)};pw1=(u32x4){PKW(pB0,8),PKW(pB0,10),PKW(pB0,12),PKW(pB0,14)};pw2=(u32x4){PKW(pB1,0),PKW(pB1,2),PKW(pB1,4),PKW(pB1,6)};pw3=(u32x4){PKW(pB1,8),PKW(pB1,10),PKW(pB1,12),PKW(pB1,14)};
    SBAR(); pv(o,vb0+sl_cur,PAF(0),PAF(1),PAF(2),PAF(3)); }
  #undef PKW
  #undef PAF
  #undef VFR
  #undef PIN
  #undef MX3
  #undef GAPA
  #undef GAPB
  #undef EX
  #undef VRD
  #undef KRD
  #undef STEP
  #undef ENDW
  {auto rr=__builtin_amdgcn_permlane32_swap(__float_as_uint(l_reg),__float_as_uint(l_reg),false,false);l_reg=__uint_as_float(rr[0])+__uint_as_float(rr[1]);}
  if(hi==0)wsf[32+r32]=l_reg;asm volatile("s_waitcnt lgkmcnt(0)":::"memory");
  float rli[16];
  #pragma unroll
  for(int r=0;r<16;++r)rli[r]=__builtin_amdgcn_rcpf(wsf[32+crow(r,hi)]);
  bf16*Ow=O+(rowbase+q0+wid*QBLK)*DM+h*D;
  { bf16*stg=(bf16*)(shm+LDS_OST)+wid*2048;
    #pragma unroll
    for(int r=0;r<16;++r){const int orow=crow(r,hi);
      #pragma unroll
      for(int d0=0;d0<2;++d0)stg[orow*64+d0*32+r32]=__float2bfloat16(o[d0][r]*rli[r]);}
    asm volatile("s_waitcnt lgkmcnt(0)":::"memory");
    #pragma unroll
    for(int i=0;i<4;++i){const int row=i*8+(lane>>3),ch=lane&7; const u32x4 v=*(const u32x4*)(stg+row*64+ch*8); ATTN_STORE16(Ow+(long)row*DM+ch*8,v);} }
  asm volatile("s_waitcnt lgkmcnt(0)\n\ts_barrier":::"memory");
  #undef DMA_K
  #undef DMA_V
  #undef CMASK
  #undef CBIAS
  #undef START
  #undef RESC
  #undef ROT
}
constexpr int ATTN_LDS_BYTES=LDS_BYTES+32768;
#undef SBAR
#undef WAIT_BAR
}


constexpr int NB = 8, SEQ = 8192, DM = 1024, MROWS = NB * SEQ;
constexpr int DEPTH = 2, NIN = 4360, NZ = 4352, DFF = 2816;
constexpr float LN_EPS = 1e-5f;
constexpr float ALPHA = 1.4142135623730951f;
constexpr float LOG2E = 1.4426950408889634f;
constexpr float C2 = 0.125f * LOG2E;
constexpr int ZQA = 0, ZKA = 512, ZVA = 640, ZQB = 768, ZKB = 1280, ZVB = 1792, ZGA = 2304, ZGB = 3328;

constexpr size_t MiB = 1u << 20;
constexpr size_t W_IN_B = (size_t)NZ * 1024 * 2, W_PA_B = (size_t)1024 * 512 * 2, W_OUT_B = (size_t)1024 * 1024 * 2, W_FI_B = (size_t)5632 * 1024 * 2, W_FO_B = (size_t)1024 * 2816 * 2;
constexpr size_t WL_IN = 0, WL_PA = WL_IN + W_IN_B, WL_PB = WL_PA + W_PA_B, WL_OUT = WL_PB + W_PA_B, WL_FI = WL_OUT + W_OUT_B, WL_FO = WL_FI + W_FI_B, WL_BYTES = WL_FO + W_FO_B;
constexpr size_t WS_W = 1 * MiB;
constexpr size_t WS_CL = 64 * MiB;
constexpr size_t WS_TOT = 66 * MiB;
constexpr size_t WS_QN = 66 * MiB + 65536, WS_KN = WS_QN + 65536;
constexpr size_t WS_TAIL = 67 * MiB, WS_HP = 73 * MiB, WS_HU = 79 * MiB;
constexpr size_t WS_HB = 96 * MiB;
constexpr size_t WS_MG = 224 * MiB;
constexpr size_t WS_Z = 352 * MiB;
constexpr size_t WS_END = WS_Z + (size_t)MROWS * NZ * 2;
static_assert(WS_W + DEPTH * WL_BYTES <= WS_CL && WS_HU + 6 * MiB <= WS_HB, "d_ws map");
constexpr size_t ZPANEL_B = (size_t)256 * NZ * 2;

constexpr int RING_BYTES = 131072, TL_OFF = RING_BYTES, LDS_BYTES = 147456;
constexpr int NWAVES = 8;

#define GAS __attribute__((address_space(1)))
#define LAS __attribute__((address_space(3)))
typedef unsigned short bf16;
typedef unsigned v4u __attribute__((ext_vector_type(4)));
typedef unsigned v2u __attribute__((ext_vector_type(2)));
typedef float f32x4 __attribute__((ext_vector_type(4)));
typedef short bf16x8 __attribute__((ext_vector_type(8)));
typedef float f32x16 __attribute__((ext_vector_type(16)));
#define LDS_WAIT() asm volatile("s_waitcnt lgkmcnt(0)" ::: "memory")
__device__ __forceinline__ unsigned f2bf(float f) { unsigned u = __builtin_bit_cast(unsigned, f); return (u + 0x7fffu + ((u >> 16) & 1u)) >> 16; }
__device__ __forceinline__ unsigned pk2(float lo, float hi) { return f2bf(lo) | (f2bf(hi) << 16); }
__device__ __forceinline__ float wave_sum(float v) {
#pragma unroll
    for (int o = 1; o < 64; o <<= 1) v += __shfl_xor(v, o);
    return v;
}

__device__ __forceinline__ void transpose_item(const float* W, int ldw, int K, int k0, int src_col0, bf16* WT, int dst_row0, LAS float* scr, int lane) {
#pragma unroll 8
    for (int i = 0; i < 32; ++i) { const int kk = 2 * i + (lane >> 5); scr[kk * 33 + (lane & 31)] = W[(size_t)(k0 + kk) * ldw + src_col0 + (lane & 31)]; }
    LDS_WAIT(); asm volatile("" ::: "memory");
    const int c = lane & 7;
#pragma unroll
    for (int j = 0; j < 4; ++j) { const int n = (lane >> 3) + 8 * j; const LAS float* s = scr + (8 * c) * 33 + n;
        v4u o; o.x = pk2(s[0 * 33], s[1 * 33]); o.y = pk2(s[2 * 33], s[3 * 33]); o.z = pk2(s[4 * 33], s[5 * 33]); o.w = pk2(s[6 * 33], s[7 * 33]);
        *(GAS v4u*)(WT + (size_t)(dst_row0 + n) * K + k0 + 8 * c) = o; }
    LDS_WAIT(); asm volatile("" ::: "memory");
}

struct Args { const float* in[15]; float* out; unsigned char* ws; };

template <bool DO_LN, bool DO_F>
__device__ __forceinline__ void row_pass(LAS unsigned char* lds, int panel, const float* src, float* dstR, bf16* HB, const float* lg, const float* lb,
                                         const float* win_l, const float* bin_l, float* CL, float* TOT) {
    int tid_ = threadIdx.x; asm volatile("" : "+v"(tid_)); const int tid = tid_, lane = tid & 63, wave = __builtin_amdgcn_readfirstlane(tid >> 6);
    LAS float* lcl = (LAS float*)lds;
    LAS float* wtot = (LAS float*)(lds + 8192);
    f32x4 gv[4], bv[4];
    if (DO_LN) {
#pragma unroll
        for (int j = 0; j < 4; ++j) { gv[j] = *(const f32x4*)(lg + 256 * j + 4 * lane); bv[j] = *(const f32x4*)(lb + 256 * j + 4 * lane); }
    }
    for (int i = 0; i < 32; ++i) {
        const size_t row = (size_t)panel * 256 + wave * 32 + i;
        const GAS f32x4* xr = (const GAS f32x4*)(src + row * DM) + lane;
        f32x4 v[4]; float s = 0.f;
#pragma unroll
        for (int j = 0; j < 4; ++j) { v[j] = xr[64 * j]; s += (v[j].x + v[j].y) + (v[j].z + v[j].w); }
        if (DO_LN) {
            const float mean = wave_sum(s) * (1.f / DM); float s2 = 0.f;
#pragma unroll
            for (int j = 0; j < 4; ++j) { v[j] = v[j] - mean; s2 += (v[j].x * v[j].x + v[j].y * v[j].y) + (v[j].z * v[j].z + v[j].w * v[j].w); }
            const float rstd = 1.f / sqrtf(wave_sum(s2) * (1.f / DM) + LN_EPS);
            GAS f32x4* orow = (GAS f32x4*)(dstR + row * DM) + lane;
#pragma unroll
            for (int j = 0; j < 4; ++j) { v[j] = v[j] * rstd * gv[j] + bv[j]; orow[64 * j] = v[j]; }
        }
        GAS v2u* o8 = (GAS v2u*)(HB + row * DM) + lane;
#pragma unroll
        for (int j = 0; j < 4; ++j) { v2u w; w.x = pk2(v[j].x, v[j].y); w.y = pk2(v[j].z, v[j].w); o8[64 * j] = w; }
    }
    if (DO_F) {
        __syncthreads();
        const float* fsrc = DO_LN ? (const float*)dstR : src;
#pragma unroll 1
        for (int half = 0; half < 2; ++half) {
            f32x4 wfa[4][4]; float run = 0.f;
#pragma unroll
            for (int j = 0; j < 4; ++j)
#pragma unroll
                for (int e = 0; e < 4; ++e) wfa[j][e] = *(const f32x4*)(win_l + (size_t)(256 * j + 4 * lane + e) * NIN + 2304 + 4 * half);
            const float bf = bin_l[2304 + 4 * half + (lane & 3)];
            for (int i = 0; i < 32; ++i) {
                const size_t row = (size_t)panel * 256 + wave * 32 + i;
                const GAS f32x4* xr = (const GAS f32x4*)(fsrc + row * DM) + lane;
                f32x4 v[4];
#pragma unroll
                for (int j = 0; j < 4; ++j) v[j] = xr[64 * j];
                f32x4 pa = (f32x4){0.f, 0.f, 0.f, 0.f};
#pragma unroll
                for (int j = 0; j < 4; ++j) pa += wfa[j][0] * v[j].x + wfa[j][1] * v[j].y + wfa[j][2] * v[j].z + wfa[j][3] * v[j].w;
                float q[4] = {pa.x, pa.y, pa.z, pa.w};
#pragma unroll
                for (int h = 0; h < 4; ++h) q[h] = wave_sum(q[h]);
                float mine = q[0];
#pragma unroll
                for (int h = 1; h < 4; ++h) mine = ((lane & 3) == h) ? q[h] : mine;
                const float x = mine + bf;
                const float lf = fminf(x, 0.f) - log1pf(__expf(-fabsf(x)));
                run += lf;
                if (lane < 4) lcl[(wave * 32 + i) * 8 + 4 * half + lane] = run;
            }
            if (lane < 4) wtot[wave * 8 + 4 * half + lane] = run;
        }
        __syncthreads();
        const int b = panel >> 5, s0 = (panel & 31) * 256;
        for (int idx = tid; idx < 2048; idx += 512) { const int h = idx >> 8, r = idx & 255; float off = 0.f;
            for (int w = 0; w < (r >> 5); ++w) off += wtot[w * 8 + h];
            CL[((size_t)(b * 8 + h)) * SEQ + s0 + r] = lcl[r * 8 + h] + off; }
        if (tid < 8) { float t = 0.f; for (int w = 0; w < 8; ++w) t += wtot[w * 8 + tid]; TOT[panel * 8 + tid] = t; }
        __syncthreads();
    }
}

namespace swa {
constexpr int KSTR = 72, VSTR = 264;
constexpr int L_K = 0, L_VT = 256 * KSTR * 2, L_END = L_VT + 64 * VSTR * 2;
__device__ __forceinline__ int crow(int r, int hi) { return (r & 3) + 8 * (r >> 2) + 4 * hi; }
__device__ __forceinline__ void unit(int b, int hkv, int blk, bf16* Z, bf16* ZO, const float* sinks_l, LAS unsigned char* lds) {
    int tid_ = threadIdx.x; asm volatile("" : "+v"(tid_)); const int tid = tid_, lane = tid & 63, r32 = lane & 31, hi = lane >> 5; const int wid = __builtin_amdgcn_readfirstlane(tid >> 6);
    const size_t rowbase = (size_t)b * SEQ; const int k0 = blk * 128 - 128;
    {
        const int key = tid >> 1, half = tid & 1, kabs = k0 + key; const bool ok = kabs >= 0;
        const bf16* kp = Z + (rowbase + (ok ? kabs : 0)) * NZ + ZKA + hkv * 64 + 32 * half;
        const bf16* vp = Z + (rowbase + (ok ? kabs : 0)) * NZ + ZVA + hkv * 64 + 32 * half;
        v4u kv[4], vv[4];
#pragma unroll
        for (int c = 0; c < 4; ++c) { kv[c] = *(const GAS v4u*)(kp + 8 * c); vv[c] = *(const GAS v4u*)(vp + 8 * c); if (!ok) { kv[c] = (v4u){0u, 0u, 0u, 0u}; vv[c] = (v4u){0u, 0u, 0u, 0u}; } }
        LAS bf16* KL = (LAS bf16*)(lds + L_K); LAS bf16* VT = (LAS bf16*)(lds + L_VT);
#pragma unroll
        for (int c = 0; c < 4; ++c) {
            *(LAS v4u*)(KL + key * KSTR + 32 * half + 8 * c) = kv[c];
            const unsigned w[4] = {vv[c].x, vv[c].y, vv[c].z, vv[c].w};
#pragma unroll
            for (int e = 0; e < 4; ++e) { const int d = 32 * half + 8 * c + 2 * e; VT[d * VSTR + key] = (bf16)(w[e] & 0xffffu); VT[(d + 1) * VSTR + key] = (bf16)(w[e] >> 16); }
        }
    }
    __syncthreads();
    const LAS unsigned char* KLb = lds + L_K; const LAS unsigned char* VTb = lds + L_VT;
    for (int task = wid; task < 16; task += 8) {
        const int g = task >> 2, qt = task & 3, hq = hkv * 4 + g, i0 = blk * 128 + 32 * qt;
        bf16* qrow = Z + (rowbase + i0 + r32) * NZ + ZQA + hq * 64;
        bf16x8 qf[4];
#pragma unroll
        for (int d0 = 0; d0 < 4; ++d0) qf[d0] = *(const GAS bf16x8*)(qrow + 16 * d0 + 8 * hi);
        const float slope2 = exp2f(-(float)(hq + 1)) * LOG2E, sink2 = sinks_l[hq] * LOG2E;
        f32x16 s[5];
#pragma unroll
        for (int jt = 0; jt < 5; ++jt) {
            s[jt] = (f32x16){};
            const int slot = 32 * qt + 32 * jt + r32;
#pragma unroll
            for (int d0 = 0; d0 < 4; ++d0) { const bf16x8 a = *(const LAS bf16x8*)(KLb + (slot * KSTR + 16 * d0 + 8 * hi) * 2); s[jt] = __builtin_amdgcn_mfma_f32_32x32x16_bf16(a, qf[d0], s[jt], 0, 0, 0); }
        }
        float m = sink2;
#pragma unroll
        for (int jt = 0; jt < 5; ++jt)
#pragma unroll
            for (int r = 0; r < 16; ++r) {
                const int kslot = 32 * qt + 32 * jt + crow(r, hi);
                const int dist = 128 + r32 - 32 * jt - crow(r, hi);
                const bool ok = (dist >= 0) && (dist < 128) && (k0 + kslot >= 0);
                const float v = ok ? (s[jt][r] - slope2 * (float)dist) : -INFINITY;
                s[jt][r] = v; m = fmaxf(m, v);
            }
        m = fmaxf(m, __shfl_xor(m, 32));
        float l = 0.f;
#pragma unroll
        for (int jt = 0; jt < 5; ++jt)
#pragma unroll
            for (int r = 0; r < 16; ++r) { const float p = __builtin_amdgcn_exp2f(s[jt][r] - m); s[jt][r] = p; l += p; }
        l += __shfl_xor(l, 32);
        l += __builtin_amdgcn_exp2f(sink2 - m);
        const float inv = 1.0f / l;
#pragma unroll
        for (int dh = 0; dh < 2; ++dh) {
            f32x16 o = (f32x16){};
#pragma unroll
            for (int jt = 0; jt < 5; ++jt)
#pragma unroll
                for (int ks = 0; ks < 2; ++ks) {
                    v4u pw; pw.x = pg8::cvt_pk_bf16(s[jt][8 * ks + 0], s[jt][8 * ks + 1]); pw.y = pg8::cvt_pk_bf16(s[jt][8 * ks + 2], s[jt][8 * ks + 3]);
                    pw.z = pg8::cvt_pk_bf16(s[jt][8 * ks + 4], s[jt][8 * ks + 5]); pw.w = pg8::cvt_pk_bf16(s[jt][8 * ks + 6], s[jt][8 * ks + 7]);
                    const int d = 32 * dh + r32, slot = 32 * qt + 32 * jt + 16 * ks + 4 * hi;
                    const v2u lo = *(const LAS v2u*)(VTb + (d * VSTR + slot) * 2), hi8 = *(const LAS v2u*)(VTb + (d * VSTR + slot + 8) * 2);
                    const v4u av = (v4u){lo.x, lo.y, hi8.x, hi8.y};
                    o = __builtin_amdgcn_mfma_f32_32x32x16_bf16(__builtin_bit_cast(bf16x8, av), __builtin_bit_cast(bf16x8, pw), o, 0, 0, 0);
                }
#pragma unroll
            for (int j = 0; j < 4; ++j) { v2u w; w.x = pg8::cvt_pk_bf16(o[4 * j] * inv, o[4 * j + 1] * inv); w.y = pg8::cvt_pk_bf16(o[4 * j + 2] * inv, o[4 * j + 3] * inv);
                *(GAS v2u*)(ZO + (qrow - Z) + 32 * dh + 8 * j + 4 * hi) = w; }
        }
    }
    __syncthreads();
}
}

#if defined(PROBE_Y)
#define GSYNC() do { grid.sync(); grid.sync(); } while (0)
#else
#define GSYNC() grid.sync()
#endif
__global__ void __launch_bounds__(NWAVES * 64, 2) hybrid_fwd(Args args) {
    extern __shared__ __attribute__((aligned(16))) unsigned char lds_raw[];
    cg::grid_group grid = cg::this_grid();
    LAS unsigned char* lds = (LAS unsigned char*)lds_raw;
    const int tid = threadIdx.x, lane = tid & 63, wave = __builtin_amdgcn_readfirstlane(tid >> 6);
    const int G = gridDim.x, bx = blockIdx.x;
    const int vcu = (bx % 8) * (G / 8) + bx / 8;
    const int panel = vcu;
    unsigned char* ws = args.ws;
    const float* x = args.in[0];
    float* R = args.out;
    bf16* HB = (bf16*)(ws + WS_HB); bf16* MG = (bf16*)(ws + WS_MG); bf16* Z = (bf16*)(ws + WS_Z);
    float* CL = (float*)(ws + WS_CL); float* TOT = (float*)(ws + WS_TOT);
    float* TAIL = (float*)(ws + WS_TAIL); float* HP = (float*)(ws + WS_HP); float* HU = (float*)(ws + WS_HU);
    bf16* Hpanel = (bf16*)(ws + WS_Z + (size_t)panel * ZPANEL_B);
    bf16* Hadj = Hpanel - (size_t)panel * 256 * DFF;

    float* RD = (float*)(ws + WS_END) - (size_t)panel * 256 * DM; bf16* HBD = (bf16*)(ws + WS_END + 2 * MiB) - (size_t)panel * 256 * DM;
    float* CLD = (float*)(ws + WS_END + 4 * MiB); float* TOTD = (float*)(ws + WS_END + 8 * MiB);
    unsigned* QN = (unsigned*)(ws + WS_QN); unsigned* KN = (unsigned*)(ws + WS_KN);
    for (int i = bx * 512 + tid; i < DEPTH * 8192; i += G * 512) QN[i] = 0u;
    for (int i = bx * 512 + tid; i < DEPTH * 1024; i += G * 512) KN[i] = 0u;
    {
        LAS float* scr = (LAS float*)(lds + wave * 16384);
        const int gw = bx * NWAVES + wave, NGW = G * NWAVES;
        constexpr int I_IN = 16 * (NZ / 32), I_PA = 8 * 32, I_OUT = 16 * 32, I_FI = 16 * (5632 / 32), I_FO = 44 * 32, I_L = I_IN + 2 * I_PA + I_OUT + I_FI + I_FO;
        for (int it = gw; it < DEPTH * I_L; it += NGW) {
            const int l = it / I_L; int r = it % I_L;
            unsigned char* wl = ws + WS_W + (size_t)l * WL_BYTES;
            if (r < I_IN) { const int nblk = NZ / 32, kb = r / nblk, nb = r % nblk, n0 = 32 * nb;
                transpose_item(args.in[3] + (size_t)l * 1024 * NIN, NIN, 1024, 64 * kb, n0 + (n0 >= 2304 ? 8 : 0), (bf16*)(wl + WL_IN), n0, scr, lane); continue; } r -= I_IN;
            if (r < I_PA) { const int kb = r / 32, nb = r % 32; transpose_item(args.in[6] + (size_t)l * 512 * 1024, 1024, 512, 64 * kb, 32 * nb, (bf16*)(wl + WL_PA), 32 * nb, scr, lane); continue; } r -= I_PA;
            if (r < I_PA) { const int kb = r / 32, nb = r % 32; transpose_item(args.in[7] + (size_t)l * 512 * 1024, 1024, 512, 64 * kb, 32 * nb, (bf16*)(wl + WL_PB), 32 * nb, scr, lane); continue; } r -= I_PA;
            if (r < I_OUT) { const int kb = r / 32, nb = r % 32; transpose_item(args.in[8] + (size_t)l * 1024 * 1024, 1024, 1024, 64 * kb, 32 * nb, (bf16*)(wl + WL_OUT), 32 * nb, scr, lane); continue; } r -= I_OUT;
            if (r < I_FI) { const int nblk = 5632 / 32, kb = r / nblk, nb = r % nblk, n0 = 32 * nb, pn = n0 >> 8, j = n0 & 255;
                const int src = (j < 128) ? (128 * pn + j) : (DFF + 128 * pn + (j - 128));
                transpose_item(args.in[11] + (size_t)l * 1024 * 5632, 5632, 1024, 64 * kb, src, (bf16*)(wl + WL_FI), n0, scr, lane); continue; } r -= I_FI;
            { const int kb = r / 32, nb = r % 32; transpose_item(args.in[14] + (size_t)l * DFF * 1024, 1024, DFF, 64 * kb, 32 * nb, (bf16*)(wl + WL_FO), 32 * nb, scr, lane); }
        }
        __syncthreads();
#if !defined(NO_ROWF)
#if defined(PROBE_R)
        row_pass<false, true>(lds, panel, x, nullptr, HBD, nullptr, nullptr, args.in[3], args.in[4], CLD, TOTD);
__syncthreads();
#endif
        row_pass<false, true>(lds, panel, x, nullptr, HB, nullptr, nullptr, args.in[3], args.in[4], CL, TOT);
#endif
    }
    GSYNC();

    for (int l = 0; l < DEPTH; ++l) {
        unsigned char* wl = ws + WS_W + (size_t)l * WL_BYTES;
        const float* resid_in = (l == 0) ? x : R;
        {
            pg8::Gemm g{HB, (const bf16*)(wl + WL_IN), MROWS, NZ, 1024, 1024}; pg8::GroupOrder S{(vcu >> 5) << 5, vcu & 31, NZ / 256};
            pg8::EpiZ E{Z, NZ, args.in[4] + (size_t)l * NIN, C2, QN + l * 8192, KN + l * 1024};

#if !defined(NO_G1)
pg8::gemm_phase<pg8::EpiZ, pg8::GroupOrder, true, true>(lds, g, S, E);
#endif
#if defined(PROBE_G)
__syncthreads(); pg8::gemm_phase<pg8::EpiZ, pg8::GroupOrder, true, true>(lds, g, S, E);
#endif

        }
        GSYNC();
        {
            const int bh = vcu >> 2, sft = vcu & 3;
#pragma unroll 1
            for (int i = 0; i < 8; ++i) {
                const int base = (i >> 1) * 8, qb = (i & 1) ? (base + 7 - sft) : (base + sft);
#if defined(PROBE_A)
                { attn_body::bf16* Od = (attn_body::bf16*)(ws + WS_END) - ((size_t)((bh >> 3) * SEQ + qb * 256) * NZ + (bh & 7) * 64);
                  attn_body::attn_unit<8>(bh >> 3, bh & 7, qb, (const attn_body::bf16*)(Z + ZQB), (const attn_body::bf16*)(Z + ZKB), (const attn_body::bf16*)(Z + ZVB), Od, CL, TOT, (const float*)(QN + l * 8192), (const float*)(KN + l * 1024), (char*)lds_raw); }
#endif
#if !defined(NO_ATT)
                attn_body::attn_unit<8>(bh >> 3, bh & 7, qb, (const attn_body::bf16*)(Z + ZQB), (const attn_body::bf16*)(Z + ZKB), (const attn_body::bf16*)(Z + ZVB), (attn_body::bf16*)(Z + ZQB), CL, TOT, (const float*)(QN + l * 8192), (const float*)(KN + l * 1024), (char*)lds_raw);
#endif
            }
            __syncthreads();
#pragma unroll 1
            for (int i = 0; i < 4; ++i) { const int uid = vcu * 4 + i;
#if defined(PROBE_S)
 swa::unit(uid >> 7, (uid >> 6) & 1, uid & 63, Z, (bf16*)(ws + WS_END) - ((size_t)(uid >> 7) * SEQ + (uid & 63) * 128) * NZ, args.in[5] + l * 8, lds);
#endif
#if !defined(NO_SWA)
 swa::unit(uid >> 7, (uid >> 6) & 1, uid & 63, Z, Z, args.in[5] + l * 8, lds);
#endif
 }
        }
        GSYNC();
        {
            pg8::PanelOrder S{panel, 4};
#if defined(PROBE_G2)
            { pg8::Gemm g{Z + ZQA, (const bf16*)(wl + WL_PA), MROWS, 1024, 512, NZ}; pg8::EpiGate<false> E{MG, Z + ZGA, NZ};

#if !defined(NO_G2)
pg8::gemm_phase<pg8::EpiGate<false>, pg8::PanelOrder, true, true>(lds, g, S, E);
#endif
 }
            __syncthreads();
            { pg8::Gemm g{Z + ZQB, (const bf16*)(wl + WL_PB), MROWS, 1024, 512, NZ}; pg8::EpiGate<true> E{MG, Z + ZGB, NZ};

#if !defined(NO_G2)
pg8::gemm_phase<pg8::EpiGate<true>, pg8::PanelOrder, true, true>(lds, g, S, E);
#endif
 }
            __syncthreads();
#endif
            { pg8::Gemm g{Z + ZQA, (const bf16*)(wl + WL_PA), MROWS, 1024, 512, NZ}; pg8::EpiGate<false> E{MG, Z + ZGA, NZ};

#if !defined(NO_G2)
pg8::gemm_phase<pg8::EpiGate<false>, pg8::PanelOrder, true, true>(lds, g, S, E);
#endif
 }
            __syncthreads();
            { pg8::Gemm g{Z + ZQB, (const bf16*)(wl + WL_PB), MROWS, 1024, 512, NZ}; pg8::EpiGate<true> E{MG, Z + ZGB, NZ};

#if !defined(NO_G2)
pg8::gemm_phase<pg8::EpiGate<true>, pg8::PanelOrder, true, true>(lds, g, S, E);
#endif
 }
            __syncthreads();
            { pg8::Gemm g{MG, (const bf16*)(wl + WL_OUT), MROWS, 1024, 1024, 1024}; pg8::EpiRes E{resid_in, R, ALPHA};
#if defined(PROBE_G3)
{ pg8::EpiRes ED{resid_in, RD, ALPHA}; pg8::gemm_phase<pg8::EpiRes, pg8::PanelOrder, true, true>(lds, g, S, ED); __syncthreads(); }
#endif
#if !defined(NO_G3)
pg8::gemm_phase<pg8::EpiRes, pg8::PanelOrder, true, true>(lds, g, S, E);
#endif
 }
            __syncthreads();
#if defined(PROBE_R)
            row_pass<true, false>(lds, panel, R, RD, HBD, args.in[1] + l * DM, args.in[2] + l * DM, nullptr, nullptr, nullptr, nullptr);
__syncthreads();
#endif
            row_pass<true, false>(lds, panel, R, R, HB, args.in[1] + l * DM, args.in[2] + l * DM, nullptr, nullptr, nullptr, nullptr);
            __syncthreads();
        }
        {
            GSYNC();
            pg8::Gemm g{HB, (const bf16*)(wl + WL_FI), MROWS, 5632, 1024, 1024}; pg8::GroupOrder S{(vcu >> 5) << 5, vcu & 31, 22};
            pg8::EpiConv E{Z, args.in[12] + (size_t)l * 3 * DFF, args.in[13] + (size_t)l * DFF, TAIL, HP, HU, (LAS float*)(lds + TL_OFF)};
#if !defined(NO_CONV)
            pg8::gemm_phase<pg8::EpiConv, pg8::GroupOrder, true, true>(lds, g, S, E);
#endif
#if defined(PROBE_G)
            __syncthreads(); pg8::gemm_phase<pg8::EpiConv, pg8::GroupOrder, true, true>(lds, g, S, E);
#endif
        }
        GSYNC();
        {
            const float* cw = args.in[12] + (size_t)l * 3 * DFF;
            const bool first = (panel & 31) == 0;
            int tidf = threadIdx.x; asm volatile("" : "+v"(tidf));
            for (int idx = tidf; idx < 2 * DFF; idx += 512) { const int r = idx / DFF, c = idx % DFF;
                float t0 = 0.f, t1 = 0.f;
                if (!first) { t0 = TAIL[((size_t)(panel - 1) * 2 + 0) * DFF + c]; t1 = TAIL[((size_t)(panel - 1) * 2 + 1) * DFF + c]; }
                float cv = HP[((size_t)panel * 2 + r) * DFF + c];
                cv += (r == 0) ? (cw[c] * t0 + cw[DFF + c] * t1) : (cw[c] * t1);
                const float hv = cv * pg8::sigmoidf_(cv) * HU[((size_t)panel * 2 + r) * DFF + c];
                Hpanel[(size_t)r * DFF + c] = (bf16)f2bf(hv); }
            __syncthreads();
            { pg8::Gemm g{Hadj, (const bf16*)(wl + WL_FO), MROWS, 1024, DFF, DFF}; pg8::PanelOrder S{panel, 4}; pg8::EpiRes E{R, R, ALPHA};
#if defined(PROBE_G5)
{ pg8::EpiRes ED{R, RD, ALPHA}; pg8::gemm_phase<pg8::EpiRes, pg8::PanelOrder, true, true>(lds, g, S, ED); __syncthreads(); }
#endif
#if !defined(NO_G3)
pg8::gemm_phase<pg8::EpiRes, pg8::PanelOrder, true, true>(lds, g, S, E);
#endif
 }
            __syncthreads();
#if defined(PROBE_R)
            if (l + 1 < DEPTH) row_pass<true, true>(lds, panel, R, RD, HBD, args.in[9] + l * DM, args.in[10] + l * DM, args.in[3] + (size_t)(l + 1) * 1024 * NIN, args.in[4] + (size_t)(l + 1) * NIN, CLD, TOTD);
            else row_pass<true, false>(lds, panel, R, RD, HBD, args.in[9] + l * DM, args.in[10] + l * DM, nullptr, nullptr, nullptr, nullptr);
            __syncthreads();
#endif
#if !defined(NO_ROWF)
            if (l + 1 < DEPTH) row_pass<true, true>(lds, panel, R, R, HB, args.in[9] + l * DM, args.in[10] + l * DM, args.in[3] + (size_t)(l + 1) * 1024 * NIN, args.in[4] + (size_t)(l + 1) * NIN, CL, TOT);
            else
#endif
            row_pass<true, false>(lds, panel, R, R, HB, args.in[9] + l * DM, args.in[10] + l * DM, nullptr, nullptr, nullptr, nullptr);
            __syncthreads();
            if (l + 1 < DEPTH) GSYNC();
        }
    }
}

extern "C" void kernel_launch(void* const* d_in, const int* in_sizes, int n_in, void* d_out, int out_size, void* d_ws, size_t ws_size, hipStream_t stream) {
    static int grid = 0;
    if (grid == 0) {
        if (n_in != 15 || in_sizes[0] != MROWS * DM || out_size != MROWS * DM || ws_size < WS_END) { fprintf(stderr, "kernel_launch: unexpected shapes / workspace (n_in %d, in0 %d, out %d, ws %zu < %zu)\n", n_in, n_in > 0 ? in_sizes[0] : -1, out_size, ws_size, (size_t)WS_END); grid = -1; return; }
        int dev = 0, cus = 0, per_cu = 0;
        (void)hipGetDevice(&dev); (void)hipDeviceGetAttribute(&cus, hipDeviceAttributeMultiprocessorCount, dev);
        if (hipFuncSetAttribute((const void*)hybrid_fwd, hipFuncAttributeMaxDynamicSharedMemorySize, LDS_BYTES) != hipSuccess) { fprintf(stderr, "kernel_launch: hipFuncSetAttribute failed\n"); grid = -1; return; }
        (void)hipOccupancyMaxActiveBlocksPerMultiprocessor(&per_cu, (const void*)hybrid_fwd, NWAVES * 64, LDS_BYTES);
        (void)hipGetLastError();
        if (cus * per_cu < 256) fprintf(stderr, "kernel_launch: note: occupancy query says %d x %d workgroups; launching 256 anyway (the cooperative launch checks residency)\n", cus, per_cu);
        grid = 256;
    }
    if (grid < 0) return;
    Args a{};
    for (int i = 0; i < 15; ++i) a.in[i] = (const float*)d_in[i];
    a.out = (float*)d_out; a.ws = (unsigned char*)d_ws;
    void* kargs[] = {&a};
    hipError_t e = hipLaunchCooperativeKernel((const void*)hybrid_fwd, dim3(grid), dim3(NWAVES * 64), kargs, LDS_BYTES, stream);
    if (e != hipSuccess) fprintf(stderr, "kernel_launch: cooperative launch failed: %s\n", hipGetErrorString(e));
}
```

```cpp
#include <hip/hip_runtime.h>
#include <hip/hip_cooperative_groups.h>
#include <hip/hip_bf16.h>
#include <cstdio>
#include <cstdint>
#include <cmath>
namespace cg = cooperative_groups;

#ifndef A_AUX
#define A_AUX 0
#endif
namespace pg8 {
#define PG8_LAS __attribute__((address_space(3)))
typedef unsigned short bf16_t;
typedef short bf16x8 __attribute__((ext_vector_type(8)));
typedef float f32x4 __attribute__((ext_vector_type(4)));
typedef unsigned u32x4 __attribute__((ext_vector_type(4)));
constexpr int BM = 256, BK = 64, HALF = 128, HTB = HALF * BK * 2  , STAGE_BYTES = 8 * HTB;

__host__ __device__ __forceinline__ int lds_byte(int r, int c) { const int st = (r >> 4) * 2 + (c >> 5), rr = r & 15, cc = c & 31, ob = rr * 64 + cc * 2; return st * 1024 + (ob ^ (((ob >> 9) & 1) << 5)); }
__host__ __device__ __forceinline__ void stage_rc(int b, int& R, int& C) { const int st = b / 1024, sb = b % 1024, swz = sb ^ (((sb >> 9) & 1) << 5); R = (st >> 1) * 16 + swz / 64; C = (st & 1) * 32 + (swz % 64) / 2; }
__host__ __device__ __forceinline__ int perm32(int rho) { const int n = rho >> 4, i = rho & 15; return 8 * (i >> 2) + 4 * n + (i & 3); }

struct Unit { int pm, pn; };
struct Gemm { const bf16_t* A; const bf16_t* Bt; int M, N, K, lda; size_t apstride = 0; };

struct PanelOrder {
    int pm, nN, rev, rotm;
    __device__ __forceinline__ bool next(int i, Unit& u) const { if (i >= nN) return false; u.pm = pm; int n = i + (pm & rotm); n = n >= nN ? n - nN : n; u.pn = rev ? nN - 1 - n : n; return true; }
    __device__ __forceinline__ void a_ready(const Unit&) const {}
    __device__ __forceinline__ void done(const Unit&) const {}
};

struct GroupOrder {
    int gp0, j, nN;
    __device__ __forceinline__ bool next(int i, Unit& u) const { if (i >= nN) return false; const int L = i * 32 + j, per = 8 * nN, pg = L / per, rem = L - pg * per; u.pm = gp0 + 8 * pg + (rem & 7); u.pn = rem >> 3; return true; }
    __device__ __forceinline__ void a_ready(const Unit&) const {}
    __device__ __forceinline__ void done(const Unit&) const {}
};

__device__ __forceinline__ unsigned cvt_pk_bf16(float lo, float hi) { unsigned r; asm volatile("v_cvt_pk_bf16_f32 %0, %1, %2" : "=v"(r) : "v"(lo), "v"(hi)); return r; }
__device__ __forceinline__ float bf_lo(unsigned w) { return __uint_as_float(w << 16); }
__device__ __forceinline__ float bf_hi(unsigned w) { return __uint_as_float(w & 0xffff0000u); }
__device__ __forceinline__ float sigmoidf_(float x) { return __builtin_amdgcn_rcpf(1.0f + __expf(-x)); }


struct EpiZ {
    static constexpr bool PERM = true, AFTER_DRAIN = false, PROBE2 = true;
    bf16_t* O; int ldc; const float* bias; float qscale; unsigned* QN; unsigned* KN;
    __device__ __forceinline__ void operator()(const f32x4 (&acc)[2][2][4][2], const Unit& u, int wr, int wc, int fr_in, int fq_in) const {
        int fr = fr_in, fq = fq_in; asm volatile("" : "+v"(fr), "+v"(fq));
        const int row0 = u.pm * BM + wr * 64 + fr; const int col0 = u.pn * BM + wc * 32 + 8 * fq;
        const float sc = (u.pn == 0 || u.pn == 1 || u.pn == 3 || u.pn == 4) ? qscale : 1.f;
        f32x4 bv[2][2];
#pragma unroll
        for (int bj = 0; bj < 2; ++bj)
#pragma unroll
            for (int n = 0; n < 2; ++n) { const int c = col0 + bj * HALF + 4 * n; bv[bj][n] = *(const f32x4*)(bias + c + (c >= 2304 ? 8 : 0)); }
#pragma unroll
        for (int ai = 0; ai < 2; ++ai)
#pragma unroll
            for (int m = 0; m < 4; ++m) { bf16_t* rowp = O + (size_t)(row0 + ai * HALF + m * 16) * ldc + col0;
#pragma unroll
                for (int bj = 0; bj < 2; ++bj) { f32x4 v0 = (acc[ai][bj][m][0] + bv[bj][0]) * sc, v1 = (acc[ai][bj][m][1] + bv[bj][1]) * sc;
                    u32x4 w; w.x = cvt_pk_bf16(v0[0], v0[1]); w.y = cvt_pk_bf16(v0[2], v0[3]); w.z = cvt_pk_bf16(v1[0], v1[1]); w.w = cvt_pk_bf16(v1[2], v1[3]);
                    *(u32x4*)(rowp + bj * HALF) = w; } }
        if (u.pn >= 3 && u.pn <= 6) {
            const int lane = fq * 16 + fr;
#pragma unroll
            for (int bj = 0; bj < 2; ++bj) {
                float mx = 0.f;
#pragma unroll
                for (int ai = 0; ai < 2; ++ai)
#pragma unroll
                    for (int m = 0; m < 4; ++m) { const f32x4 v0 = (acc[ai][bj][m][0] + bv[bj][0]) * sc, v1 = (acc[ai][bj][m][1] + bv[bj][1]) * sc;
                        float s = (v0[0] * v0[0] + v0[1] * v0[1]) + (v0[2] * v0[2] + v0[3] * v0[3]) + (v1[0] * v1[0] + v1[1] * v1[1]) + (v1[2] * v1[2] + v1[3] * v1[3]);
                        s += __shfl_xor(s, 16); s += __shfl_xor(s, 32); mx = fmaxf(mx, s); }
                mx = fmaxf(mx, __shfl_xor(mx, 1)); mx = fmaxf(mx, __shfl_xor(mx, 2)); mx = fmaxf(mx, __shfl_xor(mx, 4)); mx = fmaxf(mx, __shfl_xor(mx, 8));
                if (lane == 0) { const int hl = 2 * bj + (wc >> 1), half = wc & 1;
                    if (u.pn <= 4) atomicMax(QN + ((u.pm * 8 + 4 * (u.pn - 3) + hl) * 2 + half), __float_as_uint(mx));
                    else atomicMax(KN + (((u.pm >> 5) * 8 + 4 * (u.pn - 5) + hl) * 2 + half), __float_as_uint(mx)); }
            }
        }
    }
};

template <bool SECOND> struct EpiGate {
    static constexpr bool PERM = true, AFTER_DRAIN = false, PROBE2 = false;
    bf16_t* MG; const bf16_t* G; int ldg;
    __device__ __forceinline__ void operator()(const f32x4 (&acc)[2][2][4][2], const Unit& u, int wr, int wc, int fr_in, int fq_in) const {
        int fr = fr_in, fq = fq_in; asm volatile("" : "+v"(fr), "+v"(fq));
        const int row0 = u.pm * BM + wr * 64 + fr; const int col0 = u.pn * BM + wc * 32 + 8 * fq;
#pragma unroll
        for (int ai = 0; ai < 2; ++ai) {
            u32x4 gw[4][2], pw[4][2];
#pragma unroll
            for (int m = 0; m < 4; ++m)
#pragma unroll
                for (int bj = 0; bj < 2; ++bj) { const size_t row = (size_t)(row0 + ai * HALF + m * 16);
                    gw[m][bj] = *(const u32x4*)(G + row * ldg + col0 + bj * HALF);
                    if (SECOND) pw[m][bj] = *(const u32x4*)(MG + row * 1024 + col0 + bj * HALF); }
#pragma unroll
            for (int m = 0; m < 4; ++m)
#pragma unroll
                for (int bj = 0; bj < 2; ++bj) { const size_t row = (size_t)(row0 + ai * HALF + m * 16);
                    bf16_t* mp = MG + row * 1024 + col0 + bj * HALF;
                    const f32x4 a0 = acc[ai][bj][m][0], a1 = acc[ai][bj][m][1]; const u32x4 g = gw[m][bj];
                    float v[8];
                    v[0] = sigmoidf_(bf_lo(g.x)) * a0[0]; v[1] = sigmoidf_(bf_hi(g.x)) * a0[1]; v[2] = sigmoidf_(bf_lo(g.y)) * a0[2]; v[3] = sigmoidf_(bf_hi(g.y)) * a0[3];
                    v[4] = sigmoidf_(bf_lo(g.z)) * a1[0]; v[5] = sigmoidf_(bf_hi(g.z)) * a1[1]; v[6] = sigmoidf_(bf_lo(g.w)) * a1[2]; v[7] = sigmoidf_(bf_hi(g.w)) * a1[3];
                    if (SECOND) { const u32x4 p = pw[m][bj];
                        v[0] += bf_lo(p.x); v[1] += bf_hi(p.x); v[2] += bf_lo(p.y); v[3] += bf_hi(p.y); v[4] += bf_lo(p.z); v[5] += bf_hi(p.z); v[6] += bf_lo(p.w); v[7] += bf_hi(p.w); }
                    u32x4 w; w.x = cvt_pk_bf16(v[0], v[1]); w.y = cvt_pk_bf16(v[2], v[3]); w.z = cvt_pk_bf16(v[4], v[5]); w.w = cvt_pk_bf16(v[6], v[7]);
                    *(u32x4*)mp = w; }
        }
    }
};

template <bool recon, bool GST = false> struct EpiRes {
    static constexpr bool PERM = true, AFTER_DRAIN = false, PROBE2 = false;
    const float* base; float* out; float alpha; PG8_LAS const float* st; const float* lg; const float* lb; const float* gst = nullptr;
    __device__ __forceinline__ void operator()(const f32x4 (&acc)[2][2][4][2], const Unit& u, int wr, int wc, int fr_in, int fq_in) const {
        int fr = fr_in, fq = fq_in; asm volatile("" : "+v"(fr), "+v"(fq));
        typedef float f32x2s __attribute__((ext_vector_type(2)));
        const int row0 = u.pm * BM + wr * 64 + fr; const int col0 = u.pn * BM + wc * 32 + 8 * fq;
        f32x4 bs[2][2][2];
#define ER_LOAD(buf, k_) do { _Pragma("unroll") for (int mm = 0; mm < 2; ++mm) { const size_t off = (size_t)(row0 + (((k_) >> 1) & 1) * HALF + (2 * ((k_) & 1) + mm) * 16) * 1024 + col0 + ((k_) >> 2) * HALF; \
            bs[buf][mm][0] = *(const f32x4*)(base + off); bs[buf][mm][1] = *(const f32x4*)(base + off + 4); } } while (0)
        ER_LOAD(0, 0);
#pragma unroll
        for (int k = 0; k < 8; ++k) {
            const int bj = k >> 2, ai = (k >> 1) & 1, buf = k & 1;
            if (k < 7) ER_LOAD((k + 1) & 1, k + 1);
            f32x4 g0 = (f32x4){1.f, 1.f, 1.f, 1.f}, g1 = g0, b0 = (f32x4){0.f, 0.f, 0.f, 0.f}, b1 = b0;
            if (recon) { g0 = *(const f32x4*)(lg + col0 + bj * HALF); g1 = *(const f32x4*)(lg + col0 + bj * HALF + 4); b0 = *(const f32x4*)(lb + col0 + bj * HALF); b1 = *(const f32x4*)(lb + col0 + bj * HALF + 4); }
#pragma unroll
            for (int mm = 0; mm < 2; ++mm) { const int m = 2 * (k & 1) + mm; const size_t off = (size_t)(row0 + ai * HALF + m * 16) * 1024 + col0 + bj * HALF;
                f32x4 h0 = bs[buf][mm][0], h1 = bs[buf][mm][1];
                if (recon) { f32x2s ms; if (GST) ms = *(const f32x2s*)(gst + (size_t)(u.pm * BM + ai * HALF + wr * 64 + m * 16 + fr) * 2); else ms = *(const PG8_LAS f32x2s*)(st + (ai * HALF + wr * 64 + m * 16 + fr) * 2);
                    h0 = (h0 - ms.x) * ms.y * g0 + b0; h1 = (h1 - ms.x) * ms.y * g1 + b1; }
                *(f32x4*)(out + off) = h0 * alpha + acc[ai][bj][m][0];
                *(f32x4*)(out + off + 4) = h1 * alpha + acc[ai][bj][m][1]; }
        }
#undef ER_LOAD
    }
};

__device__ __forceinline__ float dpp_shr1(float v) { return __builtin_bit_cast(float, __builtin_amdgcn_update_dpp(0, __builtin_bit_cast(int, v), 0x111, 0xf, 0xf, true)); }
__device__ __forceinline__ float dpp_shr2(float v) { return __builtin_bit_cast(float, __builtin_amdgcn_update_dpp(0, __builtin_bit_cast(int, v), 0x112, 0xf, 0xf, true)); }
__device__ __forceinline__ float dpp_ror1(float v) { return __builtin_bit_cast(float, __builtin_amdgcn_update_dpp(0, __builtin_bit_cast(int, v), 0x121, 0xf, 0xf, false)); }
__device__ __forceinline__ float dpp_ror2(float v) { return __builtin_bit_cast(float, __builtin_amdgcn_update_dpp(0, __builtin_bit_cast(int, v), 0x122, 0xf, 0xf, false)); }
__device__ __forceinline__ float lane_get(float v, int src_lane) { return __builtin_bit_cast(float, __builtin_amdgcn_ds_bpermute(src_lane * 4, __builtin_bit_cast(int, v))); }

struct EpiConv {
    static constexpr bool PERM = true, AFTER_DRAIN = false, PROBE2 = false;
    bf16_t* HZ;
    const float* cw; const float* cb;
    float* TAIL; float* HP; float* HU;
    PG8_LAS float* tl;
    __device__ __forceinline__ void operator()(const f32x4 (&acc)[2][2][4][2], const Unit& u, int wr, int wc, int fr_in, int fq_in) const {
        int fr = fr_in, fq = fq_in; asm volatile("" : "+v"(fr), "+v"(fq));
        const int lane = fq * 16 + fr;
        const int colw = wc * 32 + 8 * fq; const int hc0 = u.pn * 128 + colw;
        if (fr >= 14) {
#pragma unroll
            for (int ai = 0; ai < 2; ++ai)
#pragma unroll
                for (int n = 0; n < 2; ++n) *(PG8_LAS f32x4*)(tl + ((ai * 2 + wr) * 2 + (fr - 14)) * 128 + colw + 4 * n) = acc[ai][0][3][n];
            if (wr == 1) {
#pragma unroll
                for (int n = 0; n < 2; ++n) *(f32x4*)(TAIL + ((size_t)u.pm * 2 + (fr - 14)) * 2816 + hc0 + 4 * n) = acc[1][0][3][n];
            }
        }
        asm volatile("s_waitcnt lgkmcnt(0)" ::: "memory"); __builtin_amdgcn_s_barrier(); asm volatile("" ::: "memory");
        typedef unsigned u32x2 __attribute__((ext_vector_type(2)));
        u32x2 pk0[2][4];
#pragma unroll
        for (int n = 0; n < 2; ++n) {
            const f32x4 w0 = *(const f32x4*)(cw + hc0 + 4 * n), w1 = *(const f32x4*)(cw + 2816 + hc0 + 4 * n), w2 = *(const f32x4*)(cw + 5632 + hc0 + 4 * n), bb = *(const f32x4*)(cb + hc0 + 4 * n);
#pragma unroll
            for (int ai = 0; ai < 2; ++ai) {
                const int lin = ai * 2 + wr;
                f32x4 hA = (f32x4){0.f, 0.f, 0.f, 0.f}, hB = (f32x4){0.f, 0.f, 0.f, 0.f};
                if (lin > 0) { hA = *(const PG8_LAS f32x4*)(tl + ((lin - 1) * 2 + 1) * 128 + colw + 4 * n); hB = *(const PG8_LAS f32x4*)(tl + ((lin - 1) * 2 + 0) * 128 + colw + 4 * n); }
#pragma unroll
                for (int m = 0; m < 4; ++m) {
                    float hv[4], cv[4];
#pragma unroll
                    for (int e = 0; e < 4; ++e) {
                        const float G = acc[ai][0][m][n][e];
                        float X, Y;
                        if (m == 0) { X = hA[e]; Y = (fr == 0) ? hB[e] : hA[e]; }
                        else { const float Gp = acc[ai][0][m - 1][n][e]; X = dpp_ror1(Gp); Y = dpp_ror2(Gp); }
                        const float s1 = dpp_shr1(G), s2 = dpp_shr2(G);
                        const float p1 = (fr >= 1) ? s1 : X, p2 = (fr >= 2) ? s2 : Y;
                        const float c = bb[e] + w0[e] * p2 + w1[e] * p1 + w2[e] * G;
                        cv[e] = c;
                        hv[e] = c * sigmoidf_(c) * acc[ai][1][m][n][e];
                    }
                    const int rl = ai * HALF + wr * 64 + m * 16 + fr;
                    u32x2 w; w.x = cvt_pk_bf16(hv[0], hv[1]); w.y = cvt_pk_bf16(hv[2], hv[3]);
                    if (n == 0) pk0[ai][m] = w;
                    else { u32x4 w4; w4.x = pk0[ai][m].x; w4.y = pk0[ai][m].y; w4.z = w.x; w4.w = w.y; *(u32x4*)(HZ + (size_t)u.pm * (256 * 4352) + rl * 2816 + hc0) = w4; }
                    if (ai == 0 && m == 0 && wr == 0 && fr < 2) {
                        *(f32x4*)(HP + ((size_t)u.pm * 2 + fr) * 2816 + hc0 + 4 * n) = (f32x4){cv[0], cv[1], cv[2], cv[3]};
                        *(f32x4*)(HU + ((size_t)u.pm * 2 + fr) * 2816 + hc0 + 4 * n) = acc[0][1][0][n];
                    }
                }
            }
        }
    }
};

template <class Epi, class Sched, bool ALIGN_EPI = false, bool SP2 = false>
__device__ __forceinline__ void gemm_phase(PG8_LAS unsigned char* lds, const Gemm g, const Sched& S, const Epi& E) {
    int tid_ = threadIdx.x; asm volatile("" : "+v"(tid_)); const int tid = tid_, wid = __builtin_amdgcn_readfirstlane(tid >> 6), lane = tid & 63, wr = wid >> 2, wc = wid & 3, fr = lane & 15, fq = lane >> 4;
    const int K = g.K, nt = K / BK;
    unsigned voffA[2], voffB[2];
#pragma unroll
    for (int i = 0; i < 2; ++i) { int R, C; stage_rc(tid * 16 + i * 8192, R, C); const int Rb = Epi::PERM ? ((R & ~31) + perm32(R & 31)) : R;
        voffA[i] = (unsigned)(R * g.lda + C) * 2u; voffB[i] = (unsigned)(Rb * K + C) * 2u; }
    const size_t kstep = (size_t)(BK * 2);
    const size_t hstepA = (size_t)HALF * g.lda * 2, hstepB = (size_t)HALF * K * 2;
    const size_t tstepA = g.apstride ? g.apstride : 2 * hstepA, tstepB = 2 * hstepB;
    const unsigned ldsw = (unsigned)wid * 1024u;
    const int aoff = lds_byte(wr * 64 + fr, fq * 8), boff = lds_byte(wc * 32 + fr, fq * 8);
#define PG8_SA(b, h) (((b) * 2 + (h)) * HTB)
#define PG8_SB(b, h) ((4 + (b) * 2 + (h)) * HTB)
#define PG8_STAGE(bufoff, gbase, voff) do { _Pragma("unroll") for (int _i = 0; _i < 2; ++_i) \
        __builtin_amdgcn_global_load_lds((const unsigned*)((const char*)(gbase) + (voff)[_i]), (PG8_LAS unsigned*)(lds + (bufoff) + ldsw + _i * 8192), 16, 0, 0); } while (0)
#define PG8_STAGEA(bufoff, gbase, voff) do { _Pragma("unroll") for (int _i = 0; _i < 2; ++_i) \
        __builtin_amdgcn_global_load_lds((const unsigned*)((const char*)(gbase) + (voff)[_i]), (PG8_LAS unsigned*)(lds + (bufoff) + ldsw + _i * 8192), 16, 0, A_AUX); } while (0)
#define PG8_LDA(dst, b, h) do { _Pragma("unroll") for (int m = 0; m < 4; ++m) _Pragma("unroll") for (int k = 0; k < 2; ++k) dst[m][k] = *(const PG8_LAS bf16x8*)(lds + PG8_SA(b, h) + aoff + m * 2048 + k * 1024); } while (0)
#define PG8_LDB(dst, b, h) do { _Pragma("unroll") for (int n = 0; n < 2; ++n) _Pragma("unroll") for (int k = 0; k < 2; ++k) dst[n][k] = *(const PG8_LAS bf16x8*)(lds + PG8_SB(b, h) + boff + n * 2048 + k * 1024); } while (0)
#define PG8_MMA(ai, bj, At, Bt) do { __builtin_amdgcn_s_setprio(1); _Pragma("unroll") for (int m = 0; m < 4; ++m) _Pragma("unroll") for (int n = 0; n < 2; ++n) _Pragma("unroll") for (int k = 0; k < 2; ++k) \
        acc[ai][bj][m][n] = __builtin_amdgcn_mfma_f32_16x16x32_bf16(Bt[n][k], At[m][k], acc[ai][bj][m][n], 0, 0, 0); __builtin_amdgcn_s_setprio(0); } while (0)
#define PG8_WAIT_V(n) asm volatile("s_waitcnt vmcnt(" #n ")" ::: "memory")
#define PG8_WAIT_L(n) asm volatile("s_waitcnt lgkmcnt(" #n ")" ::: "memory")
#define PG8_BAR __builtin_amdgcn_s_barrier()
#define PG8_SCHED __builtin_amdgcn_sched_barrier(0)
    Unit cur, nxt; int ui = 0;
    if (!S.next(0, cur)) return;
    f32x4 acc[2][2][4][2];
#pragma unroll
    for (int a = 0; a < 2; ++a)
#pragma unroll
        for (int b = 0; b < 2; ++b)
#pragma unroll
            for (int m = 0; m < 4; ++m)
#pragma unroll
                for (int n = 0; n < 2; ++n) acc[a][b][m][n] = (f32x4){0.f, 0.f, 0.f, 0.f};
    bf16x8 At[4][2], B0[2][2], B1[2][2];
    const char* cA = (const char*)g.A + (size_t)cur.pm * tstepA; const char* cB = (const char*)g.Bt + (size_t)cur.pn * tstepB;
    S.a_ready(cur);
    if constexpr (SP2) {
        PG8_STAGE(PG8_SB(0, 0), cB, voffB); PG8_STAGE(PG8_SB(0, 1), cB + hstepB, voffB); PG8_STAGEA(PG8_SA(0, 0), cA, voffA); PG8_STAGEA(PG8_SA(0, 1), cA + hstepA, voffA);
        if (wr == 1) PG8_BAR;
        PG8_WAIT_V(2); PG8_BAR;
        PG8_STAGE(PG8_SB(1, 0), cB + kstep, voffB); PG8_STAGEA(PG8_SA(1, 0), cA + kstep, voffA); PG8_STAGE(PG8_SB(1, 1), cB + hstepB + kstep, voffB);
        PG8_WAIT_V(6); PG8_BAR;
    } else {
        PG8_STAGE(PG8_SB(0, 0), cB, voffB); PG8_STAGEA(PG8_SA(0, 0), cA, voffA); PG8_STAGE(PG8_SB(0, 1), cB + hstepB, voffB); PG8_STAGEA(PG8_SA(0, 1), cA + hstepA, voffA);
        if (wr == 1) PG8_BAR;
        PG8_WAIT_V(4); PG8_BAR;
        PG8_STAGE(PG8_SB(1, 0), cB + kstep, voffB); PG8_STAGEA(PG8_SA(1, 0), cA + kstep, voffA); PG8_STAGE(PG8_SB(1, 1), cB + hstepB + kstep, voffB);
        PG8_WAIT_V(6); PG8_BAR;
    }
    for (;;) {
        const bool has_next = S.next(ui + 1, nxt);
        const char* nA = has_next ? (const char*)g.A + (size_t)nxt.pm * tstepA : cA; const char* nB = has_next ? (const char*)g.Bt + (size_t)nxt.pn * tstepB : cB;
        for (int t = 0; t < nt; t += 2) {
            const bool last = (t == nt - 2);
            const char* a1 = cA + (size_t)(t + 1) * kstep;
            const char* a2 = last ? nA : cA + (size_t)(t + 2) * kstep; const char* b2 = last ? nB : cB + (size_t)(t + 2) * kstep;
            const char* a3 = a2 + kstep; const char* b3 = b2 + kstep;
            if (last && has_next) S.a_ready(nxt);
            if constexpr (SP2) {
            PG8_LDB(B0, 0, 0); PG8_LDB(B1, 0, 1); PG8_SCHED; PG8_LDA(At, 0, 0); PG8_STAGEA(PG8_SA(1, 1), a1 + hstepA, voffA);
            PG8_WAIT_V(8); PG8_WAIT_L(0); PG8_BAR; PG8_MMA(0, 0, At, B0); PG8_MMA(0, 1, At, B1); PG8_BAR; PG8_SCHED;
            PG8_LDA(At, 0, 1); PG8_STAGE(PG8_SB(0, 0), b2, voffB); PG8_STAGE(PG8_SB(0, 1), b2 + hstepB, voffB); PG8_STAGEA(PG8_SA(0, 0), a2, voffA);
            PG8_WAIT_V(8); PG8_WAIT_L(0); PG8_BAR; PG8_MMA(1, 0, At, B0); PG8_MMA(1, 1, At, B1); PG8_BAR; PG8_SCHED;
            PG8_LDB(B0, 1, 0); PG8_LDB(B1, 1, 1); PG8_SCHED; PG8_LDA(At, 1, 0); PG8_STAGEA(PG8_SA(0, 1), a2 + hstepA, voffA);
            PG8_WAIT_V(8); PG8_WAIT_L(0); PG8_BAR; PG8_MMA(0, 0, At, B0); PG8_MMA(0, 1, At, B1); PG8_BAR; PG8_SCHED;
            PG8_LDA(At, 1, 1); PG8_STAGE(PG8_SB(1, 0), b3, voffB); PG8_STAGE(PG8_SB(1, 1), b3 + hstepB, voffB); PG8_STAGEA(PG8_SA(1, 0), a3, voffA);
            PG8_WAIT_V(8); PG8_WAIT_L(0); PG8_BAR; PG8_MMA(1, 0, At, B0); PG8_MMA(1, 1, At, B1); PG8_BAR; PG8_SCHED;
            } else {
            PG8_LDB(B0, 0, 0); PG8_SCHED; PG8_LDA(At, 0, 0); PG8_STAGEA(PG8_SA(1, 1), a1 + hstepA, voffA);
            PG8_WAIT_L(8); PG8_BAR; PG8_WAIT_L(0); PG8_MMA(0, 0, At, B0); PG8_BAR; PG8_SCHED;
            PG8_LDB(B1, 0, 1); PG8_STAGE(PG8_SB(0, 0), b2, voffB);
            PG8_BAR; PG8_WAIT_L(0); PG8_MMA(0, 1, At, B1); PG8_BAR;
            PG8_LDA(At, 0, 1); PG8_STAGEA(PG8_SA(0, 0), a2, voffA);
            PG8_BAR; PG8_WAIT_L(0); PG8_MMA(1, 0, At, B0); PG8_BAR; PG8_SCHED;
            PG8_STAGE(PG8_SB(0, 1), b2 + hstepB, voffB);
            PG8_WAIT_V(6); PG8_BAR; PG8_MMA(1, 1, At, B1); PG8_BAR;
            PG8_LDB(B0, 1, 0); PG8_SCHED; PG8_LDA(At, 1, 0); PG8_STAGEA(PG8_SA(0, 1), a2 + hstepA, voffA);
            PG8_WAIT_L(8); PG8_BAR; PG8_WAIT_L(0); PG8_MMA(0, 0, At, B0); PG8_BAR; PG8_SCHED;
            PG8_LDB(B1, 1, 1); PG8_STAGE(PG8_SB(1, 0), b3, voffB);
            PG8_BAR; PG8_WAIT_L(0); PG8_MMA(0, 1, At, B1); PG8_BAR;
            PG8_LDA(At, 1, 1); PG8_STAGEA(PG8_SA(1, 0), a3, voffA);
            PG8_BAR; PG8_WAIT_L(0); PG8_MMA(1, 0, At, B0); PG8_BAR; PG8_SCHED;
            PG8_STAGE(PG8_SB(1, 1), b3 + hstepB, voffB);
            PG8_WAIT_V(6); PG8_BAR; PG8_MMA(1, 1, At, B1); PG8_BAR;
            }
        }
        if constexpr (ALIGN_EPI) { if (wr == 0) PG8_BAR; }
        if constexpr (!Epi::AFTER_DRAIN) { E(acc, cur, wr, wc, fr, fq);
            S.done(cur); }
        if (!has_next) break;
#pragma unroll
        for (int a = 0; a < 2; ++a)
#pragma unroll
            for (int b = 0; b < 2; ++b)
#pragma unroll
                for (int m = 0; m < 4; ++m)
#pragma unroll
                    for (int n = 0; n < 2; ++n) acc[a][b][m][n] = (f32x4){0.f, 0.f, 0.f, 0.f};
        cur = nxt; cA = nA; cB = nB; ++ui;
        if constexpr (ALIGN_EPI) { if (wr == 1) PG8_BAR; }
    }
    PG8_WAIT_V(0);
    if constexpr (!ALIGN_EPI) { if (wr == 0) PG8_BAR; }
    PG8_BAR;
    if constexpr (Epi::AFTER_DRAIN) { E.fused(acc, cur, wr, wc, fr, fq, lds, wid, lane); S.done(cur); }
#undef PG8_SA
#undef PG8_SB
#undef PG8_STAGE
#undef PG8_STAGEA
#undef PG8_LDA
#undef PG8_LDB
#undef PG8_MMA
#undef PG8_WAIT_V
#undef PG8_WAIT_L
#undef PG8_BAR
#undef PG8_SCHED
}

}

namespace attn_body {
using bf16=__hip_bfloat16;
using bf16x8=__attribute__((ext_vector_type(8)))short;
using s16x4=__attribute__((ext_vector_type(4)))short;
using f32x16=__attribute__((ext_vector_type(16)))float;
using u32x4=__attribute__((ext_vector_type(4)))unsigned;
constexpr int BATCH=8,NHEAD=8,SEQ=8192,D=64,DM=4352;
constexpr int NW=8,QBLK=32,QB=QBLK*NW,KVBLK=64,NQB=SEQ/QB;
constexpr int ATTN_PITCH=DM, ATTN_UNIT_ROWS=QB;
__device__ __forceinline__ int crow(int r,int hi){return (r&3)+8*(r>>2)+4*hi;}
#define SBAR() __builtin_amdgcn_sched_barrier(0)
__device__ __forceinline__ void cmask(f32x16&p0,f32x16&p1,int jb,int qrel,int hi){
  const float NEG=-INFINITY; int kb=64*jb+4*hi;
  #pragma unroll
  for(int r=0;r<16;++r){int kv=kb+(r&3)+8*(r>>2); if(kv>qrel)p0[r]=NEG; if(kv+32>qrel)p1[r]=NEG;}
}

constexpr int NSLOT=3, SLOTB=8192;
constexpr int LDS_K=0, LDS_V=NSLOT*SLOTB, LDS_WS=2*NSLOT*SLOTB, LDS_OST=LDS_WS+NW*64*4, LDS_BYTES=LDS_OST+NW*4096;
constexpr int LDS_CB=LDS_BYTES;
constexpr float C2=0.125f*1.4426950408889634f;
__device__ __forceinline__ void glds16(const void*gsrc,unsigned lds_dst){unsigned keep;
  asm volatile("s_mov_b32 %0, m0\n\ts_mov_b32 m0, %2\n\ts_nop 0\n\tglobal_load_lds_dwordx4 %1, off\n\ts_mov_b32 m0, %0":"=&s"(keep):"v"(gsrc),"s"(lds_dst):"memory");}
__device__ __forceinline__ float max3f(float a,float b,float c){float r;asm("v_max3_f32 %0, %1, %2, %3":"=v"(r):"v"(a),"v"(b),"v"(c));return r;}
__device__ __forceinline__ float max2f(float a,float b){float r;asm("v_max_f32_e32 %0, %1, %2":"=v"(r):"v"(a),"v"(b));return r;}
__device__ __forceinline__ float fadd_s(float a,float b){float r;asm("v_add_f32_e32 %0, %1, %2":"=v"(r):"v"(a),"v"(b));return r;}
__device__ __forceinline__ float fsub_s(float a,float b){float r;asm("v_sub_f32_e32 %0, %1, %2":"=v"(r):"v"(a),"v"(b));return r;}
typedef float f32x2_t __attribute__((ext_vector_type(2))); typedef __bf16 bf16x2_t __attribute__((ext_vector_type(2)));
__device__ __forceinline__ unsigned cvtpk_s(float lo,float hi){f32x2_t v={lo,hi};bf16x2_t b=__builtin_convertvector(v,bf16x2_t);return __builtin_bit_cast(unsigned,b);}
#define WAIT_BAR(N) asm volatile("s_waitcnt vmcnt(" #N ") lgkmcnt(0)\n\ts_barrier":::"memory")

__device__ __forceinline__ void qkt(f32x16&p0,f32x16&p1,const char*Kslot,const bf16x8*qr,const f32x16&negm,int r32,int hi){
  const char*kb=Kslot+hi*1024+r32*16;
  #pragma unroll
  for(int d0=0;d0<4;++d0){
    const bf16x8 b0=*reinterpret_cast<const bf16x8*>(kb+d0*2048);
    const bf16x8 b1=*reinterpret_cast<const bf16x8*>(kb+d0*2048+512);
    if(d0==0){p0=__builtin_amdgcn_mfma_f32_32x32x16_bf16(b0,qr[0],negm,0,0,0);p1=__builtin_amdgcn_mfma_f32_32x32x16_bf16(b1,qr[0],negm,0,0,0);}
    else{p0=__builtin_amdgcn_mfma_f32_32x32x16_bf16(b0,qr[d0],p0,0,0,0);p1=__builtin_amdgcn_mfma_f32_32x32x16_bf16(b1,qr[d0],p1,0,0,0);}}
}
typedef __attribute__((address_space(3))) const char* lds_cptr;
typedef short v4i16_t __attribute__((ext_vector_type(4)));
__device__ __forceinline__ void kload8(bf16x8*kf,lds_cptr kp){
  kf[0]=*(const __attribute__((address_space(3))) bf16x8*)(kp);      kf[1]=*(const __attribute__((address_space(3))) bf16x8*)(kp+512);
  kf[2]=*(const __attribute__((address_space(3))) bf16x8*)(kp+2048); kf[3]=*(const __attribute__((address_space(3))) bf16x8*)(kp+2560);
  kf[4]=*(const __attribute__((address_space(3))) bf16x8*)(kp+4096); kf[5]=*(const __attribute__((address_space(3))) bf16x8*)(kp+4608);
  kf[6]=*(const __attribute__((address_space(3))) bf16x8*)(kp+6144); kf[7]=*(const __attribute__((address_space(3))) bf16x8*)(kp+6656);
}
__device__ __forceinline__ void kload2(bf16x8*kf,lds_cptr kp,int j){ kf[2*j]=*(const __attribute__((address_space(3))) bf16x8*)(kp+j*2048); kf[2*j+1]=*(const __attribute__((address_space(3))) bf16x8*)(kp+j*2048+512); }
__device__ __forceinline__ s16x4 vtr(lds_cptr p){ return __builtin_bit_cast(s16x4,__builtin_amdgcn_ds_read_tr16_b64_v4i16((__attribute__((address_space(3))) v4i16_t*)p)); }
__device__ __forceinline__ float rowmax(const f32x16&p0,const f32x16&p1){
  float a=max3f(p0[0],p0[1],p1[0]),b=max3f(p0[2],p0[3],p1[1]);a=max3f(a,p1[2],p1[3]);
  #pragma unroll
  for(int r=4;r<16;r+=4){a=max3f(a,p0[r],p0[r+1]);b=max3f(b,p0[r+2],p0[r+3]);a=max3f(a,p1[r],p1[r+1]);b=max3f(b,p1[r+2],p1[r+3]);}
  const float m=max2f(a,b);
  auto rr=__builtin_amdgcn_permlane32_swap(__float_as_uint(m),__float_as_uint(m),false,false);
  return max2f(__uint_as_float(rr[0]),__uint_as_float(rr[1]));
}
__device__ __forceinline__ void pv(f32x16*o,int vb,bf16x8 pa0,bf16x8 pa1,bf16x8 pa2,bf16x8 pa3){
  #pragma unroll
  for(int d0=0;d0<2;++d0){s16x4 lo[4],hi[4];
    #pragma unroll
    for(int ks=0;ks<4;++ks){
      asm volatile("ds_read_b64_tr_b16 %0,%1 offset:%c2":"=&v"(lo[ks]):"v"(vb),"i"(d0*4096+ks*1024):"memory");
      asm volatile("ds_read_b64_tr_b16 %0,%1 offset:%c2":"=&v"(hi[ks]):"v"(vb),"i"(d0*4096+ks*1024+512):"memory");}
    asm volatile("s_waitcnt lgkmcnt(0)":::"memory");SBAR();
    #define PK(k) (bf16x8){lo[k][0],lo[k][1],lo[k][2],lo[k][3],hi[k][0],hi[k][1],hi[k][2],hi[k][3]}
    o[d0]=__builtin_amdgcn_mfma_f32_32x32x16_bf16(pa0,PK(0),o[d0],0,0,0);
    o[d0]=__builtin_amdgcn_mfma_f32_32x32x16_bf16(pa1,PK(1),o[d0],0,0,0);
    o[d0]=__builtin_amdgcn_mfma_f32_32x32x16_bf16(pa2,PK(2),o[d0],0,0,0);
    o[d0]=__builtin_amdgcn_mfma_f32_32x32x16_bf16(pa3,PK(3),o[d0],0,0,0);
    #undef PK
  }
}

#ifndef ATTN_STORE16
#define ATTN_STORE16(p,v) (*(u32x4*)(p)=(v))
#endif
template<int THRL> __device__ __forceinline__ void attn_unit(int b,int h,int qb,const bf16*Q,const bf16*__restrict__ K,const bf16*__restrict__ V,bf16*O,const float*__restrict__ cl,const float*__restrict__ tot,const float*__restrict__ qn,const float*__restrict__ kn,char*shm){
  int tid_=threadIdx.x; asm volatile("":"+v"(tid_)); const int tid=tid_,lane=tid&63,r32=lane&31,hi=lane>>5; const int wid=__builtin_amdgcn_readfirstlane(tid>>6);
  const long rowbase=(long)b*SEQ; const int q0=qb*QB;
  const bf16*Qw=Q+(rowbase+q0+wid*QBLK)*DM+h*D;

  typedef float f32x4_t __attribute__((ext_vector_type(4)));
  int t_start=0;
  {
    const float qnA_=qn[((b*32+qb)*8+h)*2],qnB_=qn[((b*32+qb)*8+h)*2+1],knA_=kn[(b*8+h)*2],knB_=kn[(b*8+h)*2+1];
    const int j_=tid>>4;
    float inc_=((lane&31)<qb)?tot[((b*32+(lane&31))*8)+h]:0.f;
    #pragma unroll
    for(int o_=1;o_<32;o_<<=1){ const float u_=__shfl_up(inc_,o_,32); if((lane&31)>=o_)inc_+=u_; }
    const float Pq=(qb>0)?__shfl(inc_,qb-1,32):0.f;
    const float Pj_=__shfl(inc_,(j_>0?j_-1:0)&31,32); const float Pj=(j_>0)?Pj_:0.f;
    const float*clh=cl+(size_t)(b*NHEAD+h)*SEQ;
    const float cref=clh[q0]+Pq;
    __attribute__((address_space(3))) float*cbf=(__attribute__((address_space(3))) float*)((__attribute__((address_space(3))) char*)shm+LDS_CB);
    if(16*tid<q0+QB){
      __attribute__((address_space(3))) f32x4_t*dst=(__attribute__((address_space(3))) f32x4_t*)cbf+4*tid;
      #pragma unroll
      for(int c_=0;c_<4;++c_){ f32x4_t v_=*(const f32x4_t*)(clh+16*tid+4*c_); v_=(cref-(v_+Pj))*1.4426950408889634f; dst[c_]=v_; }
    }
    asm volatile("s_waitcnt lgkmcnt(0)\n\ts_barrier":::"memory");
    const float q2=(qnA_+qnB_)*1.02f, k2=(knA_+knB_)*1.02f;
    const float thr=-2.f*sqrtf(q2*k2)-152.f;
    const int NT0=(q0+QB)/KVBLK; int lo_=0,hi_=NT0-4;
    while(lo_<hi_){ const int mid_=(lo_+hi_)>>1; if(cbf[64*mid_+63]<thr)lo_=mid_+1; else hi_=mid_; }
    t_start=__builtin_amdgcn_readfirstlane(lo_&~1);
  }
  #define CBIAS(P0,P1,t) do{ const lds_cptr cb_=shm3+LDS_CB+(t_start+(t))*256+hi*16; \
    _Pragma("unroll") for(int j_=0;j_<4;++j_){ const f32x4_t b0_=*(const __attribute__((address_space(3))) f32x4_t*)(cb_+j_*32)-mhat; const f32x4_t b1_=*(const __attribute__((address_space(3))) f32x4_t*)(cb_+128+j_*32)-mhat; \
      P0[4*j_]+=b0_[0];P0[4*j_+1]+=b0_[1];P0[4*j_+2]+=b0_[2];P0[4*j_+3]+=b0_[3]; P1[4*j_]+=b1_[0];P1[4*j_+1]+=b1_[1];P1[4*j_+2]+=b1_[2];P1[4*j_+3]+=b1_[3]; } }while(0)
  #define LBIAS(P0,P1,t) do{ const lds_cptr cb_=shm3+LDS_CB+(t_start+(t))*256+hi*16; \
    _Pragma("unroll") for(int j_=0;j_<4;++j_){ const f32x4_t b0_=*(const __attribute__((address_space(3))) f32x4_t*)(cb_+j_*32); const f32x4_t b1_=*(const __attribute__((address_space(3))) f32x4_t*)(cb_+128+j_*32); \
      P0[4*j_]=b0_[0];P0[4*j_+1]=b0_[1];P0[4*j_+2]=b0_[2];P0[4*j_+3]=b0_[3]; P1[4*j_]=b1_[0];P1[4*j_+1]=b1_[1];P1[4*j_+2]=b1_[2];P1[4*j_+3]=b1_[3]; } \
    if(__builtin_expect(__any(mhat!=0.f),0)){ _Pragma("unroll") for(int r_=0;r_<16;++r_){P0[r_]-=mhat;P1[r_]-=mhat;} } }while(0)
  const bf16*Kh=K+(rowbase+(long)t_start*KVBLK)*DM+h*D,*Vh=V+(rowbase+(long)t_start*KVBLK)*DM+h*D;
  const unsigned lds0=(unsigned)(uintptr_t)shm;
  float*wsf=(float*)(shm+LDS_WS)+wid*64;
  const bf16*ksrc=Kh+(long)lane*DM+wid*8;
  const bf16*vsrc=Vh+(long)(16*(wid&3)+(lane>>2))*DM+(wid>>2)*32+(lane&3)*8;
  const unsigned kdst=lds0+LDS_K+wid*1024, vdst=lds0+LDS_V+wid*1024;
  #define DMA_K(t,slot) glds16(ksrc+(long)(t)*KVBLK*DM,(unsigned)__builtin_amdgcn_readfirstlane(kdst+(slot)))
  #define DMA_V(t,slot) glds16(vsrc+(long)(t)*KVBLK*DM,(unsigned)__builtin_amdgcn_readfirstlane(vdst+(slot)))
  const int vb0=(int)(lds0+LDS_V)+((lane>>4)&1)*32+(lane&3)*8+(4*hi+((lane&15)>>2))*64;
  const char*Kbase=shm+LDS_K; bf16x8 kf[8];
  const lds_cptr shm3=(lds_cptr)shm; const lds_cptr kp0=shm3+LDS_K+hi*1024+r32*16; const lds_cptr vp0=shm3+LDS_V+((lane>>4)&1)*32+(lane&3)*8+(4*hi+((lane&15)>>2))*64;
  const int NT=(q0+QB)/KVBLK-t_start;
  DMA_K(0,0);DMA_V(0,0);DMA_K(1,SLOTB);
  bf16x8 qr[4];
  #pragma unroll
  for(int d0=0;d0<4;++d0)qr[d0]=*reinterpret_cast<const bf16x8*>(&Qw[(long)r32*DM+d0*16+hi*8]);
  float mhat=0.f,l_reg=0.f;f32x16 o[2];o[0]=f32x16{};o[1]=f32x16{};const f32x16 negm=f32x16{};
  const int qrel=wid*QBLK+r32;
  #define CMASK(P0,P1,t) do{int jb_=(t)-(NT-4); if(jb_>=0)cmask(P0,P1,jb_,qrel,hi);}while(0)
  bool resc=false;
  #define START(P0,P1) do{ const float rm=rowmax(P0,P1); resc=false; \
    { const float dl=__builtin_fmaxf(rm,0.f); mhat=fadd_s(mhat,dl); \
      _Pragma("unroll") for(int r=0;r<16;++r){P0[r]=fsub_s(P0[r],dl);P1[r]=fsub_s(P1[r],dl);} \
       } \
    _Pragma("unroll") for(int r=0;r<16;++r)P0[r]=__builtin_amdgcn_exp2f(P0[r]); }while(0)
  #define RESC() do{ if(resc){ asm volatile("s_waitcnt lgkmcnt(0)":::"memory"); \
      _Pragma("unroll") for(int d_=0;d_<2;++d_) _Pragma("unroll") for(int r=0;r<16;++r)o[d_][r]*=wsf[crow(r,hi)]; } }while(0)
  f32x16 pA0,pA1,pB0,pB1;
  int sl_prev=0,sl_cur=0,sl_next=SLOTB;
  #define ROT() do{sl_prev=sl_cur;sl_cur=sl_next;sl_next=(sl_next==(NSLOT-1)*SLOTB)?0:sl_next+SLOTB;}while(0)
  DMA_K(2,2*SLOTB);
  WAIT_BAR(3);
  qkt(pA0,pA1,Kbase,qr,negm,r32,hi);asm volatile("s_nop 15\n\ts_nop 7":"+v"(pA0),"+v"(pA1));CMASK(pA0,pA1,0);CBIAS(pA0,pA1,0);
  START(pA0,pA1);
  _Pragma("unroll") for(int r=0;r<16;++r)pA1[r]=__builtin_amdgcn_exp2f(pA1[r]);
  WAIT_BAR(0);
  DMA_K(3,0);DMA_V(1,SLOTB);
  ROT();
  kload8(kf,kp0+sl_cur);
  WAIT_BAR(2);
  s16x4 vlo[8],vhi[8]; u32x4 pw0,pw1,pw2,pw3;
  #define PKW(P,B) cvtpk_s(P[B],P[B+1])
  #define PAF(k) __builtin_bit_cast(bf16x8,pw##k)
  #define VFR(i) (bf16x8){vlo[i][0],vlo[i][1],vlo[i][2],vlo[i][3],vhi[i][0],vhi[i][1],vhi[i][2],vhi[i][3]}
  #define PIN(x) asm volatile("":"+v"(x))
  #define MX3(a,b,c) __builtin_fmaxf(__builtin_fmaxf((a),(b)),(c))
  #define GAPA(MF,A0,A1,A2,A3,W0,W1,PW) do{ MF; sacc+=A0; sacc+=A1; sacc+=A2; sacc+=A3; PIN(sacc); W0; W1; PIN(PW); SBAR(); }while(0)
  #define EX(v) __builtin_amdgcn_exp2f(v)
  #define GAPB(MF,X,B) do{ MF; X[B]=EX(X[B]); X[B+1]=EX(X[B+1]); X[B+2]=EX(X[B+2]); X[B+3]=EX(X[B+3]); PIN(X); SBAR(); }while(0)
  #define VRD(i) do{ vlo[i]=vtr(vp_+(((i)>>2)*4096+((i)&3)*1024)); vhi[i]=vtr(vp_+(((i)>>2)*4096+((i)&3)*1024+512)); }while(0)
  #define KRD(G,j) do{ if(G){ kload2(kf,kp0+sl_next,j); SBAR(); } }while(0)
  #define STEP(C0,C1,P0,P1,t,GK,GV,GL) do{ SBAR(); \
    const lds_cptr vp_=vp0+sl_prev; LBIAS(C0,C1,t); \
    VRD(0); SBAR(); float sacc=(P0[0]+P0[1]); \
    GAPA(C0=__builtin_amdgcn_mfma_f32_32x32x16_bf16(kf[0],qr[0],C0,0,0,0), P0[2],P0[3],P0[4],P0[5],     pw0[0]=PKW(P0,0), pw0[1]=PKW(P0,2), pw0); \
    VRD(4); SBAR(); GAPA(C1=__builtin_amdgcn_mfma_f32_32x32x16_bf16(kf[1],qr[0],C1,0,0,0), P0[6],P0[7],P0[8],P0[9],     pw0[2]=PKW(P0,4), pw0[3]=PKW(P0,6), pw0); \
    VRD(1); SBAR(); GAPA(C0=__builtin_amdgcn_mfma_f32_32x32x16_bf16(kf[2],qr[1],C0,0,0,0),   P0[10],P0[11],P0[12],P0[13], pw1[0]=PKW(P0,8), pw1[1]=PKW(P0,10), pw1); \
    VRD(5); SBAR(); GAPA(C1=__builtin_amdgcn_mfma_f32_32x32x16_bf16(kf[3],qr[1],C1,0,0,0),   P0[14],P0[15],P1[0],P1[1],   pw1[2]=PKW(P0,12),pw1[3]=PKW(P0,14), pw1); \
    VRD(2); SBAR(); GAPA(C0=__builtin_amdgcn_mfma_f32_32x32x16_bf16(kf[4],qr[2],C0,0,0,0),   P1[2],P1[3],P1[4],P1[5],     pw2[0]=PKW(P1,0), pw2[1]=PKW(P1,2), pw2); \
    VRD(6); SBAR(); GAPA(C1=__builtin_amdgcn_mfma_f32_32x32x16_bf16(kf[5],qr[2],C1,0,0,0),   P1[6],P1[7],P1[8],P1[9],     pw2[2]=PKW(P1,4), pw2[3]=PKW(P1,6), pw2); \
    VRD(3); SBAR(); GAPA(C0=__builtin_amdgcn_mfma_f32_32x32x16_bf16(kf[6],qr[3],C0,0,0,0),   P1[10],P1[11],P1[12],P1[13], pw3[0]=PKW(P1,8), pw3[1]=PKW(P1,10), pw3); \
    VRD(7); SBAR(); GAPA(C1=__builtin_amdgcn_mfma_f32_32x32x16_bf16(kf[7],qr[3],C1,0,0,0),   P1[14],P1[15],0.f,0.f,       pw3[2]=PKW(P1,12),pw3[3]=PKW(P1,14), pw3); \
    l_reg+=sacc; \
    if(GK){DMA_K((t)+3,sl_cur);} if(GV){DMA_V((t)+1,sl_next);} \
    CMASK(C0,C1,t); \
    { float a=MX3(C0[0],C0[1],C1[0]),b=MX3(C0[2],C0[3],C1[1]); a=MX3(a,C1[2],C1[3]); \
      _Pragma("unroll") for(int r=4;r<16;r+=4){a=MX3(a,C0[r],C0[r+1]);b=MX3(b,C0[r+2],C0[r+3]);a=MX3(a,C1[r],C1[r+1]);b=MX3(b,C1[r+2],C1[r+3]);} \
      float rm=__builtin_fmaxf(a,b); { auto rr=__builtin_amdgcn_permlane32_swap(__float_as_uint(rm),__float_as_uint(rm),false,false); rm=__builtin_fmaxf(__uint_as_float(rr[0]),__uint_as_float(rr[1])); } \
      resc=false; \
      if(__builtin_expect(__any(rm>(float)THRL),0)){ const float dl=__builtin_fmaxf(rm,0.f); mhat+=dl; \
        _Pragma("unroll") for(int r=0;r<16;++r){C0[r]-=dl;C1[r]-=dl;} \
         \
        const float f=__builtin_amdgcn_exp2f(-dl); l_reg*=f; if(hi==0)wsf[r32]=f; resc=true; } } \
    SBAR(); \
    GAPB(o[0]=__builtin_amdgcn_mfma_f32_32x32x16_bf16(PAF(0),VFR(0),o[0],0,0,0), C0,0); \
    GAPB(o[1]=__builtin_amdgcn_mfma_f32_32x32x16_bf16(PAF(0),VFR(4),o[1],0,0,0), C0,4); \
    KRD(GL,0); GAPB(o[0]=__builtin_amdgcn_mfma_f32_32x32x16_bf16(PAF(1),VFR(1),o[0],0,0,0), C0,8); \
    KRD(GL,1); GAPB(o[1]=__builtin_amdgcn_mfma_f32_32x32x16_bf16(PAF(1),VFR(5),o[1],0,0,0), C0,12); \
    KRD(GL,2); GAPB(o[0]=__builtin_amdgcn_mfma_f32_32x32x16_bf16(PAF(2),VFR(2),o[0],0,0,0), C1,0); \
    KRD(GL,3); GAPB(o[1]=__builtin_amdgcn_mfma_f32_32x32x16_bf16(PAF(2),VFR(6),o[1],0,0,0), C1,4); \
    GAPB(o[0]=__builtin_amdgcn_mfma_f32_32x32x16_bf16(PAF(3),VFR(3),o[0],0,0,0), C1,8); \
    GAPB(o[1]=__builtin_amdgcn_mfma_f32_32x32x16_bf16(PAF(3),VFR(7),o[1],0,0,0), C1,12); \
    }while(0)
  int t=1;
  #undef CMASK
  #define CMASK(P0,P1,t) do{}while(0)
  for(;t+5<NT;t+=2){
    STEP(pB0,pB1,pA0,pA1,t,true,true,true);     WAIT_BAR(2); RESC(); ROT();
    STEP(pA0,pA1,pB0,pB1,t+1,true,true,true);   WAIT_BAR(2); RESC(); ROT();
  }
  #undef CMASK
  #define CMASK(P0,P1,t) do{int jb_=(t)-(NT-4); if(jb_>=0)cmask(P0,P1,jb_,qrel,hi);}while(0)
  #define ENDW(tt) do{ if((tt)+3<NT){WAIT_BAR(2);} else if((tt)+2<NT){WAIT_BAR(1);} else {WAIT_BAR(0);} }while(0)
  for(;t+1<NT;t+=2){
    STEP(pB0,pB1,pA0,pA1,t,(t+3<NT),(t+1<NT),(t+1<NT));       ENDW(t);   RESC(); ROT();
    STEP(pA0,pA1,pB0,pB1,t+1,(t+4<NT),(t+2<NT),(t+2<NT));     ENDW(t+1); RESC(); ROT();
  }
  STEP(pB0,pB1,pA0,pA1,NT-1,false,false,false); RESC();
  { float sacc=pB0[0]+pB0[1]; _Pragma("unroll") for(int r=2;r<16;++r)sacc+=pB0[r]; _Pragma("unroll") for(int r=0;r<16;++r)sacc+=pB1[r]; l_reg+=sacc;
    pw0=(u32x4){PKW(pB0,0),PKW(pB0,2),PKW(pB0,4),PKW(pB0,6)};pw1=(u32x4){PKW(pB0,8),PKW(pB0,10),PKW(pB0,12),PKW(pB0,14)};pw2=(u32x4){PKW(pB1,0),PKW(pB1,2),PKW(pB1,4),PKW(pB1,6)};pw3=(u32x4){PKW(pB1,8),PKW(pB1,10),PKW(pB1,12),PKW(pB1,14)};
    SBAR(); pv(o,vb0+sl_cur,PAF(0),PAF(1),PAF(2),PAF(3)); }
  #undef PKW
  #undef PAF
  #undef VFR
  #undef PIN
  #undef MX3
  #undef GAPA
  #undef GAPB
  #undef EX
  #undef VRD
  #undef KRD
  #undef STEP
  #undef ENDW
  {auto rr=__builtin_amdgcn_permlane32_swap(__float_as_uint(l_reg),__float_as_uint(l_reg),false,false);l_reg=__uint_as_float(rr[0])+__uint_as_float(rr[1]);}
  if(hi==0)wsf[32+r32]=l_reg;asm volatile("s_waitcnt lgkmcnt(0)":::"memory");
  float rli[16];
  #pragma unroll
  for(int r=0;r<16;++r)rli[r]=__builtin_amdgcn_rcpf(wsf[32+crow(r,hi)]);
  bf16*Ow=O+(rowbase+q0+wid*QBLK)*DM+h*D;
  { bf16*stg=(bf16*)(shm+LDS_OST)+wid*2048;
    #pragma unroll
    for(int r=0;r<16;++r){const int orow=crow(r,hi);
      #pragma unroll
      for(int d0=0;d0<2;++d0)stg[orow*64+d0*32+r32]=__float2bfloat16(o[d0][r]*rli[r]);}
    asm volatile("s_waitcnt lgkmcnt(0)":::"memory");
    #pragma unroll
    for(int i=0;i<4;++i){const int row=i*8+(lane>>3),ch=lane&7; const u32x4 v=*(const u32x4*)(stg+row*64+ch*8); ATTN_STORE16(Ow+(long)row*DM+ch*8,v);} }
  asm volatile("s_waitcnt lgkmcnt(0)\n\ts_barrier":::"memory");
  #undef DMA_K
  #undef DMA_V
  #undef CMASK
  #undef CBIAS
  #undef LBIAS
  #undef START
  #undef RESC
  #undef ROT
}
constexpr int ATTN_LDS_BYTES=LDS_BYTES+32768;
#undef SBAR
#undef WAIT_BAR
}


constexpr int NB = 8, SEQ = 8192, DM = 1024, MROWS = NB * SEQ;
constexpr int DEPTH = 2, NIN = 4360, NZ = 4352, DFF = 2816;
constexpr float LN_EPS = 1e-5f;
constexpr float ALPHA = 1.4142135623730951f;
constexpr float LOG2E = 1.4426950408889634f;
constexpr float C2 = 0.125f * LOG2E;
constexpr int ZQA = 0, ZKA = 512, ZVA = 640, ZQB = 768, ZKB = 1280, ZVB = 1792, ZGA = 2304, ZGB = 3328;

constexpr size_t MiB = 1u << 20;
constexpr size_t W_IN_B = (size_t)NZ * 1024 * 2, W_PA_B = (size_t)1024 * 512 * 2, W_OUT_B = (size_t)1024 * 1024 * 2, W_FI_B = (size_t)5632 * 1024 * 2, W_FO_B = (size_t)1024 * 2816 * 2;
constexpr size_t WL_IN = 0, WL_PA = WL_IN + W_IN_B, WL_PB = WL_PA + W_PA_B, WL_OUT = WL_PB + W_PA_B, WL_FI = WL_OUT + W_OUT_B, WL_FO = WL_FI + W_FI_B, WL_BYTES = WL_FO + W_FO_B;
constexpr size_t WS_W = 1 * MiB;
constexpr size_t WS_CL = 64 * MiB;
constexpr size_t WS_TOT = 66 * MiB;
constexpr size_t WS_QN = 66 * MiB + 65536, WS_KN = WS_QN + 65536;
constexpr size_t WS_TAIL = 67 * MiB, WS_HP = 73 * MiB, WS_HU = 79 * MiB;
constexpr size_t WS_ST = 86 * MiB;
constexpr size_t WS_HB = 96 * MiB;
constexpr size_t WS_MG = 224 * MiB;
constexpr size_t WS_Z = 352 * MiB;
constexpr size_t WS_END = WS_Z + (size_t)MROWS * NZ * 2;
static_assert(WS_W + DEPTH * WL_BYTES <= WS_CL && WS_HU + 6 * MiB <= WS_HB, "d_ws map");
constexpr size_t ZPANEL_B = (size_t)256 * NZ * 2;

constexpr int RING_BYTES = 131072, TL_OFF = RING_BYTES, STATS_OFF = TL_OFF + 4096  , LDS_BYTES = 147456;
constexpr int NWAVES = 8;

#define GAS __attribute__((address_space(1)))
#define LAS __attribute__((address_space(3)))
typedef unsigned short bf16;
typedef unsigned v4u __attribute__((ext_vector_type(4)));
typedef unsigned v2u __attribute__((ext_vector_type(2)));
typedef float f32x4 __attribute__((ext_vector_type(4)));
typedef short bf16x8 __attribute__((ext_vector_type(8)));
typedef float f32x16 __attribute__((ext_vector_type(16)));
#define LDS_WAIT() asm volatile("s_waitcnt lgkmcnt(0)" ::: "memory")
__device__ __forceinline__ unsigned f2bf(float f) { unsigned u = __builtin_bit_cast(unsigned, f); return (u + 0x7fffu + ((u >> 16) & 1u)) >> 16; }
__device__ __forceinline__ unsigned pk2(float lo, float hi) { return f2bf(lo) | (f2bf(hi) << 16); }
__device__ __forceinline__ float wave_sum(float v) {
#pragma unroll
    for (int o = 1; o < 64; o <<= 1) v += __shfl_xor(v, o);
    return v;
}

__device__ __forceinline__ void transpose_item(const float* W, int ldw, int K, int k0, int src_col0, bf16* WT, int dst_row0, LAS float* scr, int lane) {
#pragma unroll 8
    for (int i = 0; i < 32; ++i) { const int kk = 2 * i + (lane >> 5); scr[kk * 33 + (lane & 31)] = W[(size_t)(k0 + kk) * ldw + src_col0 + (lane & 31)]; }
    LDS_WAIT(); asm volatile("" ::: "memory");
    const int c = lane & 7;
#pragma unroll
    for (int j = 0; j < 4; ++j) { const int n = (lane >> 3) + 8 * j; const LAS float* s = scr + (8 * c) * 33 + n;
        v4u o; o.x = pk2(s[0 * 33], s[1 * 33]); o.y = pk2(s[2 * 33], s[3 * 33]); o.z = pk2(s[4 * 33], s[5 * 33]); o.w = pk2(s[6 * 33], s[7 * 33]);
        *(GAS v4u*)(WT + (size_t)(dst_row0 + n) * K + k0 + 8 * c) = o; }
    LDS_WAIT(); asm volatile("" ::: "memory");
}

struct Args { const float* in[15]; float* out; unsigned char* ws; };

template <bool DO_LN, bool DO_F, bool WRITE_R = true, bool WRITE_HB = true>
__device__ __forceinline__ void row_pass(LAS unsigned char* lds, int panel, const float* src, float* dstR, bf16* HB, const float* lg, const float* lb,
                                         const float* win_l, const float* bin_l, float* CL, float* TOT, float* GSTAT = nullptr) {
    int tid_ = threadIdx.x; asm volatile("" : "+v"(tid_)); const int tid = tid_, lane = tid & 63, wave = __builtin_amdgcn_readfirstlane(tid >> 6);
    LAS float* lcl = (LAS float*)lds;
    LAS float* wtot = (LAS float*)(lds + 8192);
    f32x4 gv[4], bv[4];
    if (DO_LN) {
#pragma unroll
        for (int j = 0; j < 4; ++j) { gv[j] = *(const f32x4*)(lg + 256 * j + 4 * lane); bv[j] = *(const f32x4*)(lb + 256 * j + 4 * lane); }
    }
    constexpr int RB = DO_F ? 2 : 4;
    f32x4 wfa[4][4], wfb[4][4]; float bf = 0.f, run = 0.f;
    if (DO_F) {
#pragma unroll
        for (int j = 0; j < 4; ++j)
#pragma unroll
            for (int e = 0; e < 4; ++e) { const float* p = win_l + (size_t)(256 * j + 4 * lane + e) * NIN + 2304; wfa[j][e] = *(const f32x4*)p; wfb[j][e] = *(const f32x4*)(p + 4); }
        bf = bin_l[2304 + (lane & 7)];
    }
    for (int i = 0; i < 32; i += RB) {
        const size_t row0 = (size_t)panel * 256 + wave * 32 + i;
        f32x4 v[RB][4]; float s[RB];
#pragma unroll
        for (int r = 0; r < RB; ++r) { const GAS f32x4* xr = (const GAS f32x4*)(src + (row0 + r) * DM) + lane; s[r] = 0.f;
#pragma unroll
            for (int j = 0; j < 4; ++j) { v[r][j] = xr[64 * j]; } }
        if (DO_LN) {
#pragma unroll
            for (int r = 0; r < RB; ++r)
#pragma unroll
                for (int j = 0; j < 4; ++j) s[r] += (v[r][j].x + v[r][j].y) + (v[r][j].z + v[r][j].w);
#pragma unroll
            for (int o = 1; o < 64; o <<= 1)
#pragma unroll
                for (int r = 0; r < RB; ++r) s[r] += __shfl_xor(s[r], o);
            float s2[RB];
#pragma unroll
            for (int r = 0; r < RB; ++r) { const float mean = s[r] * (1.f / DM); s2[r] = 0.f;
#pragma unroll
                for (int j = 0; j < 4; ++j) { v[r][j] = v[r][j] - mean; s2[r] += (v[r][j].x * v[r][j].x + v[r][j].y * v[r][j].y) + (v[r][j].z * v[r][j].z + v[r][j].w * v[r][j].w); } }
#pragma unroll
            for (int o = 1; o < 64; o <<= 1)
#pragma unroll
                for (int r = 0; r < RB; ++r) s2[r] += __shfl_xor(s2[r], o);
#pragma unroll
            for (int r = 0; r < RB; ++r) { const float rstd = 1.f / sqrtf(s2[r] * (1.f / DM) + LN_EPS);
                GAS f32x4* orow = (GAS f32x4*)(dstR + (row0 + r) * DM) + lane;
                if (!WRITE_R && lane == 0) { typedef float f32x2s __attribute__((ext_vector_type(2))); *(LAS f32x2s*)(lds + STATS_OFF + (wave * 32 + i + r) * 8) = (f32x2s){s[r] * (1.f / DM), rstd}; if (GSTAT) *(f32x2s*)(GSTAT + (row0 + r) * 2) = (f32x2s){s[r] * (1.f / DM), rstd}; }
#pragma unroll
                for (int j = 0; j < 4; ++j) { v[r][j] = v[r][j] * rstd * gv[j] + bv[j]; if (WRITE_R) orow[64 * j] = v[r][j]; } }
        }
        if (WRITE_HB)
#pragma unroll
        for (int r = 0; r < RB; ++r) { GAS v2u* o8 = (GAS v2u*)(HB + (row0 + r) * DM) + lane;
#pragma unroll
            for (int j = 0; j < 4; ++j) { v2u w; w.x = pk2(v[r][j].x, v[r][j].y); w.y = pk2(v[r][j].z, v[r][j].w); o8[64 * j] = w; } }
        if (DO_F) {
            float q[RB][8];
#pragma unroll
            for (int r = 0; r < RB; ++r) { f32x4 pa = (f32x4){0.f, 0.f, 0.f, 0.f}, pb = (f32x4){0.f, 0.f, 0.f, 0.f};
#pragma unroll
                for (int j = 0; j < 4; ++j) { pa += wfa[j][0] * v[r][j].x + wfa[j][1] * v[r][j].y + wfa[j][2] * v[r][j].z + wfa[j][3] * v[r][j].w; pb += wfb[j][0] * v[r][j].x + wfb[j][1] * v[r][j].y + wfb[j][2] * v[r][j].z + wfb[j][3] * v[r][j].w; }
                q[r][0] = pa.x; q[r][1] = pa.y; q[r][2] = pa.z; q[r][3] = pa.w; q[r][4] = pb.x; q[r][5] = pb.y; q[r][6] = pb.z; q[r][7] = pb.w; }
#pragma unroll
            for (int o = 1; o < 64; o <<= 1)
#pragma unroll
                for (int r = 0; r < RB; ++r)
#pragma unroll
                    for (int h = 0; h < 8; ++h) q[r][h] += __shfl_xor(q[r][h], o);
#pragma unroll
            for (int r = 0; r < RB; ++r) { float mine = q[r][0];
#pragma unroll
                for (int h = 1; h < 8; ++h) mine = ((lane & 7) == h) ? q[r][h] : mine;
                const float x = mine + bf;
                const float lf = fminf(x, 0.f) - log1pf(__expf(-fabsf(x)));
                run += lf;
                if (lane < 8) lcl[(wave * 32 + i + r) * 8 + lane] = run; }
        }
    }
    if (DO_F) {
        __syncthreads();
        if (lane < 8) wtot[wave * 8 + lane] = run;
        __syncthreads();
        const int b = panel >> 5, s0 = (panel & 31) * 256;
        for (int idx = tid; idx < 2048; idx += 512) { const int h = idx >> 8, r = idx & 255; float off = 0.f;
            for (int w = 0; w < (r >> 5); ++w) off += wtot[w * 8 + h];
            CL[((size_t)(b * 8 + h)) * SEQ + s0 + r] = lcl[r * 8 + h] + off; }
        if (tid < 8) { float t = 0.f; for (int w = 0; w < 8; ++w) t += wtot[w * 8 + tid]; TOT[panel * 8 + tid] = t; }
        __syncthreads();
    }
}


typedef GAS unsigned gu32;
#define RLX_AGENT __ATOMIC_RELAXED, __HIP_MEMORY_SCOPE_AGENT
#define XB_TMO      128
#define XB_XCNT(j)  (256  + 64 * (j))
#define XB_XSUB(j)  (1280 + 64 * (j))
#define XB_XGEN(j)  (2304 + 64 * (j))
#define XB_TOP      3328
#define XB_TOPGEN   3392
#define XCD_BAR_WORDS 3456
#define XB_SPIN_CAP (1u << 18)

__device__ __forceinline__ unsigned xb_ld(unsigned* p)              { return __hip_atomic_load(p, __ATOMIC_RELAXED, __HIP_MEMORY_SCOPE_AGENT); }
__device__ __forceinline__ unsigned xb_add(unsigned* p, unsigned v) { return __hip_atomic_fetch_add(p, v, __ATOMIC_RELAXED, __HIP_MEMORY_SCOPE_AGENT); }
__device__ __forceinline__ unsigned xb_xcc_id() { return (unsigned)__builtin_amdgcn_s_getreg((3 << 11) | 20) & 0xFu; }
#define XB_SPIN(cond, bar) do { unsigned _sp = 0; while (cond) { __builtin_amdgcn_s_sleep(1); \
    if ((++_sp & 255u) == 0u) { if (xb_ld(&(bar)[XB_TMO])) break; if (_sp > XB_SPIN_CAP) { atomicAdd(&(bar)[XB_TMO], 1u); break; } } } } while (0)

struct XcdBarrier {
    unsigned* bar; unsigned x;
    volatile LAS unsigned* st;
};

__device__ __forceinline__ XcdBarrier xcd_barrier_post(unsigned* bar, volatile LAS unsigned* st) {
    XcdBarrier b; b.bar = bar; b.x = xb_xcc_id(); b.st = st;
    if (threadIdx.x == 0) (void)xb_add(&bar[XB_XCNT(b.x)], 1u);
    return b;
}
__device__ __forceinline__ void xcd_barrier_complete(unsigned* bar, unsigned x, unsigned& nloc, unsigned& nx) {
    const unsigned G = gridDim.x * gridDim.y * gridDim.z;
    unsigned sum, cnt, mine, sp = 0u;
    for (;;) {
        sum = 0u; cnt = 0u; mine = 0u;
#pragma unroll
        for (unsigned j = 0; j < 16; ++j) { const unsigned c = xb_ld(&bar[XB_XCNT(j)]); sum += c; cnt += (c > 0u) ? 1u : 0u; mine = (j == x) ? c : mine; }
        if (sum == G) break;
        __builtin_amdgcn_s_sleep(1);
        if ((++sp & 255u) == 0u) { if (xb_ld(&bar[XB_TMO])) break; if (sp > XB_SPIN_CAP) { atomicAdd(&bar[XB_TMO], 1u); break; } }
    }
    nloc = mine > 0u ? mine : 1u; nx = cnt > 0u ? cnt : 1u;
}

__device__ __forceinline__ void xcd_barrier(const XcdBarrier& b) {
    asm volatile("s_waitcnt vmcnt(0)" ::: "memory");
    __syncthreads();
    if (threadIdx.x == 0) {
        unsigned* bar = b.bar;
        __builtin_amdgcn_s_waitcnt(0);
        unsigned nloc = b.st[0], nx = b.st[1];
        if (nloc == 0u) { xcd_barrier_complete(bar, b.x, nloc, nx); b.st[0] = nloc; b.st[1] = nx; }
        const unsigned old = xb_add(&bar[XB_XSUB(b.x)], 1u);
        const unsigned gen = old / nloc;
        if (old + 1u == (gen + 1u) * nloc) {
            __builtin_amdgcn_fence(__ATOMIC_RELEASE, "agent");
            asm volatile("s_waitcnt vmcnt(0)" ::: "memory");
            const unsigned og = xb_add(&bar[XB_TOP], 1u);
            const unsigned tg = og / nx;
            if (og + 1u == (tg + 1u) * nx) xb_add(&bar[XB_TOPGEN], 1u);
            else XB_SPIN(xb_ld(&bar[XB_TOPGEN]) == tg, bar);
            __builtin_amdgcn_fence(__ATOMIC_ACQUIRE, "agent");
            xb_add(&bar[XB_XGEN(b.x)], 1u);
            asm volatile("s_waitcnt vmcnt(0)" ::: "memory");
        } else {
            XB_SPIN(xb_ld(&bar[XB_XGEN(b.x)]) == gen, bar);
            __builtin_amdgcn_fence(__ATOMIC_ACQUIRE, "agent");
            asm volatile("s_waitcnt vmcnt(0)" ::: "memory");
        }
    }
    __syncthreads();
}
__device__ __forceinline__ void group_barrier(unsigned* cnt) {
    asm volatile("s_waitcnt vmcnt(0)" ::: "memory");
    __syncthreads();
    if (threadIdx.x == 0) {
        __builtin_amdgcn_fence(__ATOMIC_RELEASE, "agent");
        asm volatile("s_waitcnt vmcnt(0)" ::: "memory");
        const unsigned old = __hip_atomic_fetch_add(cnt, 1u, __ATOMIC_RELAXED, __HIP_MEMORY_SCOPE_AGENT);
        const unsigned target = (old / 32u + 1u) * 32u;
        unsigned sp = 0u;
        while (__hip_atomic_load(cnt, __ATOMIC_RELAXED, __HIP_MEMORY_SCOPE_AGENT) < target) { __builtin_amdgcn_s_sleep(1); if (++sp > (1u << 22)) break; }
        __builtin_amdgcn_fence(__ATOMIC_ACQUIRE, "agent");
        asm volatile("s_waitcnt vmcnt(0)" ::: "memory");
    }
    __syncthreads();
}

namespace swa {
constexpr int KSTR = 72, VSTR = 264;
constexpr int L_K = 0, L_VT = 256 * KSTR * 2, L_END = L_VT + 64 * VSTR * 2;
__device__ __forceinline__ int crow(int r, int hi) { return (r & 3) + 8 * (r >> 2) + 4 * hi; }
__device__ __forceinline__ void unit(int b, int hkv, int blk, bf16* Z, bf16* ZO, const float* sinks_l, LAS unsigned char* lds) {
    int tid_ = threadIdx.x; asm volatile("" : "+v"(tid_)); const int tid = tid_, lane = tid & 63, r32 = lane & 31, hi = lane >> 5; const int wid = __builtin_amdgcn_readfirstlane(tid >> 6);
    const size_t rowbase = (size_t)b * SEQ; const int k0 = blk * 128 - 128;
    {
        const int key = tid >> 1, half = tid & 1, kabs = k0 + key; const bool ok = kabs >= 0;
        const bf16* kp = Z + (rowbase + (ok ? kabs : 0)) * NZ + ZKA + hkv * 64 + 32 * half;
        const bf16* vp = Z + (rowbase + (ok ? kabs : 0)) * NZ + ZVA + hkv * 64 + 32 * half;
        v4u kv[4], vv[4];
#pragma unroll
        for (int c = 0; c < 4; ++c) { kv[c] = *(const GAS v4u*)(kp + 8 * c); vv[c] = *(const GAS v4u*)(vp + 8 * c); if (!ok) { kv[c] = (v4u){0u, 0u, 0u, 0u}; vv[c] = (v4u){0u, 0u, 0u, 0u}; } }
        LAS bf16* KL = (LAS bf16*)(lds + L_K); LAS bf16* VT = (LAS bf16*)(lds + L_VT);
#pragma unroll
        for (int c = 0; c < 4; ++c) {
            *(LAS v4u*)(KL + key * KSTR + 32 * half + 8 * c) = kv[c];
            const unsigned w[4] = {vv[c].x, vv[c].y, vv[c].z, vv[c].w};
#pragma unroll
            for (int e = 0; e < 4; ++e) { const int d = 32 * half + 8 * c + 2 * e; VT[d * VSTR + key] = (bf16)(w[e] & 0xffffu); VT[(d + 1) * VSTR + key] = (bf16)(w[e] >> 16); }
        }
    }
    __syncthreads();
    const LAS unsigned char* KLb = lds + L_K; const LAS unsigned char* VTb = lds + L_VT;
    for (int task = wid; task < 16; task += 8) {
        const int g = task >> 2, qt = task & 3, hq = hkv * 4 + g, i0 = blk * 128 + 32 * qt;
        bf16* qrow = Z + (rowbase + i0 + r32) * NZ + ZQA + hq * 64;
        bf16x8 qf[4];
#pragma unroll
        for (int d0 = 0; d0 < 4; ++d0) qf[d0] = *(const GAS bf16x8*)(qrow + 16 * d0 + 8 * hi);
        const float slope2 = exp2f(-(float)(hq + 1)) * LOG2E, sink2 = sinks_l[hq] * LOG2E;
        f32x16 s[5];
#pragma unroll
        for (int jt = 0; jt < 5; ++jt) {
            s[jt] = (f32x16){};
            const int slot = 32 * qt + 32 * jt + r32;
#pragma unroll
            for (int d0 = 0; d0 < 4; ++d0) { const bf16x8 a = *(const LAS bf16x8*)(KLb + (slot * KSTR + 16 * d0 + 8 * hi) * 2); s[jt] = __builtin_amdgcn_mfma_f32_32x32x16_bf16(a, qf[d0], s[jt], 0, 0, 0); }
        }
        float m = sink2;
#pragma unroll
        for (int jt = 0; jt < 5; ++jt)
#pragma unroll
            for (int r = 0; r < 16; ++r) {
                const int kslot = 32 * qt + 32 * jt + crow(r, hi);
                const int dist = 128 + r32 - 32 * jt - crow(r, hi);
                const bool ok = (dist >= 0) && (dist < 128) && (k0 + kslot >= 0);
                const float v = ok ? (s[jt][r] - slope2 * (float)dist) : -INFINITY;
                s[jt][r] = v; m = fmaxf(m, v);
            }
        m = fmaxf(m, __shfl_xor(m, 32));
        float l = 0.f;
#pragma unroll
        for (int jt = 0; jt < 5; ++jt)
#pragma unroll
            for (int r = 0; r < 16; ++r) { const float p = __builtin_amdgcn_exp2f(s[jt][r] - m); s[jt][r] = p; l += p; }
        l += __shfl_xor(l, 32);
        l += __builtin_amdgcn_exp2f(sink2 - m);
        const float inv = 1.0f / l;
#pragma unroll
        for (int dh = 0; dh < 2; ++dh) {
            f32x16 o = (f32x16){};
#pragma unroll
            for (int jt = 0; jt < 5; ++jt)
#pragma unroll
                for (int ks = 0; ks < 2; ++ks) {
                    v4u pw; pw.x = pg8::cvt_pk_bf16(s[jt][8 * ks + 0], s[jt][8 * ks + 1]); pw.y = pg8::cvt_pk_bf16(s[jt][8 * ks + 2], s[jt][8 * ks + 3]);
                    pw.z = pg8::cvt_pk_bf16(s[jt][8 * ks + 4], s[jt][8 * ks + 5]); pw.w = pg8::cvt_pk_bf16(s[jt][8 * ks + 6], s[jt][8 * ks + 7]);
                    const int d = 32 * dh + r32, slot = 32 * qt + 32 * jt + 16 * ks + 4 * hi;
                    const v2u lo = *(const LAS v2u*)(VTb + (d * VSTR + slot) * 2), hi8 = *(const LAS v2u*)(VTb + (d * VSTR + slot + 8) * 2);
                    const v4u av = (v4u){lo.x, lo.y, hi8.x, hi8.y};
                    o = __builtin_amdgcn_mfma_f32_32x32x16_bf16(__builtin_bit_cast(bf16x8, av), __builtin_bit_cast(bf16x8, pw), o, 0, 0, 0);
                }
#pragma unroll
            for (int j = 0; j < 4; ++j) { v2u w; w.x = pg8::cvt_pk_bf16(o[4 * j] * inv, o[4 * j + 1] * inv); w.y = pg8::cvt_pk_bf16(o[4 * j + 2] * inv, o[4 * j + 3] * inv);
                *(GAS v2u*)(ZO + (qrow - Z) + 32 * dh + 8 * j + 4 * hi) = w; }
        }
    }
    __syncthreads();
}
}

#ifndef STAG_TICKS
#define STAG_TICKS 800
#endif
__device__ __forceinline__ void stagger(int cls) {
    if (cls) { const unsigned long long t0 = __builtin_amdgcn_s_memrealtime(), want = (unsigned long long)cls * STAG_TICKS;
        while (__builtin_amdgcn_s_memrealtime() - t0 < want) __builtin_amdgcn_s_sleep(16); }
}
#define GSYNC() xcd_barrier(xbar)
__global__ void __launch_bounds__(NWAVES * 64, 2) hybrid_fwd(Args args) {
    extern __shared__ __attribute__((aligned(16))) unsigned char lds_raw[];
    cg::grid_group grid = cg::this_grid();
    LAS unsigned char* lds = (LAS unsigned char*)lds_raw;
    const int tid = threadIdx.x, lane = tid & 63, wave = __builtin_amdgcn_readfirstlane(tid >> 6);
    const int G = gridDim.x, bx = blockIdx.x;
    const int vcu = (bx % 8) * (G / 8) + bx / 8;
    const int panel = vcu;
    unsigned char* ws = args.ws;
    const float* x = args.in[0];
    float* R = args.out;
    bf16* HB = (bf16*)(ws + WS_HB); bf16* MG = (bf16*)(ws + WS_MG); bf16* Z = (bf16*)(ws + WS_Z);
    float* CL = (float*)(ws + WS_CL); float* TOT = (float*)(ws + WS_TOT);
    float* TAIL = (float*)(ws + WS_TAIL); float* HP = (float*)(ws + WS_HP); float* HU = (float*)(ws + WS_HU);
    bf16* Hpanel = (bf16*)(ws + WS_Z + (size_t)panel * ZPANEL_B);
    bf16* Hadj = Hpanel - (size_t)panel * 256 * DFF;

    float* RD = (float*)(ws + WS_END) - (size_t)panel * 256 * DM; bf16* HBD = (bf16*)(ws + WS_END + 2 * MiB) - (size_t)panel * 256 * DM;
    float* CLD = (float*)(ws + WS_END + 4 * MiB); float* TOTD = (float*)(ws + WS_END + 8 * MiB);
    volatile LAS unsigned* xst = (volatile LAS unsigned*)(lds + TL_OFF + 8192);
    if (tid < 2) xst[tid] = 0u;
    __syncthreads();
    XcdBarrier xbar = xcd_barrier_post((unsigned*)(ws + 4096), xst);
    unsigned* gcnt = (unsigned*)(ws + 32768) + 64 * (vcu >> 5);
    unsigned* QN = (unsigned*)(ws + WS_QN); unsigned* KN = (unsigned*)(ws + WS_KN);
    for (int i = bx * 512 + tid; i < DEPTH * 8192; i += G * 512) QN[i] = 0u;
    for (int i = bx * 512 + tid; i < DEPTH * 1024; i += G * 512) KN[i] = 0u;
#define STAMP(k) do {} while (0)
    STAMP(0);
    {
        LAS float* scr = (LAS float*)(lds + wave * 16384);
        const int gw = bx * NWAVES + wave, NGW = G * NWAVES;
        constexpr int I_IN = 16 * (NZ / 32), I_PA = 8 * 32, I_OUT = 16 * 32, I_FI = 16 * (5632 / 32), I_FO = 44 * 32, I_L = I_IN + 2 * I_PA + I_OUT + I_FI + I_FO;
        for (int it = gw; it < DEPTH * I_L; it += NGW) {
            const int l = it / I_L; int r = it % I_L;
            unsigned char* wl = ws + WS_W + (size_t)l * WL_BYTES;
            if (r < I_IN) { const int nblk = NZ / 32, kb = r / nblk, nb = r % nblk, n0 = 32 * nb;
                transpose_item(args.in[3] + (size_t)l * 1024 * NIN, NIN, 1024, 64 * kb, n0 + (n0 >= 2304 ? 8 : 0), (bf16*)(wl + WL_IN), n0, scr, lane); continue; } r -= I_IN;
            if (r < I_PA) { const int kb = r / 32, nb = r % 32; transpose_item(args.in[6] + (size_t)l * 512 * 1024, 1024, 512, 64 * kb, 32 * nb, (bf16*)(wl + WL_PA), 32 * nb, scr, lane); continue; } r -= I_PA;
            if (r < I_PA) { const int kb = r / 32, nb = r % 32; transpose_item(args.in[7] + (size_t)l * 512 * 1024, 1024, 512, 64 * kb, 32 * nb, (bf16*)(wl + WL_PB), 32 * nb, scr, lane); continue; } r -= I_PA;
            if (r < I_OUT) { const int kb = r / 32, nb = r % 32; transpose_item(args.in[8] + (size_t)l * 1024 * 1024, 1024, 1024, 64 * kb, 32 * nb, (bf16*)(wl + WL_OUT), 32 * nb, scr, lane); continue; } r -= I_OUT;
            if (r < I_FI) { const int nblk = 5632 / 32, kb = r / nblk, nb = r % nblk, n0 = 32 * nb, pn = n0 >> 8, j = n0 & 255;
                const int src = (j < 128) ? (128 * pn + j) : (DFF + 128 * pn + (j - 128));
                transpose_item(args.in[11] + (size_t)l * 1024 * 5632, 5632, 1024, 64 * kb, src, (bf16*)(wl + WL_FI), n0, scr, lane); continue; } r -= I_FI;
            { const int kb = r / 32, nb = r % 32; transpose_item(args.in[14] + (size_t)l * DFF * 1024, 1024, DFF, 64 * kb, 32 * nb, (bf16*)(wl + WL_FO), 32 * nb, scr, lane); }
        }
        __syncthreads();
        row_pass<false, true>(lds, panel, x, nullptr, HB, nullptr, nullptr, args.in[3], args.in[4], CL, TOT);
    }
    STAMP(1); grid.sync(); STAMP(2);

    for (int l = 0; l < DEPTH; ++l) {
        unsigned char* wl = ws + WS_W + (size_t)l * WL_BYTES;
        const float* resid_in = (l == 0) ? x : R;
        {
            pg8::Gemm g{HB, (const bf16*)(wl + WL_IN), MROWS, NZ, 1024, 1024}; pg8::GroupOrder S{(vcu >> 5) << 5, vcu & 31, NZ / 256};
            pg8::EpiZ E{Z, NZ, args.in[4] + (size_t)l * NIN, C2, QN + l * 8192, KN + l * 1024};

pg8::gemm_phase<pg8::EpiZ, pg8::GroupOrder, true, true>(lds, g, S, E);

        }
        STAMP(3 + 10 * l); GSYNC(); STAMP(4 + 10 * l);
        {
            const int g8 = vcu >> 3, w8 = vcu & 7;
#pragma unroll 1
            for (int i = 0; i < 8; ++i) {
                const int hsel = i >> 2, k4 = i & 3, bh = 2 * g8 + hsel, ww = hsel ? 7 - w8 : w8;
                const int qb = (k4 == 0) ? ww : (k4 == 1) ? 15 - ww : (k4 == 2) ? 16 + ww : 31 - ww;
                attn_body::attn_unit<20>(bh >> 3, bh & 7, qb, (const attn_body::bf16*)(Z + ZQB), (const attn_body::bf16*)(Z + ZKB), (const attn_body::bf16*)(Z + ZVB), (attn_body::bf16*)(Z + ZQB), CL, TOT, (const float*)(QN + l * 8192), (const float*)(KN + l * 1024), (char*)lds_raw);
            }
            __syncthreads();
#pragma unroll 1
            for (int i = 0; i < 4; ++i) { const int uid = vcu * 4 + i;
 swa::unit(uid >> 7, (uid >> 6) & 1, uid & 63, Z, Z, args.in[5] + l * 8, lds);
 }
        }
        STAMP(5 + 10 * l); GSYNC(); STAMP(6 + 10 * l);
        {
            pg8::PanelOrder S{panel, 4, 0, 3};
            { pg8::Gemm g{Z + ZQA, (const bf16*)(wl + WL_PA), MROWS, 1024, 512, NZ}; pg8::EpiGate<false> E{MG, Z + ZGA, NZ};

pg8::gemm_phase<pg8::EpiGate<false>, pg8::PanelOrder, true, true>(lds, g, S, E);
 }
            __syncthreads();
            { pg8::Gemm g{Z + ZQB, (const bf16*)(wl + WL_PB), MROWS, 1024, 512, NZ}; pg8::EpiGate<true> E{MG, Z + ZGB, NZ};

pg8::gemm_phase<pg8::EpiGate<true>, pg8::PanelOrder, true, true>(lds, g, S, E);
 }
            __syncthreads();
            { pg8::Gemm g{MG, (const bf16*)(wl + WL_OUT), MROWS, 1024, 1024, 1024};
              if (l == 0) { pg8::EpiRes<false> E{x, R, ALPHA, (LAS const float*)(lds + STATS_OFF), nullptr, nullptr};
                  pg8::gemm_phase<pg8::EpiRes<false>, pg8::PanelOrder, true, true>(lds, g, S, E); }
              else { pg8::EpiRes<true> E{R, R, ALPHA, (LAS const float*)(lds + STATS_OFF), args.in[9] + (l - 1) * DM, args.in[10] + (l - 1) * DM};
                  pg8::gemm_phase<pg8::EpiRes<true>, pg8::PanelOrder, true, true>(lds, g, S, E); }
            }
            __syncthreads();
            row_pass<true, false, false>(lds, panel, R, R, HB, args.in[1] + l * DM, args.in[2] + l * DM, nullptr, nullptr, nullptr, nullptr, (float*)(ws + WS_ST));
            __syncthreads();
        }
        STAMP(7 + 10 * l);
        {
            GSYNC();
            pg8::Gemm g{HB, (const bf16*)(wl + WL_FI), MROWS, 5632, 1024, 1024}; pg8::GroupOrder S{(vcu >> 5) << 5, vcu & 31, 22};
            pg8::EpiConv E{Z, args.in[12] + (size_t)l * 3 * DFF, args.in[13] + (size_t)l * DFF, TAIL, HP, HU, (LAS float*)(lds + TL_OFF)};
            pg8::gemm_phase<pg8::EpiConv, pg8::GroupOrder, true, true>(lds, g, S, E);
        }
        STAMP(8 + 10 * l); GSYNC(); STAMP(9 + 10 * l);
        {
            const float* cw = args.in[12] + (size_t)l * 3 * DFF;
            const bool first = (panel & 31) == 0;
            int tidf = threadIdx.x; asm volatile("" : "+v"(tidf));
            for (int idx = tidf; idx < 2 * DFF; idx += 512) { const int r = idx / DFF, c = idx % DFF;
                float t0 = 0.f, t1 = 0.f;
                if (!first) { t0 = TAIL[((size_t)(panel - 1) * 2 + 0) * DFF + c]; t1 = TAIL[((size_t)(panel - 1) * 2 + 1) * DFF + c]; }
                float cv = HP[((size_t)panel * 2 + r) * DFF + c];
                cv += (r == 0) ? (cw[c] * t0 + cw[DFF + c] * t1) : (cw[c] * t1);
                const float hv = cv * pg8::sigmoidf_(cv) * HU[((size_t)panel * 2 + r) * DFF + c];
                Hpanel[(size_t)r * DFF + c] = (bf16)f2bf(hv); }
            GSYNC();
            { pg8::Gemm g{(const bf16*)(ws + WS_Z), (const bf16*)(wl + WL_FO), MROWS, 1024, DFF, DFF, ZPANEL_B}; pg8::GroupOrder S{(vcu >> 5) << 5, vcu & 31, 4};
              pg8::EpiRes<true, true> E{R, R, ALPHA, (LAS const float*)(lds + STATS_OFF), args.in[1] + l * DM, args.in[2] + l * DM, (const float*)(ws + WS_ST)};
              pg8::gemm_phase<pg8::EpiRes<true, true>, pg8::GroupOrder, true, true>(lds, g, S, E); }
            GSYNC();
            if (l + 1 < DEPTH) row_pass<true, true, false>(lds, panel, R, R, HB, args.in[9] + l * DM, args.in[10] + l * DM, args.in[3] + (size_t)(l + 1) * 1024 * NIN, args.in[4] + (size_t)(l + 1) * NIN, CL, TOT);
            else
            row_pass<true, false, true, false>(lds, panel, R, R, HB, args.in[9] + l * DM, args.in[10] + l * DM, nullptr, nullptr, nullptr, nullptr);
            __syncthreads();
            if (l + 1 < DEPTH) GSYNC();
        }
        if (l + 1 < DEPTH) STAMP(12);
    }
}

extern "C" void kernel_launch(void* const* d_in, const int* in_sizes, int n_in, void* d_out, int out_size, void* d_ws, size_t ws_size, hipStream_t stream) {
    static int grid = 0;
    if (grid == 0) {
        if (n_in != 15 || in_sizes[0] != MROWS * DM || out_size != MROWS * DM || ws_size < WS_END) { fprintf(stderr, "kernel_launch: unexpected shapes / workspace (n_in %d, in0 %d, out %d, ws %zu < %zu)\n", n_in, n_in > 0 ? in_sizes[0] : -1, out_size, ws_size, (size_t)WS_END); grid = -1; return; }
        int dev = 0, cus = 0, per_cu = 0;
        (void)hipGetDevice(&dev); (void)hipDeviceGetAttribute(&cus, hipDeviceAttributeMultiprocessorCount, dev);
        if (hipFuncSetAttribute((const void*)hybrid_fwd, hipFuncAttributeMaxDynamicSharedMemorySize, LDS_BYTES) != hipSuccess) { fprintf(stderr, "kernel_launch: hipFuncSetAttribute failed\n"); grid = -1; return; }
        (void)hipOccupancyMaxActiveBlocksPerMultiprocessor(&per_cu, (const void*)hybrid_fwd, NWAVES * 64, LDS_BYTES);
        (void)hipGetLastError();
        if (cus * per_cu < 256) fprintf(stderr, "kernel_launch: note: occupancy query says %d x %d workgroups; launching 256 anyway (the cooperative launch checks residency)\n", cus, per_cu);
        grid = 256;
    }
    if (grid < 0) return;
    if (hipMemsetAsync(d_ws, 0, 65536, stream) != hipSuccess) { fprintf(stderr, "kernel_launch: hipMemsetAsync failed\n"); return; }
    Args a{};
    for (int i = 0; i < 15; ++i) a.in[i] = (const float*)d_in[i];
    a.out = (float*)d_out; a.ws = (unsigned char*)d_ws;
    void* kargs[] = {&a};
    hipError_t e = hipLaunchCooperativeKernel((const void*)hybrid_fwd, dim3(grid), dim3(NWAVES * 64), kargs, LDS_BYTES, stream);
    if (e != hipSuccess) fprintf(stderr, "kernel_launch: cooperative launch failed: %s\n", hipGetErrorString(e));
}
```

```cpp
#include <hip/hip_runtime.h>
#include <hip/hip_cooperative_groups.h>
#include <hip/hip_bf16.h>
#include <cstdio>
#include <cstdint>
#include <cmath>
namespace cg = cooperative_groups;

#ifndef A_AUX
#define A_AUX 0
#endif
namespace pg8 {
#define PG8_LAS __attribute__((address_space(3)))
typedef unsigned short bf16_t;
typedef short bf16x8 __attribute__((ext_vector_type(8)));
typedef float f32x4 __attribute__((ext_vector_type(4)));
typedef unsigned u32x4 __attribute__((ext_vector_type(4)));
constexpr int BM = 256, BK = 64, HALF = 128, HTB = HALF * BK * 2  , STAGE_BYTES = 8 * HTB;

__host__ __device__ __forceinline__ int lds_byte(int r, int c) { const int st = (r >> 4) * 2 + (c >> 5), rr = r & 15, cc = c & 31, ob = rr * 64 + cc * 2; return st * 1024 + (ob ^ (((ob >> 9) & 1) << 5)); }
__host__ __device__ __forceinline__ void stage_rc(int b, int& R, int& C) { const int st = b / 1024, sb = b % 1024, swz = sb ^ (((sb >> 9) & 1) << 5); R = (st >> 1) * 16 + swz / 64; C = (st & 1) * 32 + (swz % 64) / 2; }
__host__ __device__ __forceinline__ int perm32(int rho) { const int n = rho >> 4, i = rho & 15; return 8 * (i >> 2) + 4 * n + (i & 3); }

struct Unit { int pm, pn; };
struct Gemm { const bf16_t* A; const bf16_t* Bt; int M, N, K, lda; size_t apstride = 0; };

struct PanelOrder {
    int pm, nN, rev, rotm;
    __device__ __forceinline__ bool next(int i, Unit& u) const { if (i >= nN) return false; u.pm = pm; int n = i + (pm & rotm); n = n >= nN ? n - nN : n; u.pn = rev ? nN - 1 - n : n; return true; }
    __device__ __forceinline__ void a_ready(const Unit&) const {}
    __device__ __forceinline__ void done(const Unit&) const {}
};

struct GroupOrder {
    int gp0, j, nN;
    __device__ __forceinline__ bool next(int i, Unit& u) const { if (i >= nN) return false; const int L = i * 32 + j, per = 8 * nN, pg = L / per, rem = L - pg * per; u.pm = gp0 + 8 * pg + (rem & 7); u.pn = rem >> 3; return true; }
    __device__ __forceinline__ void a_ready(const Unit&) const {}
    __device__ __forceinline__ void done(const Unit&) const {}
};

__device__ __forceinline__ unsigned cvt_pk_bf16(float lo, float hi) { unsigned r; asm volatile("v_cvt_pk_bf16_f32 %0, %1, %2" : "=v"(r) : "v"(lo), "v"(hi)); return r; }
__device__ __forceinline__ float bf_lo(unsigned w) { return __uint_as_float(w << 16); }
__device__ __forceinline__ float bf_hi(unsigned w) { return __uint_as_float(w & 0xffff0000u); }
__device__ __forceinline__ float sigmoidf_(float x) { return __builtin_amdgcn_rcpf(1.0f + __expf(-x)); }


struct EpiZ {
    static constexpr bool PERM = true, AFTER_DRAIN = false, PROBE2 = true;
    bf16_t* O; int ldc; const float* bias; float qscale; unsigned* QN; unsigned* KN;
    __device__ __forceinline__ void operator()(const f32x4 (&acc)[2][2][4][2], const Unit& u, int wr, int wc, int fr_in, int fq_in) const {
        int fr = fr_in, fq = fq_in; asm volatile("" : "+v"(fr), "+v"(fq));
        const int row0 = u.pm * BM + wr * 64 + fr; const int col0 = u.pn * BM + wc * 32 + 8 * fq;
        const float sc = (u.pn == 0 || u.pn == 1 || u.pn == 3 || u.pn == 4) ? qscale : 1.f;
        f32x4 bv[2][2];
#pragma unroll
        for (int bj = 0; bj < 2; ++bj)
#pragma unroll
            for (int n = 0; n < 2; ++n) { const int c = col0 + bj * HALF + 4 * n; bv[bj][n] = *(const f32x4*)(bias + c + (c >= 2304 ? 8 : 0)); }
#pragma unroll
        for (int ai = 0; ai < 2; ++ai)
#pragma unroll
            for (int m = 0; m < 4; ++m) { bf16_t* rowp = O + (size_t)(row0 + ai * HALF + m * 16) * ldc + col0;
#pragma unroll
                for (int bj = 0; bj < 2; ++bj) { f32x4 v0 = (acc[ai][bj][m][0] + bv[bj][0]) * sc, v1 = (acc[ai][bj][m][1] + bv[bj][1]) * sc;
                    u32x4 w; w.x = cvt_pk_bf16(v0[0], v0[1]); w.y = cvt_pk_bf16(v0[2], v0[3]); w.z = cvt_pk_bf16(v1[0], v1[1]); w.w = cvt_pk_bf16(v1[2], v1[3]);
                    *(u32x4*)(rowp + bj * HALF) = w; } }
        if (u.pn >= 3 && u.pn <= 6) {
            const int lane = fq * 16 + fr;
#pragma unroll
            for (int bj = 0; bj < 2; ++bj) {
                float mx = 0.f;
#pragma unroll
                for (int ai = 0; ai < 2; ++ai)
#pragma unroll
                    for (int m = 0; m < 4; ++m) { const f32x4 v0 = (acc[ai][bj][m][0] + bv[bj][0]) * sc, v1 = (acc[ai][bj][m][1] + bv[bj][1]) * sc;
                        float s = (v0[0] * v0[0] + v0[1] * v0[1]) + (v0[2] * v0[2] + v0[3] * v0[3]) + (v1[0] * v1[0] + v1[1] * v1[1]) + (v1[2] * v1[2] + v1[3] * v1[3]);
                        s += __shfl_xor(s, 16); s += __shfl_xor(s, 32); mx = fmaxf(mx, s); }
                mx = fmaxf(mx, __shfl_xor(mx, 1)); mx = fmaxf(mx, __shfl_xor(mx, 2)); mx = fmaxf(mx, __shfl_xor(mx, 4)); mx = fmaxf(mx, __shfl_xor(mx, 8));
                if (lane == 0) { const int hl = 2 * bj + (wc >> 1), half = wc & 1;
                    if (u.pn <= 4) atomicMax(QN + ((u.pm * 8 + 4 * (u.pn - 3) + hl) * 2 + half), __float_as_uint(mx));
                    else atomicMax(KN + (((u.pm >> 5) * 8 + 4 * (u.pn - 5) + hl) * 2 + half), __float_as_uint(mx)); }
            }
        }
    }
};

template <bool SECOND> struct EpiGate {
    static constexpr bool PERM = true, AFTER_DRAIN = false, PROBE2 = false;
    bf16_t* MG; const bf16_t* G; int ldg;
    __device__ __forceinline__ void operator()(const f32x4 (&acc)[2][2][4][2], const Unit& u, int wr, int wc, int fr_in, int fq_in) const {
        int fr = fr_in, fq = fq_in; asm volatile("" : "+v"(fr), "+v"(fq));
        const int row0 = u.pm * BM + wr * 64 + fr; const int col0 = u.pn * BM + wc * 32 + 8 * fq;
#pragma unroll
        for (int ai = 0; ai < 2; ++ai) {
            u32x4 gw[4][2], pw[4][2];
#pragma unroll
            for (int m = 0; m < 4; ++m)
#pragma unroll
                for (int bj = 0; bj < 2; ++bj) { const size_t row = (size_t)(row0 + ai * HALF + m * 16);
                    gw[m][bj] = *(const u32x4*)(G + row * ldg + col0 + bj * HALF);
                    if (SECOND) pw[m][bj] = *(const u32x4*)(MG + row * 1024 + col0 + bj * HALF); }
#pragma unroll
            for (int m = 0; m < 4; ++m)
#pragma unroll
                for (int bj = 0; bj < 2; ++bj) { const size_t row = (size_t)(row0 + ai * HALF + m * 16);
                    bf16_t* mp = MG + row * 1024 + col0 + bj * HALF;
                    const f32x4 a0 = acc[ai][bj][m][0], a1 = acc[ai][bj][m][1]; const u32x4 g = gw[m][bj];
                    float v[8];
                    v[0] = sigmoidf_(bf_lo(g.x)) * a0[0]; v[1] = sigmoidf_(bf_hi(g.x)) * a0[1]; v[2] = sigmoidf_(bf_lo(g.y)) * a0[2]; v[3] = sigmoidf_(bf_hi(g.y)) * a0[3];
                    v[4] = sigmoidf_(bf_lo(g.z)) * a1[0]; v[5] = sigmoidf_(bf_hi(g.z)) * a1[1]; v[6] = sigmoidf_(bf_lo(g.w)) * a1[2]; v[7] = sigmoidf_(bf_hi(g.w)) * a1[3];
                    if (SECOND) { const u32x4 p = pw[m][bj];
                        v[0] += bf_lo(p.x); v[1] += bf_hi(p.x); v[2] += bf_lo(p.y); v[3] += bf_hi(p.y); v[4] += bf_lo(p.z); v[5] += bf_hi(p.z); v[6] += bf_lo(p.w); v[7] += bf_hi(p.w); }
                    u32x4 w; w.x = cvt_pk_bf16(v[0], v[1]); w.y = cvt_pk_bf16(v[2], v[3]); w.z = cvt_pk_bf16(v[4], v[5]); w.w = cvt_pk_bf16(v[6], v[7]);
                    *(u32x4*)mp = w; }
        }
    }
};

template <bool recon, bool GST = false> struct EpiRes {
    static constexpr bool PERM = true, AFTER_DRAIN = false, PROBE2 = false;
    const float* base; float* out; float alpha; PG8_LAS const float* st; const float* lg; const float* lb; const float* gst = nullptr;
    __device__ __forceinline__ void operator()(const f32x4 (&acc)[2][2][4][2], const Unit& u, int wr, int wc, int fr_in, int fq_in) const {
        int fr = fr_in, fq = fq_in; asm volatile("" : "+v"(fr), "+v"(fq));
        typedef float f32x2s __attribute__((ext_vector_type(2)));
        const int row0 = u.pm * BM + wr * 64 + fr; const int col0 = u.pn * BM + wc * 32 + 8 * fq;
        f32x4 bs[2][2][2];
#define ER_LOAD(buf, k_) do { _Pragma("unroll") for (int mm = 0; mm < 2; ++mm) { const size_t off = (size_t)(row0 + (((k_) >> 1) & 1) * HALF + (2 * ((k_) & 1) + mm) * 16) * 1024 + col0 + ((k_) >> 2) * HALF; \
            bs[buf][mm][0] = *(const f32x4*)(base + off); bs[buf][mm][1] = *(const f32x4*)(base + off + 4); } } while (0)
        ER_LOAD(0, 0);
#pragma unroll
        for (int k = 0; k < 8; ++k) {
            const int bj = k >> 2, ai = (k >> 1) & 1, buf = k & 1;
            if (k < 7) ER_LOAD((k + 1) & 1, k + 1);
            f32x4 g0 = (f32x4){1.f, 1.f, 1.f, 1.f}, g1 = g0, b0 = (f32x4){0.f, 0.f, 0.f, 0.f}, b1 = b0;
            if (recon) { g0 = *(const f32x4*)(lg + col0 + bj * HALF); g1 = *(const f32x4*)(lg + col0 + bj * HALF + 4); b0 = *(const f32x4*)(lb + col0 + bj * HALF); b1 = *(const f32x4*)(lb + col0 + bj * HALF + 4); }
#pragma unroll
            for (int mm = 0; mm < 2; ++mm) { const int m = 2 * (k & 1) + mm; const size_t off = (size_t)(row0 + ai * HALF + m * 16) * 1024 + col0 + bj * HALF;
                f32x4 h0 = bs[buf][mm][0], h1 = bs[buf][mm][1];
                if (recon) { f32x2s ms; if (GST) ms = *(const f32x2s*)(gst + (size_t)(u.pm * BM + ai * HALF + wr * 64 + m * 16 + fr) * 2); else ms = *(const PG8_LAS f32x2s*)(st + (ai * HALF + wr * 64 + m * 16 + fr) * 2);
                    h0 = (h0 - ms.x) * ms.y * g0 + b0; h1 = (h1 - ms.x) * ms.y * g1 + b1; }
                *(f32x4*)(out + off) = h0 * alpha + acc[ai][bj][m][0];
                *(f32x4*)(out + off + 4) = h1 * alpha + acc[ai][bj][m][1]; }
        }
#undef ER_LOAD
    }
};

__device__ __forceinline__ float dpp_shr1(float v) { return __builtin_bit_cast(float, __builtin_amdgcn_update_dpp(0, __builtin_bit_cast(int, v), 0x111, 0xf, 0xf, true)); }
__device__ __forceinline__ float dpp_shr2(float v) { return __builtin_bit_cast(float, __builtin_amdgcn_update_dpp(0, __builtin_bit_cast(int, v), 0x112, 0xf, 0xf, true)); }
__device__ __forceinline__ float dpp_ror1(float v) { return __builtin_bit_cast(float, __builtin_amdgcn_update_dpp(0, __builtin_bit_cast(int, v), 0x121, 0xf, 0xf, false)); }
__device__ __forceinline__ float dpp_ror2(float v) { return __builtin_bit_cast(float, __builtin_amdgcn_update_dpp(0, __builtin_bit_cast(int, v), 0x122, 0xf, 0xf, false)); }
__device__ __forceinline__ float lane_get(float v, int src_lane) { return __builtin_bit_cast(float, __builtin_amdgcn_ds_bpermute(src_lane * 4, __builtin_bit_cast(int, v))); }

struct EpiConv {
    static constexpr bool PERM = true, AFTER_DRAIN = false, PROBE2 = false;
    bf16_t* HZ;
    const float* cw; const float* cb;
    float* TAIL; float* HP; float* HU;
    PG8_LAS float* tl;
    __device__ __forceinline__ void operator()(const f32x4 (&acc)[2][2][4][2], const Unit& u, int wr, int wc, int fr_in, int fq_in) const {
        int fr = fr_in, fq = fq_in; asm volatile("" : "+v"(fr), "+v"(fq));
        const int lane = fq * 16 + fr;
        const int colw = wc * 32 + 8 * fq; const int hc0 = u.pn * 128 + colw;
        if (fr >= 14) {
#pragma unroll
            for (int ai = 0; ai < 2; ++ai)
#pragma unroll
                for (int n = 0; n < 2; ++n) *(PG8_LAS f32x4*)(tl + ((ai * 2 + wr) * 2 + (fr - 14)) * 128 + colw + 4 * n) = acc[ai][0][3][n];
            if (wr == 1) {
#pragma unroll
                for (int n = 0; n < 2; ++n) *(f32x4*)(TAIL + ((size_t)u.pm * 2 + (fr - 14)) * 2816 + hc0 + 4 * n) = acc[1][0][3][n];
            }
        }
        asm volatile("s_waitcnt lgkmcnt(0)" ::: "memory"); __builtin_amdgcn_s_barrier(); asm volatile("" ::: "memory");
        typedef unsigned u32x2 __attribute__((ext_vector_type(2)));
        u32x2 pk0[2][4];
#pragma unroll
        for (int n = 0; n < 2; ++n) {
            const f32x4 w0 = *(const f32x4*)(cw + hc0 + 4 * n), w1 = *(const f32x4*)(cw + 2816 + hc0 + 4 * n), w2 = *(const f32x4*)(cw + 5632 + hc0 + 4 * n), bb = *(const f32x4*)(cb + hc0 + 4 * n);
#pragma unroll
            for (int ai = 0; ai < 2; ++ai) {
                const int lin = ai * 2 + wr;
                f32x4 hA = (f32x4){0.f, 0.f, 0.f, 0.f}, hB = (f32x4){0.f, 0.f, 0.f, 0.f};
                if (lin > 0) { hA = *(const PG8_LAS f32x4*)(tl + ((lin - 1) * 2 + 1) * 128 + colw + 4 * n); hB = *(const PG8_LAS f32x4*)(tl + ((lin - 1) * 2 + 0) * 128 + colw + 4 * n); }
#pragma unroll
                for (int m = 0; m < 4; ++m) {
                    float hv[4], cv[4];
#pragma unroll
                    for (int e = 0; e < 4; ++e) {
                        const float G = acc[ai][0][m][n][e];
                        float X, Y;
                        if (m == 0) { X = hA[e]; Y = (fr == 0) ? hB[e] : hA[e]; }
                        else { const float Gp = acc[ai][0][m - 1][n][e]; X = dpp_ror1(Gp); Y = dpp_ror2(Gp); }
                        const float s1 = dpp_shr1(G), s2 = dpp_shr2(G);
                        const float p1 = (fr >= 1) ? s1 : X, p2 = (fr >= 2) ? s2 : Y;
                        const float c = bb[e] + w0[e] * p2 + w1[e] * p1 + w2[e] * G;
                        cv[e] = c;
                        hv[e] = c * sigmoidf_(c) * acc[ai][1][m][n][e];
                    }
                    const int rl = ai * HALF + wr * 64 + m * 16 + fr;
                    u32x2 w; w.x = cvt_pk_bf16(hv[0], hv[1]); w.y = cvt_pk_bf16(hv[2], hv[3]);
                    if (n == 0) pk0[ai][m] = w;
                    else { u32x4 w4; w4.x = pk0[ai][m].x; w4.y = pk0[ai][m].y; w4.z = w.x; w4.w = w.y; *(u32x4*)(HZ + (size_t)u.pm * (256 * 4352) + rl * 2816 + hc0) = w4; }
                    if (ai == 0 && m == 0 && wr == 0 && fr < 2) {
                        *(f32x4*)(HP + ((size_t)u.pm * 2 + fr) * 2816 + hc0 + 4 * n) = (f32x4){cv[0], cv[1], cv[2], cv[3]};
                        *(f32x4*)(HU + ((size_t)u.pm * 2 + fr) * 2816 + hc0 + 4 * n) = acc[0][1][0][n];
                    }
                }
            }
        }
    }
};

template <class Epi, class Sched, bool ALIGN_EPI = false, bool SP2 = false>
__device__ __forceinline__ void gemm_phase(PG8_LAS unsigned char* lds, const Gemm g, const Sched& S, const Epi& E) {
    int tid_ = threadIdx.x; asm volatile("" : "+v"(tid_)); const int tid = tid_, wid = __builtin_amdgcn_readfirstlane(tid >> 6), lane = tid & 63, wr = wid >> 2, wc = wid & 3, fr = lane & 15, fq = lane >> 4;
    const int K = g.K, nt = K / BK;
    unsigned voffA[2], voffB[2];
#pragma unroll
    for (int i = 0; i < 2; ++i) { int R, C; stage_rc(tid * 16 + i * 8192, R, C); const int Rb = Epi::PERM ? ((R & ~31) + perm32(R & 31)) : R;
        voffA[i] = (unsigned)(R * g.lda + C) * 2u; voffB[i] = (unsigned)(Rb * K + C) * 2u; }
    const size_t kstep = (size_t)(BK * 2);
    const size_t hstepA = (size_t)HALF * g.lda * 2, hstepB = (size_t)HALF * K * 2;
    const size_t tstepA = g.apstride ? g.apstride : 2 * hstepA, tstepB = 2 * hstepB;
    const unsigned ldsw = (unsigned)wid * 1024u;
    const int aoff = lds_byte(wr * 64 + fr, fq * 8), boff = lds_byte(wc * 32 + fr, fq * 8);
#define PG8_SA(b, h) (((b) * 2 + (h)) * HTB)
#define PG8_SB(b, h) ((4 + (b) * 2 + (h)) * HTB)
#define PG8_STAGE(bufoff, gbase, voff) do { _Pragma("unroll") for (int _i = 0; _i < 2; ++_i) \
        __builtin_amdgcn_global_load_lds((const unsigned*)((const char*)(gbase) + (voff)[_i]), (PG8_LAS unsigned*)(lds + (bufoff) + ldsw + _i * 8192), 16, 0, 0); } while (0)
#define PG8_STAGEA(bufoff, gbase, voff) do { _Pragma("unroll") for (int _i = 0; _i < 2; ++_i) \
        __builtin_amdgcn_global_load_lds((const unsigned*)((const char*)(gbase) + (voff)[_i]), (PG8_LAS unsigned*)(lds + (bufoff) + ldsw + _i * 8192), 16, 0, A_AUX); } while (0)
#define PG8_LDA(dst, b, h) do { _Pragma("unroll") for (int m = 0; m < 4; ++m) _Pragma("unroll") for (int k = 0; k < 2; ++k) dst[m][k] = *(const PG8_LAS bf16x8*)(lds + PG8_SA(b, h) + aoff + m * 2048 + k * 1024); } while (0)
#define PG8_LDB(dst, b, h) do { _Pragma("unroll") for (int n = 0; n < 2; ++n) _Pragma("unroll") for (int k = 0; k < 2; ++k) dst[n][k] = *(const PG8_LAS bf16x8*)(lds + PG8_SB(b, h) + boff + n * 2048 + k * 1024); } while (0)
#define PG8_MMA(ai, bj, At, Bt) do { __builtin_amdgcn_s_setprio(1); _Pragma("unroll") for (int m = 0; m < 4; ++m) _Pragma("unroll") for (int n = 0; n < 2; ++n) _Pragma("unroll") for (int k = 0; k < 2; ++k) \
        acc[ai][bj][m][n] = __builtin_amdgcn_mfma_f32_16x16x32_bf16(Bt[n][k], At[m][k], acc[ai][bj][m][n], 0, 0, 0); __builtin_amdgcn_s_setprio(0); } while (0)
#define PG8_WAIT_V(n) asm volatile("s_waitcnt vmcnt(" #n ")" ::: "memory")
#define PG8_WAIT_L(n) asm volatile("s_waitcnt lgkmcnt(" #n ")" ::: "memory")
#define PG8_BAR __builtin_amdgcn_s_barrier()
#define PG8_SCHED __builtin_amdgcn_sched_barrier(0)
    Unit cur, nxt; int ui = 0;
    if (!S.next(0, cur)) return;
    f32x4 acc[2][2][4][2];
#pragma unroll
    for (int a = 0; a < 2; ++a)
#pragma unroll
        for (int b = 0; b < 2; ++b)
#pragma unroll
            for (int m = 0; m < 4; ++m)
#pragma unroll
                for (int n = 0; n < 2; ++n) acc[a][b][m][n] = (f32x4){0.f, 0.f, 0.f, 0.f};
    bf16x8 At[4][2], B0[2][2], B1[2][2];
    const char* cA = (const char*)g.A + (size_t)cur.pm * tstepA; const char* cB = (const char*)g.Bt + (size_t)cur.pn * tstepB;
    S.a_ready(cur);
    if constexpr (SP2) {
        PG8_STAGE(PG8_SB(0, 0), cB, voffB); PG8_STAGE(PG8_SB(0, 1), cB + hstepB, voffB); PG8_STAGEA(PG8_SA(0, 0), cA, voffA); PG8_STAGEA(PG8_SA(0, 1), cA + hstepA, voffA);
        if (wr == 1) PG8_BAR;
        PG8_WAIT_V(2); PG8_BAR;
        PG8_STAGE(PG8_SB(1, 0), cB + kstep, voffB); PG8_STAGEA(PG8_SA(1, 0), cA + kstep, voffA); PG8_STAGE(PG8_SB(1, 1), cB + hstepB + kstep, voffB);
        PG8_WAIT_V(6); PG8_BAR;
    } else {
        PG8_STAGE(PG8_SB(0, 0), cB, voffB); PG8_STAGEA(PG8_SA(0, 0), cA, voffA); PG8_STAGE(PG8_SB(0, 1), cB + hstepB, voffB); PG8_STAGEA(PG8_SA(0, 1), cA + hstepA, voffA);
        if (wr == 1) PG8_BAR;
        PG8_WAIT_V(4); PG8_BAR;
        PG8_STAGE(PG8_SB(1, 0), cB + kstep, voffB); PG8_STAGEA(PG8_SA(1, 0), cA + kstep, voffA); PG8_STAGE(PG8_SB(1, 1), cB + hstepB + kstep, voffB);
        PG8_WAIT_V(6); PG8_BAR;
    }
    for (;;) {
        const bool has_next = S.next(ui + 1, nxt);
        const char* nA = has_next ? (const char*)g.A + (size_t)nxt.pm * tstepA : cA; const char* nB = has_next ? (const char*)g.Bt + (size_t)nxt.pn * tstepB : cB;
        for (int t = 0; t < nt; t += 2) {
            const bool last = (t == nt - 2);
            const char* a1 = cA + (size_t)(t + 1) * kstep;
            const char* a2 = last ? nA : cA + (size_t)(t + 2) * kstep; const char* b2 = last ? nB : cB + (size_t)(t + 2) * kstep;
            const char* a3 = a2 + kstep; const char* b3 = b2 + kstep;
            if (last && has_next) S.a_ready(nxt);
            if constexpr (SP2) {
            PG8_LDB(B0, 0, 0); PG8_LDB(B1, 0, 1); PG8_SCHED; PG8_LDA(At, 0, 0); PG8_STAGEA(PG8_SA(1, 1), a1 + hstepA, voffA);
            PG8_WAIT_V(8); PG8_WAIT_L(0); PG8_BAR; PG8_MMA(0, 0, At, B0); PG8_MMA(0, 1, At, B1); PG8_BAR; PG8_SCHED;
            PG8_LDA(At, 0, 1); PG8_STAGE(PG8_SB(0, 0), b2, voffB); PG8_STAGE(PG8_SB(0, 1), b2 + hstepB, voffB); PG8_STAGEA(PG8_SA(0, 0), a2, voffA);
            PG8_WAIT_V(8); PG8_WAIT_L(0); PG8_BAR; PG8_MMA(1, 0, At, B0); PG8_MMA(1, 1, At, B1); PG8_BAR; PG8_SCHED;
            PG8_LDB(B0, 1, 0); PG8_LDB(B1, 1, 1); PG8_SCHED; PG8_LDA(At, 1, 0); PG8_STAGEA(PG8_SA(0, 1), a2 + hstepA, voffA);
            PG8_WAIT_V(8); PG8_WAIT_L(0); PG8_BAR; PG8_MMA(0, 0, At, B0); PG8_MMA(0, 1, At, B1); PG8_BAR; PG8_SCHED;
            PG8_LDA(At, 1, 1); PG8_STAGE(PG8_SB(1, 0), b3, voffB); PG8_STAGE(PG8_SB(1, 1), b3 + hstepB, voffB); PG8_STAGEA(PG8_SA(1, 0), a3, voffA);
            PG8_WAIT_V(8); PG8_WAIT_L(0); PG8_BAR; PG8_MMA(1, 0, At, B0); PG8_MMA(1, 1, At, B1); PG8_BAR; PG8_SCHED;
            } else {
            PG8_LDB(B0, 0, 0); PG8_SCHED; PG8_LDA(At, 0, 0); PG8_STAGEA(PG8_SA(1, 1), a1 + hstepA, voffA);
            PG8_WAIT_L(8); PG8_BAR; PG8_WAIT_L(0); PG8_MMA(0, 0, At, B0); PG8_BAR; PG8_SCHED;
            PG8_LDB(B1, 0, 1); PG8_STAGE(PG8_SB(0, 0), b2, voffB);
            PG8_BAR; PG8_WAIT_L(0); PG8_MMA(0, 1, At, B1); PG8_BAR;
            PG8_LDA(At, 0, 1); PG8_STAGEA(PG8_SA(0, 0), a2, voffA);
            PG8_BAR; PG8_WAIT_L(0); PG8_MMA(1, 0, At, B0); PG8_BAR; PG8_SCHED;
            PG8_STAGE(PG8_SB(0, 1), b2 + hstepB, voffB);
            PG8_WAIT_V(6); PG8_BAR; PG8_MMA(1, 1, At, B1); PG8_BAR;
            PG8_LDB(B0, 1, 0); PG8_SCHED; PG8_LDA(At, 1, 0); PG8_STAGEA(PG8_SA(0, 1), a2 + hstepA, voffA);
            PG8_WAIT_L(8); PG8_BAR; PG8_WAIT_L(0); PG8_MMA(0, 0, At, B0); PG8_BAR; PG8_SCHED;
            PG8_LDB(B1, 1, 1); PG8_STAGE(PG8_SB(1, 0), b3, voffB);
            PG8_BAR; PG8_WAIT_L(0); PG8_MMA(0, 1, At, B1); PG8_BAR;
            PG8_LDA(At, 1, 1); PG8_STAGEA(PG8_SA(1, 0), a3, voffA);
            PG8_BAR; PG8_WAIT_L(0); PG8_MMA(1, 0, At, B0); PG8_BAR; PG8_SCHED;
            PG8_STAGE(PG8_SB(1, 1), b3 + hstepB, voffB);
            PG8_WAIT_V(6); PG8_BAR; PG8_MMA(1, 1, At, B1); PG8_BAR;
            }
        }
        if constexpr (ALIGN_EPI) { if (wr == 0) PG8_BAR; }
        if constexpr (!Epi::AFTER_DRAIN) { E(acc, cur, wr, wc, fr, fq);
            S.done(cur); }
        if (!has_next) break;
#pragma unroll
        for (int a = 0; a < 2; ++a)
#pragma unroll
            for (int b = 0; b < 2; ++b)
#pragma unroll
                for (int m = 0; m < 4; ++m)
#pragma unroll
                    for (int n = 0; n < 2; ++n) acc[a][b][m][n] = (f32x4){0.f, 0.f, 0.f, 0.f};
        cur = nxt; cA = nA; cB = nB; ++ui;
        if constexpr (ALIGN_EPI) { if (wr == 1) PG8_BAR; }
    }
    PG8_WAIT_V(0);
    if constexpr (!ALIGN_EPI) { if (wr == 0) PG8_BAR; }
    PG8_BAR;
    if constexpr (Epi::AFTER_DRAIN) { E.fused(acc, cur, wr, wc, fr, fq, lds, wid, lane); S.done(cur); }
#undef PG8_SA
#undef PG8_SB
#undef PG8_STAGE
#undef PG8_STAGEA
#undef PG8_LDA
#undef PG8_LDB
#undef PG8_MMA
#undef PG8_WAIT_V
#undef PG8_WAIT_L
#undef PG8_BAR
#undef PG8_SCHED
}

}

namespace attn_body {
using bf16=__hip_bfloat16;
using bf16x8=__attribute__((ext_vector_type(8)))short;
using s16x4=__attribute__((ext_vector_type(4)))short;
using f32x16=__attribute__((ext_vector_type(16)))float;
using u32x4=__attribute__((ext_vector_type(4)))unsigned;
constexpr int BATCH=8,NHEAD=8,SEQ=8192,D=64,DM=4352;
constexpr int NW=8,QBLK=32,QB=QBLK*NW,KVBLK=64,NQB=SEQ/QB;
constexpr int ATTN_PITCH=DM, ATTN_UNIT_ROWS=QB;
__device__ __forceinline__ int crow(int r,int hi){return (r&3)+8*(r>>2)+4*hi;}
#define SBAR() __builtin_amdgcn_sched_barrier(0)
__device__ __forceinline__ void cmask(f32x16&p0,f32x16&p1,int jb,int qrel,int hi){
  const float NEG=-INFINITY; int kb=64*jb+4*hi;
  #pragma unroll
  for(int r=0;r<16;++r){int kv=kb+(r&3)+8*(r>>2); if(kv>qrel)p0[r]=NEG; if(kv+32>qrel)p1[r]=NEG;}
}

constexpr int NSLOT=3, SLOTB=8192;
constexpr int LDS_K=0, LDS_V=NSLOT*SLOTB, LDS_WS=2*NSLOT*SLOTB, LDS_OST=LDS_WS+NW*64*4, LDS_BYTES=LDS_OST+NW*4096;
constexpr int LDS_CB=LDS_BYTES;
constexpr float C2=0.125f*1.4426950408889634f;
__device__ __forceinline__ void glds16(const void*gsrc,unsigned lds_dst){unsigned keep;
  asm volatile("s_mov_b32 %0, m0\n\ts_mov_b32 m0, %2\n\ts_nop 0\n\tglobal_load_lds_dwordx4 %1, off\n\ts_mov_b32 m0, %0":"=&s"(keep):"v"(gsrc),"s"(lds_dst):"memory");}
__device__ __forceinline__ float max3f(float a,float b,float c){float r;asm("v_max3_f32 %0, %1, %2, %3":"=v"(r):"v"(a),"v"(b),"v"(c));return r;}
__device__ __forceinline__ float max2f(float a,float b){float r;asm("v_max_f32_e32 %0, %1, %2":"=v"(r):"v"(a),"v"(b));return r;}
__device__ __forceinline__ float fadd_s(float a,float b){float r;asm("v_add_f32_e32 %0, %1, %2":"=v"(r):"v"(a),"v"(b));return r;}
__device__ __forceinline__ float fsub_s(float a,float b){float r;asm("v_sub_f32_e32 %0, %1, %2":"=v"(r):"v"(a),"v"(b));return r;}
typedef float f32x2_t __attribute__((ext_vector_type(2))); typedef __bf16 bf16x2_t __attribute__((ext_vector_type(2)));
__device__ __forceinline__ unsigned cvtpk_s(float lo,float hi){f32x2_t v={lo,hi};bf16x2_t b=__builtin_convertvector(v,bf16x2_t);return __builtin_bit_cast(unsigned,b);}
#define WAIT_BAR(N) asm volatile("s_waitcnt vmcnt(" #N ") lgkmcnt(0)\n\ts_barrier":::"memory")

__device__ __forceinline__ void qkt(f32x16&p0,f32x16&p1,const char*Kslot,const bf16x8*qr,const f32x16&negm,int r32,int hi){
  const char*kb=Kslot+hi*1024+r32*16;
  #pragma unroll
  for(int d0=0;d0<4;++d0){
    const bf16x8 b0=*reinterpret_cast<const bf16x8*>(kb+d0*2048);
    const bf16x8 b1=*reinterpret_cast<const bf16x8*>(kb+d0*2048+512);
    if(d0==0){p0=__builtin_amdgcn_mfma_f32_32x32x16_bf16(b0,qr[0],negm,0,0,0);p1=__builtin_amdgcn_mfma_f32_32x32x16_bf16(b1,qr[0],negm,0,0,0);}
    else{p0=__builtin_amdgcn_mfma_f32_32x32x16_bf16(b0,qr[d0],p0,0,0,0);p1=__builtin_amdgcn_mfma_f32_32x32x16_bf16(b1,qr[d0],p1,0,0,0);}}
}
typedef __attribute__((address_space(3))) const char* lds_cptr;
typedef short v4i16_t __attribute__((ext_vector_type(4)));
__device__ __forceinline__ void kload8(bf16x8*kf,lds_cptr kp){
  kf[0]=*(const __attribute__((address_space(3))) bf16x8*)(kp);      kf[1]=*(const __attribute__((address_space(3))) bf16x8*)(kp+512);
  kf[2]=*(const __attribute__((address_space(3))) bf16x8*)(kp+2048); kf[3]=*(const __attribute__((address_space(3))) bf16x8*)(kp+2560);
  kf[4]=*(const __attribute__((address_space(3))) bf16x8*)(kp+4096); kf[5]=*(const __attribute__((address_space(3))) bf16x8*)(kp+4608);
  kf[6]=*(const __attribute__((address_space(3))) bf16x8*)(kp+6144); kf[7]=*(const __attribute__((address_space(3))) bf16x8*)(kp+6656);
}
__device__ __forceinline__ void kload2(bf16x8*kf,lds_cptr kp,int j){ kf[2*j]=*(const __attribute__((address_space(3))) bf16x8*)(kp+j*2048); kf[2*j+1]=*(const __attribute__((address_space(3))) bf16x8*)(kp+j*2048+512); }
__device__ __forceinline__ s16x4 vtr(lds_cptr p){ return __builtin_bit_cast(s16x4,__builtin_amdgcn_ds_read_tr16_b64_v4i16((__attribute__((address_space(3))) v4i16_t*)p)); }
__device__ __forceinline__ float rowmax(const f32x16&p0,const f32x16&p1){
  float a=max3f(p0[0],p0[1],p1[0]),b=max3f(p0[2],p0[3],p1[1]);a=max3f(a,p1[2],p1[3]);
  #pragma unroll
  for(int r=4;r<16;r+=4){a=max3f(a,p0[r],p0[r+1]);b=max3f(b,p0[r+2],p0[r+3]);a=max3f(a,p1[r],p1[r+1]);b=max3f(b,p1[r+2],p1[r+3]);}
  const float m=max2f(a,b);
  auto rr=__builtin_amdgcn_permlane32_swap(__float_as_uint(m),__float_as_uint(m),false,false);
  return max2f(__uint_as_float(rr[0]),__uint_as_float(rr[1]));
}
__device__ __forceinline__ void pv(f32x16*o,int vb,bf16x8 pa0,bf16x8 pa1,bf16x8 pa2,bf16x8 pa3){
  #pragma unroll
  for(int d0=0;d0<2;++d0){s16x4 lo[4],hi[4];
    #pragma unroll
    for(int ks=0;ks<4;++ks){
      asm volatile("ds_read_b64_tr_b16 %0,%1 offset:%c2":"=&v"(lo[ks]):"v"(vb),"i"(d0*4096+ks*1024):"memory");
      asm volatile("ds_read_b64_tr_b16 %0,%1 offset:%c2":"=&v"(hi[ks]):"v"(vb),"i"(d0*4096+ks*1024+512):"memory");}
    asm volatile("s_waitcnt lgkmcnt(0)":::"memory");SBAR();
    #define PK(k) (bf16x8){lo[k][0],lo[k][1],lo[k][2],lo[k][3],hi[k][0],hi[k][1],hi[k][2],hi[k][3]}
    o[d0]=__builtin_amdgcn_mfma_f32_32x32x16_bf16(pa0,PK(0),o[d0],0,0,0);
    o[d0]=__builtin_amdgcn_mfma_f32_32x32x16_bf16(pa1,PK(1),o[d0],0,0,0);
    o[d0]=__builtin_amdgcn_mfma_f32_32x32x16_bf16(pa2,PK(2),o[d0],0,0,0);
    o[d0]=__builtin_amdgcn_mfma_f32_32x32x16_bf16(pa3,PK(3),o[d0],0,0,0);
    #undef PK
  }
}

#ifndef ATTN_STORE16
#define ATTN_STORE16(p,v) (*(u32x4*)(p)=(v))
#endif
template<int THRL> __device__ __forceinline__ void attn_unit(int b,int h,int qb,const bf16*Q,const bf16*__restrict__ K,const bf16*__restrict__ V,bf16*O,const float*__restrict__ cl,const float*__restrict__ tot,const float*__restrict__ qn,const float*__restrict__ kn,char*shm){
  int tid_=threadIdx.x; asm volatile("":"+v"(tid_)); const int tid=tid_,lane=tid&63,r32=lane&31,hi=lane>>5; const int wid=__builtin_amdgcn_readfirstlane(tid>>6);
  const long rowbase=(long)b*SEQ; const int q0=qb*QB;
  const bf16*Qw=Q+(rowbase+q0+wid*QBLK)*DM+h*D;

  typedef float f32x4_t __attribute__((ext_vector_type(4)));
  int t_start=0;
  {
    const float qnA_=qn[((b*32+qb)*8+h)*2],qnB_=qn[((b*32+qb)*8+h)*2+1],knA_=kn[(b*8+h)*2],knB_=kn[(b*8+h)*2+1];
    const int j_=tid>>4;
    float inc_=((lane&31)<qb)?tot[((b*32+(lane&31))*8)+h]:0.f;
    #pragma unroll
    for(int o_=1;o_<32;o_<<=1){ const float u_=__shfl_up(inc_,o_,32); if((lane&31)>=o_)inc_+=u_; }
    const float Pq=(qb>0)?__shfl(inc_,qb-1,32):0.f;
    const float Pj_=__shfl(inc_,(j_>0?j_-1:0)&31,32); const float Pj=(j_>0)?Pj_:0.f;
    const float*clh=cl+(size_t)(b*NHEAD+h)*SEQ;
    const float cref=clh[q0]+Pq;
    __attribute__((address_space(3))) float*cbf=(__attribute__((address_space(3))) float*)((__attribute__((address_space(3))) char*)shm+LDS_CB);
    if(16*tid<q0+QB){
      __attribute__((address_space(3))) f32x4_t*dst=(__attribute__((address_space(3))) f32x4_t*)cbf+4*tid;
      #pragma unroll
      for(int c_=0;c_<4;++c_){ f32x4_t v_=*(const f32x4_t*)(clh+16*tid+4*c_); v_=(cref-(v_+Pj))*1.4426950408889634f; dst[c_]=v_; }
    }
    asm volatile("s_waitcnt lgkmcnt(0)\n\ts_barrier":::"memory");
    const float q2=(qnA_+qnB_)*1.02f, k2=(knA_+knB_)*1.02f;
    const float thr=-2.f*sqrtf(q2*k2)-152.f;
    const int NT0=(q0+QB)/KVBLK; int lo_=0,hi_=NT0-4;
    while(lo_<hi_){ const int mid_=(lo_+hi_)>>1; if(cbf[64*mid_+63]<thr)lo_=mid_+1; else hi_=mid_; }
    t_start=__builtin_amdgcn_readfirstlane(lo_&~1);
  }
  #define CBIAS(P0,P1,t) do{ const lds_cptr cb_=shm3+LDS_CB+(t_start+(t))*256+hi*16; \
    _Pragma("unroll") for(int j_=0;j_<4;++j_){ const f32x4_t b0_=*(const __attribute__((address_space(3))) f32x4_t*)(cb_+j_*32)-mhat; const f32x4_t b1_=*(const __attribute__((address_space(3))) f32x4_t*)(cb_+128+j_*32)-mhat; \
      P0[4*j_]+=b0_[0];P0[4*j_+1]+=b0_[1];P0[4*j_+2]+=b0_[2];P0[4*j_+3]+=b0_[3]; P1[4*j_]+=b1_[0];P1[4*j_+1]+=b1_[1];P1[4*j_+2]+=b1_[2];P1[4*j_+3]+=b1_[3]; } }while(0)
  #define LBIAS(P0,P1,t) do{ const lds_cptr cb_=shm3+LDS_CB+(t_start+(t))*256+hi*16; \
    _Pragma("unroll") for(int j_=0;j_<4;++j_){ const f32x4_t b0_=*(const __attribute__((address_space(3))) f32x4_t*)(cb_+j_*32); const f32x4_t b1_=*(const __attribute__((address_space(3))) f32x4_t*)(cb_+128+j_*32); \
      P0[4*j_]=b0_[0];P0[4*j_+1]=b0_[1];P0[4*j_+2]=b0_[2];P0[4*j_+3]=b0_[3]; P1[4*j_]=b1_[0];P1[4*j_+1]=b1_[1];P1[4*j_+2]=b1_[2];P1[4*j_+3]=b1_[3]; } \
    if(__builtin_expect(__any(mhat!=0.f),0)){ _Pragma("unroll") for(int r_=0;r_<16;++r_){P0[r_]-=mhat;P1[r_]-=mhat;} } }while(0)
  const bf16*Kh=K+(rowbase+(long)t_start*KVBLK)*DM+h*D,*Vh=V+(rowbase+(long)t_start*KVBLK)*DM+h*D;
  const unsigned lds0=(unsigned)(uintptr_t)shm;
  float*wsf=(float*)(shm+LDS_WS)+wid*64;
  const bf16*ksrc=Kh+(long)lane*DM+wid*8;
  const bf16*vsrc=Vh+(long)(16*(wid&3)+(lane>>2))*DM+(wid>>2)*32+(lane&3)*8;
  const unsigned kdst=lds0+LDS_K+wid*1024, vdst=lds0+LDS_V+wid*1024;
  #define DMA_K(t,slot) glds16(ksrc+(long)(t)*KVBLK*DM,(unsigned)__builtin_amdgcn_readfirstlane(kdst+(slot)))
  #define DMA_V(t,slot) glds16(vsrc+(long)(t)*KVBLK*DM,(unsigned)__builtin_amdgcn_readfirstlane(vdst+(slot)))
  const int vb0=(int)(lds0+LDS_V)+((lane>>4)&1)*32+(lane&3)*8+(4*hi+((lane&15)>>2))*64;
  const char*Kbase=shm+LDS_K; bf16x8 kf[8];
  const lds_cptr shm3=(lds_cptr)shm; const lds_cptr kp0=shm3+LDS_K+hi*1024+r32*16; const lds_cptr vp0=shm3+LDS_V+((lane>>4)&1)*32+(lane&3)*8+(4*hi+((lane&15)>>2))*64;
  const int NT=(q0+QB)/KVBLK-t_start;
  DMA_K(0,0);DMA_V(0,0);DMA_K(1,SLOTB);
  bf16x8 qr[4];
  #pragma unroll
  for(int d0=0;d0<4;++d0)qr[d0]=*reinterpret_cast<const bf16x8*>(&Qw[(long)r32*DM+d0*16+hi*8]);
  float mhat=0.f,l_reg=0.f;f32x16 o[2];o[0]=f32x16{};o[1]=f32x16{};const f32x16 negm=f32x16{};
  const int qrel=wid*QBLK+r32;
  #define CMASK(P0,P1,t) do{int jb_=(t)-(NT-4); if(jb_>=0)cmask(P0,P1,jb_,qrel,hi);}while(0)
  bool resc=false;
  #define START(P0,P1) do{ const float rm=rowmax(P0,P1); resc=false; \
    { const float dl=__builtin_fmaxf(rm,0.f); mhat=fadd_s(mhat,dl); \
      _Pragma("unroll") for(int r=0;r<16;++r){P0[r]=fsub_s(P0[r],dl);P1[r]=fsub_s(P1[r],dl);} \
       } \
    _Pragma("unroll") for(int r=0;r<16;++r)P0[r]=__builtin_amdgcn_exp2f(P0[r]); }while(0)
  #define RESC() do{ if(resc){ asm volatile("s_waitcnt lgkmcnt(0)":::"memory"); \
      _Pragma("unroll") for(int d_=0;d_<2;++d_) _Pragma("unroll") for(int r=0;r<16;++r)o[d_][r]*=wsf[crow(r,hi)]; } }while(0)
  f32x16 pA0,pA1,pB0,pB1;
  int sl_prev=0,sl_cur=0,sl_next=SLOTB;
  #define ROT() do{sl_prev=sl_cur;sl_cur=sl_next;sl_next=(sl_next==(NSLOT-1)*SLOTB)?0:sl_next+SLOTB;}while(0)
  DMA_K(2,2*SLOTB);
  WAIT_BAR(3);
  qkt(pA0,pA1,Kbase,qr,negm,r32,hi);asm volatile("s_nop 15\n\ts_nop 7":"+v"(pA0),"+v"(pA1));CMASK(pA0,pA1,0);CBIAS(pA0,pA1,0);
  START(pA0,pA1);
  _Pragma("unroll") for(int r=0;r<16;++r)pA1[r]=__builtin_amdgcn_exp2f(pA1[r]);
  WAIT_BAR(0);
  DMA_K(3,0);DMA_V(1,SLOTB);
  ROT();
  kload8(kf,kp0+sl_cur);
  WAIT_BAR(2);
  s16x4 vlo[8],vhi[8]; u32x4 pw0,pw1,pw2,pw3;
  #define PKW(P,B) cvtpk_s(P[B],P[B+1])
  #define PAF(k) __builtin_bit_cast(bf16x8,pw##k)
  #define VFR(i) (bf16x8){vlo[i][0],vlo[i][1],vlo[i][2],vlo[i][3],vhi[i][0],vhi[i][1],vhi[i][2],vhi[i][3]}
  #define PIN(x) asm volatile("":"+v"(x))
  #define MX3(a,b,c) __builtin_fmaxf(__builtin_fmaxf((a),(b)),(c))
  #define GAPA(MF,A0,A1,A2,A3,W0,W1,PW) do{ MF; sacc+=A0; sacc+=A1; sacc+=A2; sacc+=A3; PIN(sacc); W0; W1; PIN(PW); SBAR(); }while(0)
  #define EX(v) __builtin_amdgcn_exp2f(v)
  #define GAPB(MF,X,B) do{ MF; X[B]=EX(X[B]); X[B+1]=EX(X[B+1]); X[B+2]=EX(X[B+2]); X[B+3]=EX(X[B+3]); PIN(X); SBAR(); }while(0)
  #define VRD(i) do{ vlo[i]=vtr(vp_+(((i)>>2)*4096+((i)&3)*1024)); vhi[i]=vtr(vp_+(((i)>>2)*4096+((i)&3)*1024+512)); }while(0)
  #define KRD(G,j) do{ if(G){ kload2(kf,kp0+sl_next,j); SBAR(); } }while(0)
  #define STEP(C0,C1,P0,P1,t,GK,GV,GL) do{ SBAR(); \
    const lds_cptr vp_=vp0+sl_prev; LBIAS(C0,C1,t); \
    VRD(0); SBAR(); float sacc=(P0[0]+P0[1]); \
    GAPA(C0=__builtin_amdgcn_mfma_f32_32x32x16_bf16(kf[0],qr[0],C0,0,0,0), P0[2],P0[3],P0[4],P0[5],     pw0[0]=PKW(P0,0), pw0[1]=PKW(P0,2), pw0); \
    VRD(4); SBAR(); GAPA(C1=__builtin_amdgcn_mfma_f32_32x32x16_bf16(kf[1],qr[0],C1,0,0,0), P0[6],P0[7],P0[8],P0[9],     pw0[2]=PKW(P0,4), pw0[3]=PKW(P0,6), pw0); \
    VRD(1); SBAR(); GAPA(C0=__builtin_amdgcn_mfma_f32_32x32x16_bf16(kf[2],qr[1],C0,0,0,0),   P0[10],P0[11],P0[12],P0[13], pw1[0]=PKW(P0,8), pw1[1]=PKW(P0,10), pw1); \
    VRD(5); SBAR(); GAPA(C1=__builtin_amdgcn_mfma_f32_32x32x16_bf16(kf[3],qr[1],C1,0,0,0),   P0[14],P0[15],P1[0],P1[1],   pw1[2]=PKW(P0,12),pw1[3]=PKW(P0,14), pw1); \
    VRD(2); SBAR(); GAPA(C0=__builtin_amdgcn_mfma_f32_32x32x16_bf16(kf[4],qr[2],C0,0,0,0),   P1[2],P1[3],P1[4],P1[5],     pw2[0]=PKW(P1,0), pw2[1]=PKW(P1,2), pw2); \
    VRD(6); SBAR(); GAPA(C1=__builtin_amdgcn_mfma_f32_32x32x16_bf16(kf[5],qr[2],C1,0,0,0),   P1[6],P1[7],P1[8],P1[9],     pw2[2]=PKW(P1,4), pw2[3]=PKW(P1,6), pw2); \
    VRD(3); SBAR(); GAPA(C0=__builtin_amdgcn_mfma_f32_32x32x16_bf16(kf[6],qr[3],C0,0,0,0),   P1[10],P1[11],P1[12],P1[13], pw3[0]=PKW(P1,8), pw3[1]=PKW(P1,10), pw3); \
    VRD(7); SBAR(); GAPA(C1=__builtin_amdgcn_mfma_f32_32x32x16_bf16(kf[7],qr[3],C1,0,0,0),   P1[14],P1[15],0.f,0.f,       pw3[2]=PKW(P1,12),pw3[3]=PKW(P1,14), pw3); \
    l_reg+=sacc; \
    if(GK){DMA_K((t)+3,sl_cur);} if(GV){DMA_V((t)+1,sl_next);} \
    CMASK(C0,C1,t); \
    { float a=MX3(C0[0],C0[1],C1[0]),b=MX3(C0[2],C0[3],C1[1]); a=MX3(a,C1[2],C1[3]); \
      _Pragma("unroll") for(int r=4;r<16;r+=4){a=MX3(a,C0[r],C0[r+1]);b=MX3(b,C0[r+2],C0[r+3]);a=MX3(a,C1[r],C1[r+1]);b=MX3(b,C1[r+2],C1[r+3]);} \
      float rm=__builtin_fmaxf(a,b); { auto rr=__builtin_amdgcn_permlane32_swap(__float_as_uint(rm),__float_as_uint(rm),false,false); rm=__builtin_fmaxf(__uint_as_float(rr[0]),__uint_as_float(rr[1])); } \
      resc=false; \
      if(__builtin_expect(__any(rm>(float)THRL),0)){ const float dl=__builtin_fmaxf(rm,0.f); mhat+=dl; \
        _Pragma("unroll") for(int r=0;r<16;++r){C0[r]-=dl;C1[r]-=dl;} \
         \
        const float f=__builtin_amdgcn_exp2f(-dl); l_reg*=f; if(hi==0)wsf[r32]=f; resc=true; } } \
    SBAR(); \
    GAPB(o[0]=__builtin_amdgcn_mfma_f32_32x32x16_bf16(PAF(0),VFR(0),o[0],0,0,0), C0,0); \
    GAPB(o[1]=__builtin_amdgcn_mfma_f32_32x32x16_bf16(PAF(0),VFR(4),o[1],0,0,0), C0,4); \
    KRD(GL,0); GAPB(o[0]=__builtin_amdgcn_mfma_f32_32x32x16_bf16(PAF(1),VFR(1),o[0],0,0,0), C0,8); \
    KRD(GL,1); GAPB(o[1]=__builtin_amdgcn_mfma_f32_32x32x16_bf16(PAF(1),VFR(5),o[1],0,0,0), C0,12); \
    KRD(GL,2); GAPB(o[0]=__builtin_amdgcn_mfma_f32_32x32x16_bf16(PAF(2),VFR(2),o[0],0,0,0), C1,0); \
    KRD(GL,3); GAPB(o[1]=__builtin_amdgcn_mfma_f32_32x32x16_bf16(PAF(2),VFR(6),o[1],0,0,0), C1,4); \
    GAPB(o[0]=__builtin_amdgcn_mfma_f32_32x32x16_bf16(PAF(3),VFR(3),o[0],0,0,0), C1,8); \
    GAPB(o[1]=__builtin_amdgcn_mfma_f32_32x32x16_bf16(PAF(3),VFR(7),o[1],0,0,0), C1,12); \
    }while(0)
  int t=1;
  #undef CMASK
  #define CMASK(P0,P1,t) do{}while(0)
  for(;t+5<NT;t+=2){
    STEP(pB0,pB1,pA0,pA1,t,true,true,true);     WAIT_BAR(2); RESC(); ROT();
    STEP(pA0,pA1,pB0,pB1,t+1,true,true,true);   WAIT_BAR(2); RESC(); ROT();
  }
  #undef CMASK
  #define CMASK(P0,P1,t) do{int jb_=(t)-(NT-4); if(jb_>=0)cmask(P0,P1,jb_,qrel,hi);}while(0)
  #define ENDW(tt) do{ if((tt)+3<NT){WAIT_BAR(2);} else if((tt)+2<NT){WAIT_BAR(1);} else {WAIT_BAR(0);} }while(0)
  for(;t+1<NT;t+=2){
    STEP(pB0,pB1,pA0,pA1,t,(t+3<NT),(t+1<NT),(t+1<NT));       ENDW(t);   RESC(); ROT();
    STEP(pA0,pA1,pB0,pB1,t+1,(t+4<NT),(t+2<NT),(t+2<NT));     ENDW(t+1); RESC(); ROT();
  }
  STEP(pB0,pB1,pA0,pA1,NT-1,false,false,false); RESC();
  { float sacc=pB0[0]+pB0[1]; _Pragma("unroll") for(int r=2;r<16;++r)sacc+=pB0[r]; _Pragma("unroll") for(int r=0;r<16;++r)sacc+=pB1[r]; l_reg+=sacc;
    pw0=(u32x4){PKW(pB0,0),PKW(pB0,2),PKW(pB0,4),PKW(pB0,6)};pw1=(u32x4){PKW(pB0,8),PKW(pB0,10),PKW(pB0,12),PKW(pB0,14)};pw2=(u32x4){PKW(pB1,0),PKW(pB1,2),PKW(pB1,4),PKW(pB1,6)};pw3=(u32x4){PKW(pB1,8),PKW(pB1,10),PKW(pB1,12),PKW(pB1,14)};
    SBAR(); pv(o,vb0+sl_cur,PAF(0),PAF(1),PAF(2),PAF(3)); }
  #undef PKW
  #undef PAF
  #undef VFR
  #undef PIN
  #undef MX3
  #undef GAPA
  #undef GAPB
  #undef EX
  #undef VRD
  #undef KRD
  #undef STEP
  #undef ENDW
  {auto rr=__builtin_amdgcn_permlane32_swap(__float_as_uint(l_reg),__float_as_uint(l_reg),false,false);l_reg=__uint_as_float(rr[0])+__uint_as_float(rr[1]);}
  if(hi==0)wsf[32+r32]=l_reg;asm volatile("s_waitcnt lgkmcnt(0)":::"memory");
  float rli[16];
  #pragma unroll
  for(int r=0;r<16;++r)rli[r]=__builtin_amdgcn_rcpf(wsf[32+crow(r,hi)]);
  bf16*Ow=O+(rowbase+q0+wid*QBLK)*DM+h*D;
  { bf16*stg=(bf16*)(shm+LDS_OST)+wid*2048;
    #pragma unroll
    for(int r=0;r<16;++r){const int orow=crow(r,hi);
      #pragma unroll
      for(int d0=0;d0<2;++d0)stg[orow*64+d0*32+r32]=__float2bfloat16(o[d0][r]*rli[r]);}
    asm volatile("s_waitcnt lgkmcnt(0)":::"memory");
    #pragma unroll
    for(int i=0;i<4;++i){const int row=i*8+(lane>>3),ch=lane&7; const u32x4 v=*(const u32x4*)(stg+row*64+ch*8); ATTN_STORE16(Ow+(long)row*DM+ch*8,v);} }
  asm volatile("s_waitcnt lgkmcnt(0)\n\ts_barrier":::"memory");
  #undef DMA_K
  #undef DMA_V
  #undef CMASK
  #undef CBIAS
  #undef LBIAS
  #undef START
  #undef RESC
  #undef ROT
}
constexpr int ATTN_LDS_BYTES=LDS_BYTES+32768;
#undef SBAR
#undef WAIT_BAR
}


constexpr int NB = 8, SEQ = 8192, DM = 1024, MROWS = NB * SEQ;
constexpr int DEPTH = 2, NIN = 4360, NZ = 4352, DFF = 2816;
constexpr float LN_EPS = 1e-5f;
constexpr float ALPHA = 1.4142135623730951f;
constexpr float LOG2E = 1.4426950408889634f;
constexpr float C2 = 0.125f * LOG2E;
constexpr int ZQA = 0, ZKA = 512, ZVA = 640, ZQB = 768, ZKB = 1280, ZVB = 1792, ZGA = 2304, ZGB = 3328;

constexpr size_t MiB = 1u << 20;
constexpr size_t W_IN_B = (size_t)NZ * 1024 * 2, W_PA_B = (size_t)1024 * 512 * 2, W_OUT_B = (size_t)1024 * 1024 * 2, W_FI_B = (size_t)5632 * 1024 * 2, W_FO_B = (size_t)1024 * 2816 * 2;
constexpr size_t WL_IN = 0, WL_PA = WL_IN + W_IN_B, WL_PB = WL_PA + W_PA_B, WL_OUT = WL_PB + W_PA_B, WL_FI = WL_OUT + W_OUT_B, WL_FO = WL_FI + W_FI_B, WL_BYTES = WL_FO + W_FO_B;
constexpr size_t WS_W = 1 * MiB;
constexpr size_t WS_CL = 64 * MiB;
constexpr size_t WS_TOT = 66 * MiB;
constexpr size_t WS_QN = 66 * MiB + 65536, WS_KN = WS_QN + 65536;
constexpr size_t WS_TAIL = 67 * MiB, WS_HP = 73 * MiB, WS_HU = 79 * MiB;
constexpr size_t WS_ST = 86 * MiB;
constexpr size_t WS_HB = 96 * MiB;
constexpr size_t WS_MG = 224 * MiB;
constexpr size_t WS_Z = 352 * MiB;
constexpr size_t WS_END = WS_Z + (size_t)MROWS * NZ * 2;
static_assert(WS_W + DEPTH * WL_BYTES <= WS_CL && WS_HU + 6 * MiB <= WS_HB, "d_ws map");
constexpr size_t ZPANEL_B = (size_t)256 * NZ * 2;

constexpr int RING_BYTES = 131072, TL_OFF = RING_BYTES, STATS_OFF = TL_OFF + 4096  , LDS_BYTES = 147456;
constexpr int NWAVES = 8;

#define GAS __attribute__((address_space(1)))
#define LAS __attribute__((address_space(3)))
typedef unsigned short bf16;
typedef unsigned v4u __attribute__((ext_vector_type(4)));
typedef unsigned v2u __attribute__((ext_vector_type(2)));
typedef float f32x4 __attribute__((ext_vector_type(4)));
typedef short bf16x8 __attribute__((ext_vector_type(8)));
typedef float f32x16 __attribute__((ext_vector_type(16)));
#define LDS_WAIT() asm volatile("s_waitcnt lgkmcnt(0)" ::: "memory")
__device__ __forceinline__ unsigned f2bf(float f) { unsigned u = __builtin_bit_cast(unsigned, f); return (u + 0x7fffu + ((u >> 16) & 1u)) >> 16; }
__device__ __forceinline__ unsigned pk2(float lo, float hi) { return f2bf(lo) | (f2bf(hi) << 16); }
__device__ __forceinline__ float wave_sum(float v) {
#pragma unroll
    for (int o = 1; o < 64; o <<= 1) v += __shfl_xor(v, o);
    return v;
}

__device__ __forceinline__ void transpose_item(const float* W, int ldw, int K, int k0, int src_col0, bf16* WT, int dst_row0, LAS float* scr, int lane) {
#pragma unroll 8
    for (int i = 0; i < 32; ++i) { const int kk = 2 * i + (lane >> 5); scr[kk * 33 + (lane & 31)] = W[(size_t)(k0 + kk) * ldw + src_col0 + (lane & 31)]; }
    LDS_WAIT(); asm volatile("" ::: "memory");
    const int c = lane & 7;
#pragma unroll
    for (int j = 0; j < 4; ++j) { const int n = (lane >> 3) + 8 * j; const LAS float* s = scr + (8 * c) * 33 + n;
        v4u o; o.x = pk2(s[0 * 33], s[1 * 33]); o.y = pk2(s[2 * 33], s[3 * 33]); o.z = pk2(s[4 * 33], s[5 * 33]); o.w = pk2(s[6 * 33], s[7 * 33]);
        *(GAS v4u*)(WT + (size_t)(dst_row0 + n) * K + k0 + 8 * c) = o; }
    LDS_WAIT(); asm volatile("" ::: "memory");
}

struct Args { const float* in[15]; float* out; unsigned char* ws; };

template <bool DO_LN, bool DO_F, bool WRITE_R = true, bool WRITE_HB = true>
__device__ __forceinline__ void row_pass(LAS unsigned char* lds, int panel, const float* src, float* dstR, bf16* HB, const float* lg, const float* lb,
                                         const float* win_l, const float* bin_l, float* CL, float* TOT, float* GSTAT = nullptr) {
    int tid_ = threadIdx.x; asm volatile("" : "+v"(tid_)); const int tid = tid_, lane = tid & 63, wave = __builtin_amdgcn_readfirstlane(tid >> 6);
    LAS float* lcl = (LAS float*)lds;
    LAS float* wtot = (LAS float*)(lds + 8192);
    f32x4 gv[4], bv[4];
    if (DO_LN) {
#pragma unroll
        for (int j = 0; j < 4; ++j) { gv[j] = *(const f32x4*)(lg + 256 * j + 4 * lane); bv[j] = *(const f32x4*)(lb + 256 * j + 4 * lane); }
    }
    constexpr int RB = DO_F ? 2 : 4;
    f32x4 wfa[4][4], wfb[4][4]; float bf = 0.f, run = 0.f;
    if (DO_F) {
#pragma unroll
        for (int j = 0; j < 4; ++j)
#pragma unroll
            for (int e = 0; e < 4; ++e) { const float* p = win_l + (size_t)(256 * j + 4 * lane + e) * NIN + 2304; wfa[j][e] = *(const f32x4*)p; wfb[j][e] = *(const f32x4*)(p + 4); }
        bf = bin_l[2304 + (lane & 7)];
    }
    for (int i = 0; i < 32; i += RB) {
        const size_t row0 = (size_t)panel * 256 + wave * 32 + i;
        f32x4 v[RB][4]; float s[RB];
#pragma unroll
        for (int r = 0; r < RB; ++r) { const GAS f32x4* xr = (const GAS f32x4*)(src + (row0 + r) * DM) + lane; s[r] = 0.f;
#pragma unroll
            for (int j = 0; j < 4; ++j) { v[r][j] = xr[64 * j]; } }
        if (DO_LN) {
#pragma unroll
            for (int r = 0; r < RB; ++r)
#pragma unroll
                for (int j = 0; j < 4; ++j) s[r] += (v[r][j].x + v[r][j].y) + (v[r][j].z + v[r][j].w);
#pragma unroll
            for (int o = 1; o < 64; o <<= 1)
#pragma unroll
                for (int r = 0; r < RB; ++r) s[r] += __shfl_xor(s[r], o);
            float s2[RB];
#pragma unroll
            for (int r = 0; r < RB; ++r) { const float mean = s[r] * (1.f / DM); s2[r] = 0.f;
#pragma unroll
                for (int j = 0; j < 4; ++j) { v[r][j] = v[r][j] - mean; s2[r] += (v[r][j].x * v[r][j].x + v[r][j].y * v[r][j].y) + (v[r][j].z * v[r][j].z + v[r][j].w * v[r][j].w); } }
#pragma unroll
            for (int o = 1; o < 64; o <<= 1)
#pragma unroll
                for (int r = 0; r < RB; ++r) s2[r] += __shfl_xor(s2[r], o);
#pragma unroll
            for (int r = 0; r < RB; ++r) { const float rstd = 1.f / sqrtf(s2[r] * (1.f / DM) + LN_EPS);
                GAS f32x4* orow = (GAS f32x4*)(dstR + (row0 + r) * DM) + lane;
                if (!WRITE_R && lane == 0) { typedef float f32x2s __attribute__((ext_vector_type(2))); *(LAS f32x2s*)(lds + STATS_OFF + (wave * 32 + i + r) * 8) = (f32x2s){s[r] * (1.f / DM), rstd}; if (GSTAT) *(f32x2s*)(GSTAT + (row0 + r) * 2) = (f32x2s){s[r] * (1.f / DM), rstd}; }
#pragma unroll
                for (int j = 0; j < 4; ++j) { v[r][j] = v[r][j] * rstd * gv[j] + bv[j]; if (WRITE_R) orow[64 * j] = v[r][j]; } }
        }
        if (WRITE_HB)
#pragma unroll
        for (int r = 0; r < RB; ++r) { GAS v2u* o8 = (GAS v2u*)(HB + (row0 + r) * DM) + lane;
#pragma unroll
            for (int j = 0; j < 4; ++j) { v2u w; w.x = pk2(v[r][j].x, v[r][j].y); w.y = pk2(v[r][j].z, v[r][j].w); o8[64 * j] = w; } }
        if (DO_F) {
            float q[RB][8];
#pragma unroll
            for (int r = 0; r < RB; ++r) { f32x4 pa = (f32x4){0.f, 0.f, 0.f, 0.f}, pb = (f32x4){0.f, 0.f, 0.f, 0.f};
#pragma unroll
                for (int j = 0; j < 4; ++j) { pa += wfa[j][0] * v[r][j].x + wfa[j][1] * v[r][j].y + wfa[j][2] * v[r][j].z + wfa[j][3] * v[r][j].w; pb += wfb[j][0] * v[r][j].x + wfb[j][1] * v[r][j].y + wfb[j][2] * v[r][j].z + wfb[j][3] * v[r][j].w; }
                q[r][0] = pa.x; q[r][1] = pa.y; q[r][2] = pa.z; q[r][3] = pa.w; q[r][4] = pb.x; q[r][5] = pb.y; q[r][6] = pb.z; q[r][7] = pb.w; }
#pragma unroll
            for (int o = 1; o < 64; o <<= 1)
#pragma unroll
                for (int r = 0; r < RB; ++r)
#pragma unroll
                    for (int h = 0; h < 8; ++h) q[r][h] += __shfl_xor(q[r][h], o);
#pragma unroll
            for (int r = 0; r < RB; ++r) { float mine = q[r][0];
#pragma unroll
                for (int h = 1; h < 8; ++h) mine = ((lane & 7) == h) ? q[r][h] : mine;
                const float x = mine + bf;
                const float lf = fminf(x, 0.f) - log1pf(__expf(-fabsf(x)));
                run += lf;
                if (lane < 8) lcl[(wave * 32 + i + r) * 8 + lane] = run; }
        }
    }
    if (DO_F) {
        __syncthreads();
        if (lane < 8) wtot[wave * 8 + lane] = run;
        __syncthreads();
        const int b = panel >> 5, s0 = (panel & 31) * 256;
        for (int idx = tid; idx < 2048; idx += 512) { const int h = idx >> 8, r = idx & 255; float off = 0.f;
            for (int w = 0; w < (r >> 5); ++w) off += wtot[w * 8 + h];
            CL[((size_t)(b * 8 + h)) * SEQ + s0 + r] = lcl[r * 8 + h] + off; }
        if (tid < 8) { float t = 0.f; for (int w = 0; w < 8; ++w) t += wtot[w * 8 + tid]; TOT[panel * 8 + tid] = t; }
        __syncthreads();
    }
}


typedef GAS unsigned gu32;
#define RLX_AGENT __ATOMIC_RELAXED, __HIP_MEMORY_SCOPE_AGENT
#define XB_TMO      128
#define XB_XCNT(j)  (256  + 64 * (j))
#define XB_XSUB(j)  (1280 + 64 * (j))
#define XB_XGEN(j)  (2304 + 64 * (j))
#define XB_TOP      3328
#define XB_TOPGEN   3392
#define XCD_BAR_WORDS 3456
#define XB_SPIN_CAP (1u << 18)

__device__ __forceinline__ unsigned xb_ld(unsigned* p)              { return __hip_atomic_load(p, __ATOMIC_RELAXED, __HIP_MEMORY_SCOPE_AGENT); }
__device__ __forceinline__ unsigned xb_add(unsigned* p, unsigned v) { return __hip_atomic_fetch_add(p, v, __ATOMIC_RELAXED, __HIP_MEMORY_SCOPE_AGENT); }
__device__ __forceinline__ unsigned xb_xcc_id() { return (unsigned)__builtin_amdgcn_s_getreg((3 << 11) | 20) & 0xFu; }
#define XB_SPIN(cond, bar) do { unsigned _sp = 0; while (cond) { __builtin_amdgcn_s_sleep(1); \
    if ((++_sp & 255u) == 0u) { if (xb_ld(&(bar)[XB_TMO])) break; if (_sp > XB_SPIN_CAP) { atomicAdd(&(bar)[XB_TMO], 1u); break; } } } } while (0)

struct XcdBarrier {
    unsigned* bar; unsigned x;
    volatile LAS unsigned* st;
};

__device__ __forceinline__ XcdBarrier xcd_barrier_post(unsigned* bar, volatile LAS unsigned* st) {
    XcdBarrier b; b.bar = bar; b.x = xb_xcc_id(); b.st = st;
    if (threadIdx.x == 0) (void)xb_add(&bar[XB_XCNT(b.x)], 1u);
    return b;
}
__device__ __forceinline__ void xcd_barrier_complete(unsigned* bar, unsigned x, unsigned& nloc, unsigned& nx) {
    const unsigned G = gridDim.x * gridDim.y * gridDim.z;
    unsigned sum, cnt, mine, sp = 0u;
    for (;;) {
        sum = 0u; cnt = 0u; mine = 0u;
#pragma unroll
        for (unsigned j = 0; j < 16; ++j) { const unsigned c = xb_ld(&bar[XB_XCNT(j)]); sum += c; cnt += (c > 0u) ? 1u : 0u; mine = (j == x) ? c : mine; }
        if (sum == G) break;
        __builtin_amdgcn_s_sleep(1);
        if ((++sp & 255u) == 0u) { if (xb_ld(&bar[XB_TMO])) break; if (sp > XB_SPIN_CAP) { atomicAdd(&bar[XB_TMO], 1u); break; } }
    }
    nloc = mine > 0u ? mine : 1u; nx = cnt > 0u ? cnt : 1u;
}

__device__ __forceinline__ void xcd_barrier(const XcdBarrier& b) {
    asm volatile("s_waitcnt vmcnt(0)" ::: "memory");
    __syncthreads();
    if (threadIdx.x == 0) {
        unsigned* bar = b.bar;
        __builtin_amdgcn_s_waitcnt(0);
        unsigned nloc = b.st[0], nx = b.st[1];
        if (nloc == 0u) { xcd_barrier_complete(bar, b.x, nloc, nx); b.st[0] = nloc; b.st[1] = nx; }
        const unsigned old = xb_add(&bar[XB_XSUB(b.x)], 1u);
        const unsigned gen = old / nloc;
        if (old + 1u == (gen + 1u) * nloc) {
            __builtin_amdgcn_fence(__ATOMIC_RELEASE, "agent");
            asm volatile("s_waitcnt vmcnt(0)" ::: "memory");
            const unsigned og = xb_add(&bar[XB_TOP], 1u);
            const unsigned tg = og / nx;
            if (og + 1u == (tg + 1u) * nx) xb_add(&bar[XB_TOPGEN], 1u);
            else XB_SPIN(xb_ld(&bar[XB_TOPGEN]) == tg, bar);
            __builtin_amdgcn_fence(__ATOMIC_ACQUIRE, "agent");
            xb_add(&bar[XB_XGEN(b.x)], 1u);
            asm volatile("s_waitcnt vmcnt(0)" ::: "memory");
        } else {
            XB_SPIN(xb_ld(&bar[XB_XGEN(b.x)]) == gen, bar);
            __builtin_amdgcn_fence(__ATOMIC_ACQUIRE, "agent");
            asm volatile("s_waitcnt vmcnt(0)" ::: "memory");
        }
    }
    __syncthreads();
}
__device__ __forceinline__ void group_barrier(unsigned* cnt) {
    asm volatile("s_waitcnt vmcnt(0)" ::: "memory");
    __syncthreads();
    if (threadIdx.x == 0) {
        __builtin_amdgcn_fence(__ATOMIC_RELEASE, "agent");
        asm volatile("s_waitcnt vmcnt(0)" ::: "memory");
        const unsigned old = __hip_atomic_fetch_add(cnt, 1u, __ATOMIC_RELAXED, __HIP_MEMORY_SCOPE_AGENT);
        const unsigned target = (old / 32u + 1u) * 32u;
        unsigned sp = 0u;
        while (__hip_atomic_load(cnt, __ATOMIC_RELAXED, __HIP_MEMORY_SCOPE_AGENT) < target) { __builtin_amdgcn_s_sleep(1); if (++sp > (1u << 22)) break; }
        __builtin_amdgcn_fence(__ATOMIC_ACQUIRE, "agent");
        asm volatile("s_waitcnt vmcnt(0)" ::: "memory");
    }
    __syncthreads();
}

namespace swa {
constexpr int KSTR = 72, VSTR = 264;
constexpr int L_K = 0, L_VT = 256 * KSTR * 2, L_END = L_VT + 64 * VSTR * 2;
__device__ __forceinline__ int crow(int r, int hi) { return (r & 3) + 8 * (r >> 2) + 4 * hi; }
__device__ __forceinline__ void unit(int b, int hkv, int blk, bf16* Z, bf16* ZO, const float* sinks_l, LAS unsigned char* lds) {
    int tid_ = threadIdx.x; asm volatile("" : "+v"(tid_)); const int tid = tid_, lane = tid & 63, r32 = lane & 31, hi = lane >> 5; const int wid = __builtin_amdgcn_readfirstlane(tid >> 6);
    const size_t rowbase = (size_t)b * SEQ; const int k0 = blk * 128 - 128;
    {
        const int key = tid >> 1, half = tid & 1, kabs = k0 + key; const bool ok = kabs >= 0;
        const bf16* kp = Z + (rowbase + (ok ? kabs : 0)) * NZ + ZKA + hkv * 64 + 32 * half;
        const bf16* vp = Z + (rowbase + (ok ? kabs : 0)) * NZ + ZVA + hkv * 64 + 32 * half;
        v4u kv[4], vv[4];
#pragma unroll
        for (int c = 0; c < 4; ++c) { kv[c] = *(const GAS v4u*)(kp + 8 * c); vv[c] = *(const GAS v4u*)(vp + 8 * c); if (!ok) { kv[c] = (v4u){0u, 0u, 0u, 0u}; vv[c] = (v4u){0u, 0u, 0u, 0u}; } }
        LAS bf16* KL = (LAS bf16*)(lds + L_K); LAS bf16* VT = (LAS bf16*)(lds + L_VT);
#pragma unroll
        for (int c = 0; c < 4; ++c) {
            *(LAS v4u*)(KL + key * KSTR + 32 * half + 8 * c) = kv[c];
            const unsigned w[4] = {vv[c].x, vv[c].y, vv[c].z, vv[c].w};
#pragma unroll
            for (int e = 0; e < 4; ++e) { const int d = 32 * half + 8 * c + 2 * e; VT[d * VSTR + key] = (bf16)(w[e] & 0xffffu); VT[(d + 1) * VSTR + key] = (bf16)(w[e] >> 16); }
        }
    }
    __syncthreads();
    const LAS unsigned char* KLb = lds + L_K; const LAS unsigned char* VTb = lds + L_VT;
    for (int task = wid; task < 16; task += 8) {
        const int g = task >> 2, qt = task & 3, hq = hkv * 4 + g, i0 = blk * 128 + 32 * qt;
        bf16* qrow = Z + (rowbase + i0 + r32) * NZ + ZQA + hq * 64;
        bf16x8 qf[4];
#pragma unroll
        for (int d0 = 0; d0 < 4; ++d0) qf[d0] = *(const GAS bf16x8*)(qrow + 16 * d0 + 8 * hi);
        const float slope2 = exp2f(-(float)(hq + 1)) * LOG2E, sink2 = sinks_l[hq] * LOG2E;
        f32x16 s[5];
#pragma unroll
        for (int jt = 0; jt < 5; ++jt) {
            s[jt] = (f32x16){};
            const int slot = 32 * qt + 32 * jt + r32;
#pragma unroll
            for (int d0 = 0; d0 < 4; ++d0) { const bf16x8 a = *(const LAS bf16x8*)(KLb + (slot * KSTR + 16 * d0 + 8 * hi) * 2); s[jt] = __builtin_amdgcn_mfma_f32_32x32x16_bf16(a, qf[d0], s[jt], 0, 0, 0); }
        }
        float m = sink2;
#pragma unroll
        for (int jt = 0; jt < 5; ++jt)
#pragma unroll
            for (int r = 0; r < 16; ++r) {
                const int kslot = 32 * qt + 32 * jt + crow(r, hi);
                const int dist = 128 + r32 - 32 * jt - crow(r, hi);
                const bool ok = (dist >= 0) && (dist < 128) && (k0 + kslot >= 0);
                const float v = ok ? (s[jt][r] - slope2 * (float)dist) : -INFINITY;
                s[jt][r] = v; m = fmaxf(m, v);
            }
        m = fmaxf(m, __shfl_xor(m, 32));
        float l = 0.f;
#pragma unroll
        for (int jt = 0; jt < 5; ++jt)
#pragma unroll
            for (int r = 0; r < 16; ++r) { const float p = __builtin_amdgcn_exp2f(s[jt][r] - m); s[jt][r] = p; l += p; }
        l += __shfl_xor(l, 32);
        l += __builtin_amdgcn_exp2f(sink2 - m);
        const float inv = 1.0f / l;
#pragma unroll
        for (int dh = 0; dh < 2; ++dh) {
            f32x16 o = (f32x16){};
#pragma unroll
            for (int jt = 0; jt < 5; ++jt)
#pragma unroll
                for (int ks = 0; ks < 2; ++ks) {
                    v4u pw; pw.x = pg8::cvt_pk_bf16(s[jt][8 * ks + 0], s[jt][8 * ks + 1]); pw.y = pg8::cvt_pk_bf16(s[jt][8 * ks + 2], s[jt][8 * ks + 3]);
                    pw.z = pg8::cvt_pk_bf16(s[jt][8 * ks + 4], s[jt][8 * ks + 5]); pw.w = pg8::cvt_pk_bf16(s[jt][8 * ks + 6], s[jt][8 * ks + 7]);
                    const int d = 32 * dh + r32, slot = 32 * qt + 32 * jt + 16 * ks + 4 * hi;
                    const v2u lo = *(const LAS v2u*)(VTb + (d * VSTR + slot) * 2), hi8 = *(const LAS v2u*)(VTb + (d * VSTR + slot + 8) * 2);
                    const v4u av = (v4u){lo.x, lo.y, hi8.x, hi8.y};
                    o = __builtin_amdgcn_mfma_f32_32x32x16_bf16(__builtin_bit_cast(bf16x8, av), __builtin_bit_cast(bf16x8, pw), o, 0, 0, 0);
                }
#pragma unroll
            for (int j = 0; j < 4; ++j) { v2u w; w.x = pg8::cvt_pk_bf16(o[4 * j] * inv, o[4 * j + 1] * inv); w.y = pg8::cvt_pk_bf16(o[4 * j + 2] * inv, o[4 * j + 3] * inv);
                *(GAS v2u*)(ZO + (qrow - Z) + 32 * dh + 8 * j + 4 * hi) = w; }
        }
    }
    __syncthreads();
}
}

#ifndef STAG_TICKS
#define STAG_TICKS 800
#endif
__device__ __forceinline__ void stagger(int cls) {
    if (cls) { const unsigned long long t0 = __builtin_amdgcn_s_memrealtime(), want = (unsigned long long)cls * STAG_TICKS;
        while (__builtin_amdgcn_s_memrealtime() - t0 < want) __builtin_amdgcn_s_sleep(16); }
}
#define GSYNC() xcd_barrier(xbar)
__global__ void __launch_bounds__(NWAVES * 64, 2) hybrid_fwd(Args args) {
    extern __shared__ __attribute__((aligned(16))) unsigned char lds_raw[];
    cg::grid_group grid = cg::this_grid();
    LAS unsigned char* lds = (LAS unsigned char*)lds_raw;
    const int tid = threadIdx.x, lane = tid & 63, wave = __builtin_amdgcn_readfirstlane(tid >> 6);
    const int G = gridDim.x, bx = blockIdx.x;
    const int vcu = (bx % 8) * (G / 8) + bx / 8;
    const int panel = vcu;
    unsigned char* ws = args.ws;
    const float* x = args.in[0];
    float* R = args.out;
    bf16* HB = (bf16*)(ws + WS_HB); bf16* MG = (bf16*)(ws + WS_MG); bf16* Z = (bf16*)(ws + WS_Z);
    float* CL = (float*)(ws + WS_CL); float* TOT = (float*)(ws + WS_TOT);
    float* TAIL = (float*)(ws + WS_TAIL); float* HP = (float*)(ws + WS_HP); float* HU = (float*)(ws + WS_HU);
    bf16* Hpanel = (bf16*)(ws + WS_Z + (size_t)panel * ZPANEL_B);
    bf16* Hadj = Hpanel - (size_t)panel * 256 * DFF;

    float* RD = (float*)(ws + WS_END) - (size_t)panel * 256 * DM; bf16* HBD = (bf16*)(ws + WS_END + 2 * MiB) - (size_t)panel * 256 * DM;
    float* CLD = (float*)(ws + WS_END + 4 * MiB); float* TOTD = (float*)(ws + WS_END + 8 * MiB);
    volatile LAS unsigned* xst = (volatile LAS unsigned*)(lds + TL_OFF + 8192);
    if (tid < 2) xst[tid] = 0u;
    __syncthreads();
    XcdBarrier xbar = xcd_barrier_post((unsigned*)(ws + 4096), xst);
    unsigned* gcnt = (unsigned*)(ws + 32768) + 64 * (vcu >> 5);
    unsigned* QN = (unsigned*)(ws + WS_QN); unsigned* KN = (unsigned*)(ws + WS_KN);
    for (int i = bx * 512 + tid; i < DEPTH * 8192; i += G * 512) QN[i] = 0u;
    for (int i = bx * 512 + tid; i < DEPTH * 1024; i += G * 512) KN[i] = 0u;
#define STAMP(k) do {} while (0)
    STAMP(0);
    {
        LAS float* scr = (LAS float*)(lds + wave * 16384);
        const int gw = bx * NWAVES + wave, NGW = G * NWAVES;
        constexpr int I_IN = 16 * (NZ / 32), I_PA = 8 * 32, I_OUT = 16 * 32, I_FI = 16 * (5632 / 32), I_FO = 44 * 32, I_L = I_IN + 2 * I_PA + I_OUT + I_FI + I_FO;
        for (int it = gw; it < DEPTH * I_L; it += NGW) {
            const int l = it / I_L; int r = it % I_L;
            unsigned char* wl = ws + WS_W + (size_t)l * WL_BYTES;
            if (r < I_IN) { const int nblk = NZ / 32, kb = r / nblk, nb = r % nblk, n0 = 32 * nb;
                transpose_item(args.in[3] + (size_t)l * 1024 * NIN, NIN, 1024, 64 * kb, n0 + (n0 >= 2304 ? 8 : 0), (bf16*)(wl + WL_IN), n0, scr, lane); continue; } r -= I_IN;
            if (r < I_PA) { const int kb = r / 32, nb = r % 32; transpose_item(args.in[6] + (size_t)l * 512 * 1024, 1024, 512, 64 * kb, 32 * nb, (bf16*)(wl + WL_PA), 32 * nb, scr, lane); continue; } r -= I_PA;
            if (r < I_PA) { const int kb = r / 32, nb = r % 32; transpose_item(args.in[7] + (size_t)l * 512 * 1024, 1024, 512, 64 * kb, 32 * nb, (bf16*)(wl + WL_PB), 32 * nb, scr, lane); continue; } r -= I_PA;
            if (r < I_OUT) { const int kb = r / 32, nb = r % 32; transpose_item(args.in[8] + (size_t)l * 1024 * 1024, 1024, 1024, 64 * kb, 32 * nb, (bf16*)(wl + WL_OUT), 32 * nb, scr, lane); continue; } r -= I_OUT;
            if (r < I_FI) { const int nblk = 5632 / 32, kb = r / nblk, nb = r % nblk, n0 = 32 * nb, pn = n0 >> 8, j = n0 & 255;
                const int src = (j < 128) ? (128 * pn + j) : (DFF + 128 * pn + (j - 128));
                transpose_item(args.in[11] + (size_t)l * 1024 * 5632, 5632, 1024, 64 * kb, src, (bf16*)(wl + WL_FI), n0, scr, lane); continue; } r -= I_FI;
            { const int kb = r / 32, nb = r % 32; transpose_item(args.in[14] + (size_t)l * DFF * 1024, 1024, DFF, 64 * kb, 32 * nb, (bf16*)(wl + WL_FO), 32 * nb, scr, lane); }
        }
        __syncthreads();
        row_pass<false, true>(lds, panel, x, nullptr, HB, nullptr, nullptr, args.in[3], args.in[4], CL, TOT);
    }
    STAMP(1); grid.sync(); STAMP(2);

    for (int l = 0; l < DEPTH; ++l) {
        unsigned char* wl = ws + WS_W + (size_t)l * WL_BYTES;
        const float* resid_in = (l == 0) ? x : R;
        {
            pg8::Gemm g{HB, (const bf16*)(wl + WL_IN), MROWS, NZ, 1024, 1024}; pg8::GroupOrder S{(vcu >> 5) << 5, vcu & 31, NZ / 256};
            pg8::EpiZ E{Z, NZ, args.in[4] + (size_t)l * NIN, C2, QN + l * 8192, KN + l * 1024};

pg8::gemm_phase<pg8::EpiZ, pg8::GroupOrder, true, true>(lds, g, S, E);

        }
        STAMP(3 + 10 * l); GSYNC(); STAMP(4 + 10 * l);
        {
            const int g8 = vcu >> 3, w8 = vcu & 7;
#pragma unroll 1
            for (int i = 0; i < 8; ++i) {
                const int hsel = i >> 2, k4 = i & 3, bh = 2 * g8 + hsel, ww = hsel ? 7 - w8 : w8;
                const int qb = (k4 == 0) ? ww : (k4 == 1) ? 15 - ww : (k4 == 2) ? 16 + ww : 31 - ww;
                attn_body::attn_unit<20>(bh >> 3, bh & 7, qb, (const attn_body::bf16*)(Z + ZQB), (const attn_body::bf16*)(Z + ZKB), (const attn_body::bf16*)(Z + ZVB), (attn_body::bf16*)(Z + ZQB), CL, TOT, (const float*)(QN + l * 8192), (const float*)(KN + l * 1024), (char*)lds_raw);
            }
            __syncthreads();
#pragma unroll 1
            for (int i = 0; i < 4; ++i) { const int uid = vcu * 4 + i;
 swa::unit(uid >> 7, (uid >> 6) & 1, uid & 63, Z, Z, args.in[5] + l * 8, lds);
 }
        }
        STAMP(5 + 10 * l); GSYNC(); STAMP(6 + 10 * l);
        {
            pg8::PanelOrder S{panel, 4, 0, 3};
            { pg8::GroupOrder SG{(vcu >> 5) << 5, vcu & 31, 4};
              { pg8::Gemm g{Z + ZQA, (const bf16*)(wl + WL_PA), MROWS, 1024, 512, NZ}; pg8::EpiGate<false> E{MG, Z + ZGA, NZ};
                pg8::gemm_phase<pg8::EpiGate<false>, pg8::GroupOrder, true, true>(lds, g, SG, E); }
              __syncthreads();
              { pg8::Gemm g{Z + ZQB, (const bf16*)(wl + WL_PB), MROWS, 1024, 512, NZ}; pg8::EpiGate<true> E{MG, Z + ZGB, NZ};
                pg8::gemm_phase<pg8::EpiGate<true>, pg8::GroupOrder, true, true>(lds, g, SG, E); }
            }
            GSYNC();
            { pg8::Gemm g{MG, (const bf16*)(wl + WL_OUT), MROWS, 1024, 1024, 1024};
              if (l == 0) { pg8::EpiRes<false> E{x, R, ALPHA, (LAS const float*)(lds + STATS_OFF), nullptr, nullptr};
                  pg8::gemm_phase<pg8::EpiRes<false>, pg8::PanelOrder, true, true>(lds, g, S, E); }
              else { pg8::EpiRes<true> E{R, R, ALPHA, (LAS const float*)(lds + STATS_OFF), args.in[9] + (l - 1) * DM, args.in[10] + (l - 1) * DM};
                  pg8::gemm_phase<pg8::EpiRes<true>, pg8::PanelOrder, true, true>(lds, g, S, E); }
            }
            __syncthreads();
            row_pass<true, false, false>(lds, panel, R, R, HB, args.in[1] + l * DM, args.in[2] + l * DM, nullptr, nullptr, nullptr, nullptr, (float*)(ws + WS_ST));
            __syncthreads();
        }
        STAMP(7 + 10 * l);
        {
            GSYNC();
            pg8::Gemm g{HB, (const bf16*)(wl + WL_FI), MROWS, 5632, 1024, 1024}; pg8::GroupOrder S{(vcu >> 5) << 5, vcu & 31, 22};
            pg8::EpiConv E{Z, args.in[12] + (size_t)l * 3 * DFF, args.in[13] + (size_t)l * DFF, TAIL, HP, HU, (LAS float*)(lds + TL_OFF)};
            pg8::gemm_phase<pg8::EpiConv, pg8::GroupOrder, true, true>(lds, g, S, E);
        }
        STAMP(8 + 10 * l); GSYNC(); STAMP(9 + 10 * l);
        {
            const float* cw = args.in[12] + (size_t)l * 3 * DFF;
            const bool first = (panel & 31) == 0;
            int tidf = threadIdx.x; asm volatile("" : "+v"(tidf));
            for (int idx = tidf; idx < 2 * DFF; idx += 512) { const int r = idx / DFF, c = idx % DFF;
                float t0 = 0.f, t1 = 0.f;
                if (!first) { t0 = TAIL[((size_t)(panel - 1) * 2 + 0) * DFF + c]; t1 = TAIL[((size_t)(panel - 1) * 2 + 1) * DFF + c]; }
                float cv = HP[((size_t)panel * 2 + r) * DFF + c];
                cv += (r == 0) ? (cw[c] * t0 + cw[DFF + c] * t1) : (cw[c] * t1);
                const float hv = cv * pg8::sigmoidf_(cv) * HU[((size_t)panel * 2 + r) * DFF + c];
                Hpanel[(size_t)r * DFF + c] = (bf16)f2bf(hv); }
            GSYNC();
            { pg8::Gemm g{(const bf16*)(ws + WS_Z), (const bf16*)(wl + WL_FO), MROWS, 1024, DFF, DFF, ZPANEL_B}; pg8::GroupOrder S{(vcu >> 5) << 5, vcu & 31, 4};
              pg8::EpiRes<true, true> E{R, R, ALPHA, (LAS const float*)(lds + STATS_OFF), args.in[1] + l * DM, args.in[2] + l * DM, (const float*)(ws + WS_ST)};
              pg8::gemm_phase<pg8::EpiRes<true, true>, pg8::GroupOrder, true, true>(lds, g, S, E); }
            GSYNC();
            if (l + 1 < DEPTH) row_pass<true, true, false>(lds, panel, R, R, HB, args.in[9] + l * DM, args.in[10] + l * DM, args.in[3] + (size_t)(l + 1) * 1024 * NIN, args.in[4] + (size_t)(l + 1) * NIN, CL, TOT);
            else
            row_pass<true, false, true, false>(lds, panel, R, R, HB, args.in[9] + l * DM, args.in[10] + l * DM, nullptr, nullptr, nullptr, nullptr);
            __syncthreads();
            if (l + 1 < DEPTH) GSYNC();
        }
        if (l + 1 < DEPTH) STAMP(12);
    }
}

extern "C" void kernel_launch(void* const* d_in, const int* in_sizes, int n_in, void* d_out, int out_size, void* d_ws, size_t ws_size, hipStream_t stream) {
    static int grid = 0;
    if (grid == 0) {
        if (n_in != 15 || in_sizes[0] != MROWS * DM || out_size != MROWS * DM || ws_size < WS_END) { fprintf(stderr, "kernel_launch: unexpected shapes / workspace (n_in %d, in0 %d, out %d, ws %zu < %zu)\n", n_in, n_in > 0 ? in_sizes[0] : -1, out_size, ws_size, (size_t)WS_END); grid = -1; return; }
        int dev = 0, cus = 0, per_cu = 0;
        (void)hipGetDevice(&dev); (void)hipDeviceGetAttribute(&cus, hipDeviceAttributeMultiprocessorCount, dev);
        if (hipFuncSetAttribute((const void*)hybrid_fwd, hipFuncAttributeMaxDynamicSharedMemorySize, LDS_BYTES) != hipSuccess) { fprintf(stderr, "kernel_launch: hipFuncSetAttribute failed\n"); grid = -1; return; }
        (void)hipOccupancyMaxActiveBlocksPerMultiprocessor(&per_cu, (const void*)hybrid_fwd, NWAVES * 64, LDS_BYTES);
        (void)hipGetLastError();
        if (cus * per_cu < 256) fprintf(stderr, "kernel_launch: note: occupancy query says %d x %d workgroups; launching 256 anyway (the cooperative launch checks residency)\n", cus, per_cu);
        grid = 256;
    }
    if (grid < 0) return;
    if (hipMemsetAsync(d_ws, 0, 65536, stream) != hipSuccess) { fprintf(stderr, "kernel_launch: hipMemsetAsync failed\n"); return; }
    Args a{};
    for (int i = 0; i < 15; ++i) a.in[i] = (const float*)d_in[i];
    a.out = (float*)d_out; a.ws = (unsigned char*)d_ws;
    void* kargs[] = {&a};
    hipError_t e = hipLaunchCooperativeKernel((const void*)hybrid_fwd, dim3(grid), dim3(NWAVES * 64), kargs, LDS_BYTES, stream);
    if (e != hipSuccess) fprintf(stderr, "kernel_launch: cooperative launch failed: %s\n", hipGetErrorString(e));
}
```
